# Optimizing an MI355X kernel written in HIP

```python
import math
import jax, jax.numpy as jnp
from jax import lax
import numpy as np

D_MODEL = 2048
BATCH = 2
SEQ = 8192
DEPTH = 1

N_META = 16
ATTN_HEADS = 8
ATTN_HEAD_DIM = 128
D_ATTN = ATTN_HEADS * ATTN_HEAD_DIM
D_SSM = D_MODEL // 2
SSM_GROUP = 16
SSM_GROUPS = D_SSM // SSM_GROUP
SSM_STATE = 64
D_FF = 5632
CONV_WIDTH = 3
Q_BLOCK = 128
EPS = 1e-6
IN_SPLITS = [D_ATTN, D_ATTN, D_ATTN, ATTN_HEADS, D_SSM, D_MODEL, D_MODEL]
N_IN = sum(IN_SPLITS)
IN_OFFSETS = [int(o) for o in np.cumsum(IN_SPLITS)[:-1]]

kernel_name = "hybrid_s5_forgetting_attn_convffn"


def rmsnorm(x, g):
    xf = x.astype(jnp.float32)
    y = xf * lax.rsqrt(jnp.mean(xf * xf, axis=-1, keepdims=True) + EPS)
    return (y * g.astype(jnp.float32)).astype(x.dtype)


def _fox_block(qb, Fq, qpos, k, v, Fk, kpos):
    s = jnp.einsum('bqhd,bkhd->bhqk', qb, k, preferred_element_type=jnp.float32) * (ATTN_HEAD_DIM ** -0.5)
    s = s + jnp.transpose(Fq, (0, 2, 1))[..., None] - jnp.transpose(Fk, (0, 2, 1))[:, :, None, :]
    mask = kpos[None, :] <= qpos[:, None]
    s = jnp.where(mask[None, None], s, -jnp.inf)
    p = jax.nn.softmax(s, axis=-1)
    return jnp.einsum('bhqk,bkhd->bqhd', p.astype(v.dtype), v)


def forgetting_attention(q, k, v, log_f):
    b, L, H, hd = q.shape
    F = jnp.cumsum(log_f, axis=1)
    pos = jnp.arange(L)
    out_meta = _fox_block(q[:, :N_META], F[:, :N_META], pos[:N_META],
                          k[:, :N_META], v[:, :N_META], F[:, :N_META], pos[:N_META])
    n_blk = (L - N_META) // Q_BLOCK
    qr = q[:, N_META:].reshape(b, n_blk, Q_BLOCK, H, hd).transpose(1, 0, 2, 3, 4)
    Fr = F[:, N_META:].reshape(b, n_blk, Q_BLOCK, H).transpose(1, 0, 2, 3)
    qpos = (N_META + jnp.arange(L - N_META)).reshape(n_blk, Q_BLOCK)
    out_r = lax.map(lambda a: _fox_block(a[0], a[1], a[2], k, v, F, pos), (qr, Fr, qpos))
    out_r = out_r.transpose(1, 0, 2, 3, 4).reshape(b, L - N_META, H, hd)
    return jnp.concatenate([out_meta, out_r], axis=1)


def s5_ssm(u, lam_re, lam_im, log_dt, b_re, b_im, c_re, c_im, d_skip):
    bsz, L, _ = u.shape
    f32 = jnp.float32
    uf = u.astype(f32).reshape(bsz, L, SSM_GROUPS, SSM_GROUP)
    dt = jnp.exp(log_dt.astype(f32))[:, None]
    lr = lam_re.astype(f32)
    li = lam_im.astype(f32)
    mag = jnp.exp(lr * dt)
    a_re = mag * jnp.cos(li * dt)
    a_im = mag * jnp.sin(li * dt)
    den = lr * lr + li * li
    nr = a_re - 1.0
    z_re = (nr * lr + a_im * li) / den
    z_im = (a_im * lr - nr * li) / den
    br = b_re.astype(f32)
    bi = b_im.astype(f32)
    bb_re = z_re[..., None] * br - z_im[..., None] * bi
    bb_im = z_re[..., None] * bi + z_im[..., None] * br
    bu_re = jnp.einsum('gpc,blgc->blgp', bb_re, uf)
    bu_im = jnp.einsum('gpc,blgc->blgp', bb_im, uf)
    at_re = jnp.broadcast_to(a_re, (1, L, SSM_GROUPS, SSM_STATE))
    at_im = jnp.broadcast_to(a_im, (1, L, SSM_GROUPS, SSM_STATE))

    def combine(e1, e2):
        ar1, ai1, br1, bi1 = e1
        ar2, ai2, br2, bi2 = e2
        return (ar2 * ar1 - ai2 * ai1,
                ar2 * ai1 + ai2 * ar1,
                ar2 * br1 - ai2 * bi1 + br2,
                ar2 * bi1 + ai2 * br1 + bi2)

    _, _, h_re, h_im = lax.associative_scan(combine, (at_re, at_im, bu_re, bu_im), axis=1)
    y = (jnp.einsum('gcp,blgp->blgc', c_re.astype(f32), h_re)
         - jnp.einsum('gcp,blgp->blgc', c_im.astype(f32), h_im))
    y = y.reshape(bsz, L, D_SSM) + d_skip.astype(f32) * u.astype(f32)
    return y.astype(u.dtype)


def conv_ffn(x, w_up, conv_w, conv_b, w_down):
    gu = x @ w_up
    g, u = jnp.split(gu, 2, axis=-1)
    L = g.shape[1]
    gp = jnp.pad(g, ((0, 0), (CONV_WIDTH - 1, 0), (0, 0)))
    gc = conv_b + conv_w[0] * gp[:, 0:L]
    for j in range(1, CONV_WIDTH):
        gc = gc + conv_w[j] * gp[:, j:j + L]
    return (jax.nn.silu(gc) * u) @ w_down


def mixer(n, w_in, b_f, lam_re, lam_im, log_dt, b_re, b_im, c_re, c_im, d_skip, w_glu, w_attn_o, w_out):
    bsz, L, _ = n.shape
    z = n @ w_in
    q, k, v, f, u, ga, gb = jnp.split(z, IN_OFFSETS, axis=-1)
    q = q.reshape(bsz, L, ATTN_HEADS, ATTN_HEAD_DIM)
    k = k.reshape(bsz, L, ATTN_HEADS, ATTN_HEAD_DIM)
    v = v.reshape(bsz, L, ATTN_HEADS, ATTN_HEAD_DIM)
    log_f = jax.nn.log_sigmoid(f.astype(jnp.float32) + b_f.astype(jnp.float32))
    attn = forgetting_attention(q, k, v, log_f).reshape(bsz, L, D_ATTN) @ w_attn_o
    y = s5_ssm(u, lam_re, lam_im, log_dt, b_re, b_im, c_re, c_im, d_skip)
    ya, yb = jnp.split(jax.nn.gelu(y) @ w_glu, 2, axis=-1)
    ssm_out = ya * jax.nn.sigmoid(yb)
    merged = jax.nn.sigmoid(ga) * ssm_out + jax.nn.sigmoid(gb) * attn
    return merged @ w_out


def setup_inputs(seed: int = 0) -> dict:
    key = jax.random.key(seed)
    ks = jax.random.split(key, 24)
    nrm = lambda k, s, sc: jax.random.normal(k, s, jnp.float32) * sc
    Dp = DEPTH
    n_idx = jnp.arange(SSM_STATE, dtype=jnp.float32)
    return {
        "x": nrm(ks[0], (BATCH, SEQ, D_MODEL), 1.0),
        "meta": nrm(ks[1], (N_META, D_MODEL), 1.0),
        "g_mix": 1.0 + nrm(ks[2], (Dp, D_MODEL), 0.01),
        "w_in": nrm(ks[3], (Dp, D_MODEL, N_IN), D_MODEL ** -0.5),
        "b_f": jax.random.uniform(ks[4], (Dp, ATTN_HEADS), jnp.float32, 1.0, 6.0),
        "lam_re": -0.5 + nrm(ks[5], (Dp, SSM_GROUPS, SSM_STATE), 0.01),
        "lam_im": math.pi * n_idx + nrm(ks[6], (Dp, SSM_GROUPS, SSM_STATE), 0.01),
        "log_dt": jax.random.uniform(ks[7], (Dp, SSM_GROUPS), jnp.float32, math.log(1e-3), math.log(1e-1)),
        "b_re": nrm(ks[8], (Dp, SSM_GROUPS, SSM_STATE, SSM_GROUP), (2 * SSM_GROUP) ** -0.5),
        "b_im": nrm(ks[9], (Dp, SSM_GROUPS, SSM_STATE, SSM_GROUP), (2 * SSM_GROUP) ** -0.5),
        "c_re": nrm(ks[10], (Dp, SSM_GROUPS, SSM_GROUP, SSM_STATE), (2 * SSM_STATE) ** -0.5),
        "c_im": nrm(ks[11], (Dp, SSM_GROUPS, SSM_GROUP, SSM_STATE), (2 * SSM_STATE) ** -0.5),
        "d_skip": nrm(ks[12], (Dp, D_SSM), 1.0),
        "w_glu": nrm(ks[13], (Dp, D_SSM, 2 * D_MODEL), D_SSM ** -0.5),
        "w_attn_o": nrm(ks[14], (Dp, D_ATTN, D_MODEL), D_ATTN ** -0.5),
        "w_out": nrm(ks[15], (Dp, D_MODEL, D_MODEL), D_MODEL ** -0.5),
        "g_ffn": 1.0 + nrm(ks[16], (Dp, D_MODEL), 0.01),
        "w_up": nrm(ks[17], (Dp, D_MODEL, 2 * D_FF), D_MODEL ** -0.5),
        "conv_w": nrm(ks[18], (Dp, CONV_WIDTH, D_FF), CONV_WIDTH ** -0.5),
        "conv_b": nrm(ks[19], (Dp, D_FF), 0.01),
        "w_down": nrm(ks[20], (Dp, D_FF, D_MODEL), D_FF ** -0.5),
        "g_final": 1.0 + nrm(ks[21], (D_MODEL,), 0.01),
    }


def reference(x, meta, g_mix, w_in, b_f, lam_re, lam_im, log_dt, b_re, b_im, c_re, c_im, d_skip,
              w_glu, w_attn_o, w_out, g_ffn, w_up, conv_w, conv_b, w_down, g_final):
    bsz = x.shape[0]
    m = jnp.broadcast_to(meta.astype(x.dtype)[None], (bsz, N_META, D_MODEL))
    h = jnp.concatenate([m, x], axis=1)
    for l in range(DEPTH):
        n = rmsnorm(h, g_mix[l])
        h = h + mixer(n, w_in[l], b_f[l], lam_re[l], lam_im[l], log_dt[l], b_re[l], b_im[l],
                      c_re[l], c_im[l], d_skip[l], w_glu[l], w_attn_o[l], w_out[l])
        n2 = rmsnorm(h, g_ffn[l])
        h = h + conv_ffn(n2, w_up[l], conv_w[l], conv_b[l], w_down[l])
    return rmsnorm(h, g_final)[:, N_META:]
```

```cpp
#include <hip/hip_runtime.h>
#include <hip/hip_bf16.h>
#include <hip/hip_cooperative_groups.h>
#include <cstdio>
#include <cstdint>
namespace cg = cooperative_groups;
namespace pg8 {
#define PG8_LAS __attribute__((address_space(3)))
typedef unsigned short bf16_t;
typedef short bf16x8 __attribute__((ext_vector_type(8)));
typedef float f32x4 __attribute__((ext_vector_type(4)));
typedef unsigned u32x4 __attribute__((ext_vector_type(4)));
constexpr int BM = 256, BK = 64, HALF = 128, HTB = HALF * BK * 2  , STAGE_BYTES = 8 * HTB, NXCD = 8, WGM = 8;

__host__ __device__ __forceinline__ int lds_byte(int r, int c) { const int st = (r >> 4) * 2 + (c >> 5), rr = r & 15, cc = c & 31, ob = rr * 64 + cc * 2; return st * 1024 + (ob ^ (((ob >> 9) & 1) << 5)); }
__host__ __device__ __forceinline__ void stage_rc(int b, int& R, int& C) { const int st = b / 1024, sb = b % 1024, swz = sb ^ (((sb >> 9) & 1) << 5); R = (st >> 1) * 16 + swz / 64; C = (st & 1) * 32 + (swz % 64) / 2; }
__host__ __device__ __forceinline__ int perm32(int rho) { const int n = rho >> 4, i = rho & 15; return 8 * (i >> 2) + 4 * n + (i & 3); }

struct Unit { int pm, pn; };
struct Gemm { const bf16_t* A; const bf16_t* Bt; int M, N, K; };

struct StaticOrder {
    int nM, nN, nwg, G, c;
    __host__ __device__ void init(int M, int N, int G_, int c_) { nM = M / BM; nN = N / BM; nwg = nM * nN; G = G_; c = c_; }
    __host__ __device__ bool next(int i, Unit& u) const {
        const long L = (long)i * G + c; if (L >= nwg) return false;
        int wgid = (int)L; { const int q = nwg / NXCD, r = nwg % NXCD, xcd = wgid % NXCD, off = wgid / NXCD; wgid = (xcd < r ? xcd * (q + 1) : r * (q + 1) + (xcd - r) * q) + off; }
        const int nig = WGM * nN, gid = wgid / nig, fm = gid * WGM, gsz = (nM - fm) < WGM ? (nM - fm) : WGM;
        u.pm = fm + ((wgid % nig) % gsz); u.pn = (wgid % nig) / gsz; return true;
    }
    __device__ __forceinline__ void a_ready(const Unit&) const {}
    __device__ __forceinline__ void done(const Unit&) const {}
};

__device__ __forceinline__ unsigned cvt_pk_bf16(float lo, float hi) { unsigned r; asm volatile("v_cvt_pk_bf16_f32 %0, %1, %2" : "=v"(r) : "v"(lo), "v"(hi)); return r; }
typedef float f32x2 __attribute__((ext_vector_type(2)));
template <class Epi, class Sched, bool ALIGN_EPI = false, bool SP2 = false>
__device__ __forceinline__ void gemm_phase(PG8_LAS unsigned char* lds, const Gemm g, const Sched& S, const Epi& E) {
    const int tid = threadIdx.x, wid = __builtin_amdgcn_readfirstlane(tid >> 6), lane = tid & 63, wr = wid >> 2, wc = wid & 3, fr = lane & 15, fq = lane >> 4;
    const int K = g.K, nt = K / BK;
    unsigned voffA[2], voffB[2];
#pragma unroll
    for (int i = 0; i < 2; ++i) { int R, C; stage_rc(tid * 16 + i * 8192, R, C); const int Rb = Epi::PERM ? ((R & ~31) + perm32(R & 31)) : R;
        voffA[i] = (unsigned)(R * K + C) * 2u; voffB[i] = (unsigned)(Rb * K + C) * 2u; }
    const size_t kstep = (size_t)(BK * 2);
    const size_t hstep = (size_t)HALF * K * 2;
    const size_t tstep = 2 * hstep;
    const unsigned ldsw = (unsigned)wid * 1024u;
    const int aoff = lds_byte(wr * 64 + fr, fq * 8), boff = lds_byte(wc * 32 + fr, fq * 8);
#define PG8_SA(b, h) (((b) * 2 + (h)) * HTB)
#define PG8_SB(b, h) ((4 + (b) * 2 + (h)) * HTB)
#define PG8_STAGE(bufoff, gbase, voff) do { _Pragma("unroll") for (int _i = 0; _i < 2; ++_i) \
        __builtin_amdgcn_global_load_lds((const unsigned*)((const char*)(gbase) + (voff)[_i]), (PG8_LAS unsigned*)(lds + (bufoff) + ldsw + _i * 8192), 16, 0, 0); } while (0)
#define PG8_LDA(dst, b, h) do { _Pragma("unroll") for (int m = 0; m < 4; ++m) _Pragma("unroll") for (int k = 0; k < 2; ++k) dst[m][k] = *(const PG8_LAS bf16x8*)(lds + PG8_SA(b, h) + aoff + m * 2048 + k * 1024); } while (0)
#define PG8_LDB(dst, b, h) do { _Pragma("unroll") for (int n = 0; n < 2; ++n) _Pragma("unroll") for (int k = 0; k < 2; ++k) dst[n][k] = *(const PG8_LAS bf16x8*)(lds + PG8_SB(b, h) + boff + n * 2048 + k * 1024); } while (0)
#define PG8_MMA(ai, bj, At, Bt) do { __builtin_amdgcn_s_setprio(1); _Pragma("unroll") for (int m = 0; m < 4; ++m) _Pragma("unroll") for (int n = 0; n < 2; ++n) _Pragma("unroll") for (int k = 0; k < 2; ++k) \
        acc[ai][bj][m][n] = __builtin_amdgcn_mfma_f32_16x16x32_bf16(Bt[n][k], At[m][k], acc[ai][bj][m][n], 0, 0, 0); __builtin_amdgcn_s_setprio(0); } while (0)
#define PG8_WAIT_V(n) asm volatile("s_waitcnt vmcnt(" #n ")" ::: "memory")
#define PG8_WAIT_L(n) asm volatile("s_waitcnt lgkmcnt(" #n ")" ::: "memory")
#define PG8_BAR __builtin_amdgcn_s_barrier()
#define PG8_SCHED __builtin_amdgcn_sched_barrier(0)
    Unit cur, nxt; int ui = 0;
    if (!S.next(0, cur)) return;
    f32x4 acc[2][2][4][2];
#pragma unroll
    for (int a = 0; a < 2; ++a)
#pragma unroll
        for (int b = 0; b < 2; ++b)
#pragma unroll
            for (int m = 0; m < 4; ++m)
#pragma unroll
                for (int n = 0; n < 2; ++n) acc[a][b][m][n] = (f32x4){0.f, 0.f, 0.f, 0.f};
    bf16x8 At[4][2], B0[2][2], B1[2][2];
    const char* cA = (const char*)g.A + (size_t)cur.pm * tstep; const char* cB = (const char*)g.Bt + (size_t)cur.pn * tstep;
    S.a_ready(cur);
    if constexpr (SP2) {
        PG8_STAGE(PG8_SB(0, 0), cB, voffB); PG8_STAGE(PG8_SB(0, 1), cB + hstep, voffB); PG8_STAGE(PG8_SA(0, 0), cA, voffA); PG8_STAGE(PG8_SA(0, 1), cA + hstep, voffA);
        if (wr == 1) PG8_BAR;
        PG8_WAIT_V(2); PG8_BAR;
        PG8_STAGE(PG8_SB(1, 0), cB + kstep, voffB); PG8_STAGE(PG8_SA(1, 0), cA + kstep, voffA); PG8_STAGE(PG8_SB(1, 1), cB + hstep + kstep, voffB);
        PG8_WAIT_V(6); PG8_BAR;
    } else {
        PG8_STAGE(PG8_SB(0, 0), cB, voffB); PG8_STAGE(PG8_SA(0, 0), cA, voffA); PG8_STAGE(PG8_SB(0, 1), cB + hstep, voffB); PG8_STAGE(PG8_SA(0, 1), cA + hstep, voffA);
        if (wr == 1) PG8_BAR;
        PG8_WAIT_V(4); PG8_BAR;
        PG8_STAGE(PG8_SB(1, 0), cB + kstep, voffB); PG8_STAGE(PG8_SA(1, 0), cA + kstep, voffA); PG8_STAGE(PG8_SB(1, 1), cB + hstep + kstep, voffB);
        PG8_WAIT_V(6); PG8_BAR;
    }
    for (;;) {
        const bool has_next = S.next(ui + 1, nxt);
        const char* nA = has_next ? (const char*)g.A + (size_t)nxt.pm * tstep : cA; const char* nB = has_next ? (const char*)g.Bt + (size_t)nxt.pn * tstep : cB;
        for (int t = 0; t < nt; t += 2) {
            const bool last = (t == nt - 2);
            const char* a1 = cA + (size_t)(t + 1) * kstep;
            const char* a2 = last ? nA : cA + (size_t)(t + 2) * kstep; const char* b2 = last ? nB : cB + (size_t)(t + 2) * kstep;
            const char* a3 = a2 + kstep; const char* b3 = b2 + kstep;
            if (last && has_next) S.a_ready(nxt);
            if constexpr (SP2) {
            PG8_LDB(B0, 0, 0); PG8_LDB(B1, 0, 1); PG8_SCHED; PG8_LDA(At, 0, 0); PG8_STAGE(PG8_SA(1, 1), a1 + hstep, voffA);
            PG8_WAIT_V(8); PG8_WAIT_L(0); PG8_BAR; PG8_MMA(0, 0, At, B0); PG8_MMA(0, 1, At, B1); PG8_BAR; PG8_SCHED;
            PG8_LDA(At, 0, 1); PG8_STAGE(PG8_SB(0, 0), b2, voffB); PG8_STAGE(PG8_SB(0, 1), b2 + hstep, voffB); PG8_STAGE(PG8_SA(0, 0), a2, voffA);
            PG8_WAIT_V(8); PG8_WAIT_L(0); PG8_BAR; PG8_MMA(1, 0, At, B0); PG8_MMA(1, 1, At, B1); PG8_BAR; PG8_SCHED;
            PG8_LDB(B0, 1, 0); PG8_LDB(B1, 1, 1); PG8_SCHED; PG8_LDA(At, 1, 0); PG8_STAGE(PG8_SA(0, 1), a2 + hstep, voffA);
            PG8_WAIT_V(8); PG8_WAIT_L(0); PG8_BAR; PG8_MMA(0, 0, At, B0); PG8_MMA(0, 1, At, B1); PG8_BAR; PG8_SCHED;
            PG8_LDA(At, 1, 1); PG8_STAGE(PG8_SB(1, 0), b3, voffB); PG8_STAGE(PG8_SB(1, 1), b3 + hstep, voffB); PG8_STAGE(PG8_SA(1, 0), a3, voffA);
            PG8_WAIT_V(8); PG8_WAIT_L(0); PG8_BAR; PG8_MMA(1, 0, At, B0); PG8_MMA(1, 1, At, B1); PG8_BAR; PG8_SCHED;
            } else {
            PG8_LDB(B0, 0, 0); PG8_SCHED; PG8_LDA(At, 0, 0); PG8_STAGE(PG8_SA(1, 1), a1 + hstep, voffA);
            PG8_WAIT_L(8); PG8_BAR; PG8_WAIT_L(0); PG8_MMA(0, 0, At, B0); PG8_BAR; PG8_SCHED;
            PG8_LDB(B1, 0, 1); PG8_STAGE(PG8_SB(0, 0), b2, voffB);
            PG8_BAR; PG8_WAIT_L(0); PG8_MMA(0, 1, At, B1); PG8_BAR;
            PG8_LDA(At, 0, 1); PG8_STAGE(PG8_SA(0, 0), a2, voffA);
            PG8_BAR; PG8_WAIT_L(0); PG8_MMA(1, 0, At, B0); PG8_BAR; PG8_SCHED;
            PG8_STAGE(PG8_SB(0, 1), b2 + hstep, voffB);
            PG8_WAIT_V(6); PG8_BAR; PG8_MMA(1, 1, At, B1); PG8_BAR;
            PG8_LDB(B0, 1, 0); PG8_SCHED; PG8_LDA(At, 1, 0); PG8_STAGE(PG8_SA(0, 1), a2 + hstep, voffA);
            PG8_WAIT_L(8); PG8_BAR; PG8_WAIT_L(0); PG8_MMA(0, 0, At, B0); PG8_BAR; PG8_SCHED;
            PG8_LDB(B1, 1, 1); PG8_STAGE(PG8_SB(1, 0), b3, voffB);
            PG8_BAR; PG8_WAIT_L(0); PG8_MMA(0, 1, At, B1); PG8_BAR;
            PG8_LDA(At, 1, 1); PG8_STAGE(PG8_SA(1, 0), a3, voffA);
            PG8_BAR; PG8_WAIT_L(0); PG8_MMA(1, 0, At, B0); PG8_BAR; PG8_SCHED;
            PG8_STAGE(PG8_SB(1, 1), b3 + hstep, voffB);
            PG8_WAIT_V(6); PG8_BAR; PG8_MMA(1, 1, At, B1); PG8_BAR;
            }
        }
        if constexpr (ALIGN_EPI) { if (wr == 0) PG8_BAR; }
        if constexpr (!Epi::AFTER_DRAIN) { E(acc, cur, wr, wc, fr, fq); S.done(cur); }
        if (!has_next) break;
#pragma unroll
        for (int a = 0; a < 2; ++a)
#pragma unroll
            for (int b = 0; b < 2; ++b)
#pragma unroll
                for (int m = 0; m < 4; ++m)
#pragma unroll
                    for (int n = 0; n < 2; ++n) acc[a][b][m][n] = (f32x4){0.f, 0.f, 0.f, 0.f};
        cur = nxt; cA = nA; cB = nB; ++ui;
        if constexpr (ALIGN_EPI) { if (wr == 1) PG8_BAR; }
    }
    PG8_WAIT_V(0);
    if constexpr (!ALIGN_EPI) { if (wr == 0) PG8_BAR; }
    PG8_BAR;
    if constexpr (Epi::AFTER_DRAIN) { E.fused(acc, cur, wr, wc, fr, fq, lds, wid, lane); S.done(cur); }
#undef PG8_SA
#undef PG8_SB
#undef PG8_STAGE
#undef PG8_LDA
#undef PG8_LDB
#undef PG8_MMA
#undef PG8_WAIT_V
#undef PG8_WAIT_L
#undef PG8_BAR
#undef PG8_SCHED
}
}
namespace att {
constexpr int D = 128, RS = 1024;
constexpr float THR = 8.f; constexpr bool WSKIP = false;
constexpr float SCALE = 0.08838834764831845f;
constexpr int NW = 8, QBLK = 32, KVBLK = 64, QB = NW * QBLK;
constexpr int SHM_V = KVBLK * D * 2, SHM_K = KVBLK * D * 2;
constexpr int LDS_BYTES = 2 * SHM_V + 2 * SHM_K + NW * 64 * 4;

using bf16 = __hip_bfloat16;
typedef short bf16x8 __attribute__((ext_vector_type(8)));
typedef short s16x4 __attribute__((ext_vector_type(4)));
typedef float f32x16 __attribute__((ext_vector_type(16)));
typedef float f32x4 __attribute__((ext_vector_type(4)));
typedef unsigned u32x4 __attribute__((ext_vector_type(4)));
template <class A, class Bt> struct same_t { static constexpr bool v = false; };
template <class A> struct same_t<A, A> { static constexpr bool v = true; };

#define KSWZ(row, colB) ((row) * 256 + ((colB) ^ (((row) & 7) << 4)))
#define SBAR() __builtin_amdgcn_sched_barrier(0)
__device__ __forceinline__ int v_st(int k, int c) { const int kk = (k & ~0xC) | ((k & 4) << 1) | ((k & 8) >> 1); return ((kk >> 3) * 4 + (c >> 5)) * 512 + ((kk & 7) * 32 + (c & 31)) * 2; }
__device__ __forceinline__ int v_rd_base(int lane) { return ((lane & 3) << 3) | (((lane >> 2) & 3) << 6) | (((lane >> 4) & 1) << 5) | (((lane >> 5) & 1) << 8); }
constexpr int v_rd_off(int d0, int ks, int half) { return d0 * 512 + ks * 4096 + half * 2048; }
__device__ __forceinline__ int crow(int r, int hi) { return (r & 3) + 8 * (r >> 2) + 4 * hi; }
__device__ __forceinline__ unsigned cvtpk(float lo, float hi) {
    unsigned r; asm volatile("v_cvt_pk_bf16_f32 %0, %1, %2" : "=v"(r) : "v"(lo), "v"(hi)); return r;
}
__device__ __forceinline__ bf16x8 pack8(f32x4 a, f32x4 b) {
    u32x4 w = {cvtpk(a[0], a[1]), cvtpk(a[2], a[3]), cvtpk(b[0], b[1]), cvtpk(b[2], b[3])};
    return *reinterpret_cast<bf16x8*>(&w);
}
template <class T> __device__ __forceinline__ bf16x8 load8(const T* p) {
    if constexpr (same_t<T, float>::v) { return pack8(*(const f32x4*)p, *(const f32x4*)(p + 4)); }
    else { return *reinterpret_cast<const bf16x8*>(p); }
}
__device__ __forceinline__ void mask_tile(f32x16& p0, f32x16& p1, int dq, unsigned W) {
    const float NEG = -__builtin_inff();
#pragma unroll
    for (int r = 0; r < 16; ++r) {
        const int c = (r & 3) + 8 * (r >> 2);
        if ((unsigned)(dq - c) >= W) p0[r] = NEG;
        if ((unsigned)(dq - c - 32) >= W) p1[r] = NEG;
    }
}
__device__ __forceinline__ void partialSM(f32x16& p0, f32x16& p1, float& m_reg, float& mn, float& alpha) {
    float pmax = p0[0]; for (int r = 1; r < 16; ++r) pmax = fmaxf(pmax, p0[r]); for (int r = 0; r < 16; ++r) pmax = fmaxf(pmax, p1[r]);
    { auto rr = __builtin_amdgcn_permlane32_swap(__float_as_uint(pmax), __float_as_uint(pmax), false, false);
      pmax = fmaxf(__uint_as_float(rr[0]), __uint_as_float(rr[1])); }
    constexpr float C2 = 1.4426950408889634f * SCALE;
    if (__builtin_expect(__all((pmax - m_reg) * SCALE <= THR), 1)) { mn = m_reg; alpha = 1.f; }
    else { mn = fmaxf(m_reg, pmax); alpha = __builtin_amdgcn_exp2f((m_reg - mn) * C2); m_reg = mn; }
    const float mnL = -mn * C2;
    for (int r = 0; r < 16; ++r) p0[r] = fmaf(p0[r], C2, mnL); for (int r = 0; r < 16; ++r) p1[r] = fmaf(p1[r], C2, mnL);
    for (int r = 0; r < 16; ++r) p0[r] = __builtin_amdgcn_exp2f(p0[r]);
}
__device__ __forceinline__ void finishSM(f32x16& p0, f32x16& p1, float alpha, float& l_reg, bf16x8& pa0, bf16x8& pa1, bf16x8& pa2, bf16x8& pa3) {
    for (int r = 0; r < 16; ++r) p1[r] = __builtin_amdgcn_exp2f(p1[r]);
    float ps = 0; for (int r = 0; r < 16; ++r) ps += p0[r]; for (int r = 0; r < 16; ++r) ps += p1[r];
    { auto rr = __builtin_amdgcn_permlane32_swap(__float_as_uint(ps), __float_as_uint(ps), false, false);
      ps = __uint_as_float(rr[0]) + __uint_as_float(rr[1]); }
    l_reg = l_reg * alpha + ps;
#define PK4(P, B_, OUT) do { unsigned a0 = cvtpk(P[B_+0], P[B_+1]), a1 = cvtpk(P[B_+2], P[B_+3]);                          \
        unsigned b0 = cvtpk(P[B_+4], P[B_+5]), b1 = cvtpk(P[B_+6], P[B_+7]);                                             \
        auto r0 = __builtin_amdgcn_permlane32_swap(a0, b0, false, false); auto r1 = __builtin_amdgcn_permlane32_swap(a1, b1, false, false); \
        u32x4 w = {r0[0], r1[0], r0[1], r1[1]}; OUT = *reinterpret_cast<bf16x8*>(&w); } while (0)
    PK4(p0, 0, pa0); PK4(p0, 8, pa1); PK4(p1, 0, pa2); PK4(p1, 8, pa3);
#undef PK4
}
template <int KB, bool SK>
__device__ __forceinline__ void qkt(f32x16& p0, f32x16& p1, const char* K_lds, int r32, int hi, const bf16x8* qr, bool act, int bia) {
    if (SK && !act) { const float NEG = -__builtin_inff();
#pragma unroll
        for (int r = 0; r < 16; ++r) { p0[r] = NEG; p1[r] = NEG; } return; }
    {
#pragma unroll
        for (int g = 0; g < 4; ++g) { typedef const __attribute__((address_space(3))) f32x4* lp4; const f32x4 a = *(lp4)(uintptr_t)(unsigned)(bia + 32 * g), b = *(lp4)(uintptr_t)(unsigned)(bia + 128 + 32 * g);
            p0[4 * g] = a[0]; p0[4 * g + 1] = a[1]; p0[4 * g + 2] = a[2]; p0[4 * g + 3] = a[3];
            p1[4 * g] = b[0]; p1[4 * g + 1] = b[1]; p1[4 * g + 2] = b[2]; p1[4 * g + 3] = b[3]; } }
    const char* kb[4];
#pragma unroll
    for (int dd = 0; dd < 4; ++dd) kb[dd] = K_lds + KB * SHM_K + KSWZ(r32, (dd * 16 + hi * 8) * 2);
#pragma unroll
    for (int d0 = 0; d0 < 8; ++d0) { const char* a = kb[d0 & 3] + (d0 >> 2) * 128;
        bf16x8 b0 = *reinterpret_cast<const bf16x8*>(a);
        bf16x8 b1 = *reinterpret_cast<const bf16x8*>(a + 32 * 256);
        p0 = __builtin_amdgcn_mfma_f32_32x32x16_bf16(b0, qr[d0], p0, 0, 0, 0);
        p1 = __builtin_amdgcn_mfma_f32_32x32x16_bf16(b1, qr[d0], p1, 0, 0, 0); }
}
template <int VB, bool SK>
__device__ __forceinline__ void pv_tile(f32x16* o, int vb0, bf16x8 pa0, bf16x8 pa1, bf16x8 pa2, bf16x8 pa3, bool act) {
    if (SK && !act) return;
#define TRRD(dst, off) asm volatile("ds_read_b64_tr_b16 %0, %1 offset:%2" : "=&v"(dst) : "v"(vb0), "i"(off) : "memory")
#define PV_D0(d0) do { s16x4 l0, l1, l2, l3, h0, h1, h2, h3; constexpr int b_ = VB * SHM_V + v_rd_off(d0, 0, 0);     \
        TRRD(l0, b_); TRRD(h0, b_ + 2048); TRRD(l1, b_ + 4096); TRRD(h1, b_ + 6144); TRRD(l2, b_ + 8192); TRRD(h2, b_ + 10240); TRRD(l3, b_ + 12288); TRRD(h3, b_ + 14336); \
        asm volatile("s_waitcnt lgkmcnt(0)" ::: "memory"); SBAR();                 \
        o[d0] = __builtin_amdgcn_mfma_f32_32x32x16_bf16(pa0, (bf16x8){l0[0], l0[1], l0[2], l0[3], h0[0], h0[1], h0[2], h0[3]}, o[d0], 0, 0, 0);   \
        o[d0] = __builtin_amdgcn_mfma_f32_32x32x16_bf16(pa1, (bf16x8){l1[0], l1[1], l1[2], l1[3], h1[0], h1[1], h1[2], h1[3]}, o[d0], 0, 0, 0);   \
        o[d0] = __builtin_amdgcn_mfma_f32_32x32x16_bf16(pa2, (bf16x8){l2[0], l2[1], l2[2], l2[3], h2[0], h2[1], h2[2], h2[3]}, o[d0], 0, 0, 0);   \
        o[d0] = __builtin_amdgcn_mfma_f32_32x32x16_bf16(pa3, (bf16x8){l3[0], l3[1], l3[2], l3[3], h3[0], h3[1], h3[2], h3[3]}, o[d0], 0, 0, 0); } while (0)
    PV_D0(0); PV_D0(1); PV_D0(2); PV_D0(3);
#undef PV_D0
#undef TRRD
}

template <class TIn, class TOut> struct BlockRef { const TIn* Q; const TIn* K; const TIn* V; TOut* O; int P0; };
template <class TIn> struct Seam {
    bf16x8 qr[8];
    bf16x8 st_v0, st_v1, st_k0, st_k1; f32x4 sf0, sf1, sf2, sf3;
    f32x4 tq[16];
};
__device__ __forceinline__ int swa_jlo(int P0, int W) { const int lowk = P0 - W + 1; return lowk > 0 ? lowk / KVBLK : 0; }
#define ROW(p, k0, rr) ((p) + (size_t)((k0) + (rr)) * RS + sc)
#define VMW() asm volatile("s_waitcnt vmcnt(0)" ::: "memory")
#define VMWN(n) asm volatile("s_waitcnt vmcnt(%0)" :: "i"(n) : "memory")
#define SLOAD_H(Kp, Vp, k0) do { S.st_v0 = load8<TIn>(ROW(Vp, k0, sr)); S.st_v1 = load8<TIn>(ROW(Vp, k0, 32 + sr));              \
                         S.st_k0 = load8<TIn>(ROW(Kp, k0, sr)); S.st_k1 = load8<TIn>(ROW(Kp, k0, 32 + sr)); } while (0)
#define SWRITE_HK(bf) do { *(bf16x8*)(K_lds + (bf) * SHM_K + kws) = S.st_k0; *(bf16x8*)(K_lds + (bf) * SHM_K + kws + 32 * 256) = S.st_k1; } while (0)
#define SWRITE_HV(bf) do { *(bf16x8*)(V_lds + (bf) * SHM_V + vst0) = S.st_v0; *(bf16x8*)(V_lds + (bf) * SHM_V + vst1) = S.st_v1; } while (0)
#define SWRITE_H(bf) do { SWRITE_HV(bf); SWRITE_HK(bf); } while (0)
#define SLOAD_F(p, k0) do { S.sf0 = *(const f32x4*)ROW(p, k0, sr); S.sf1 = *(const f32x4*)(ROW(p, k0, sr) + 4);                \
                            S.sf2 = *(const f32x4*)ROW(p, k0, 32 + sr); S.sf3 = *(const f32x4*)(ROW(p, k0, 32 + sr) + 4); } while (0)
#define SWRITE_KF(bf) do { *(bf16x8*)(K_lds + (bf) * SHM_K + kws) = pack8(S.sf0, S.sf1); *(bf16x8*)(K_lds + (bf) * SHM_K + kws + 32 * 256) = pack8(S.sf2, S.sf3); } while (0)
#define SWRITE_VF(bf) do { *(bf16x8*)(V_lds + (bf) * SHM_V + vst0) = pack8(S.sf0, S.sf1); *(bf16x8*)(V_lds + (bf) * SHM_V + vst1) = pack8(S.sf2, S.sf3); } while (0)
template <class TIn, class TOut>
__device__ __forceinline__ void causal_swa_prime(const BlockRef<TIn, TOut>& cur, int W, char* lds, Seam<TIn>& S) {
    constexpr bool F32 = same_t<TIn, float>::v;
    const int tid = threadIdx.x, wid = __builtin_amdgcn_readfirstlane(tid >> 6), lane = tid & 63, r32 = lane & 31, hi = lane >> 5;
    const int sr = tid >> 4, sc = (tid & 15) * 8, kws = KSWZ(sr, sc * 2); char* K_lds = lds + 2 * SHM_V;
    const int kb0 = swa_jlo(cur.P0, W) * KVBLK;
    for (int d0 = 0; d0 < 8; ++d0) S.qr[d0] = load8<TIn>(cur.Q + (size_t)(wid * QBLK + r32) * RS + d0 * 16 + hi * 8);
    if constexpr (F32) { SLOAD_F((const float*)cur.K, kb0); VMW(); SWRITE_KF(0); SBAR(); SLOAD_F((const float*)cur.V, kb0); }
    else { SLOAD_H(cur.K, cur.V, kb0); VMW(); SWRITE_HK(0); }
    __syncthreads();
}
template <class TIn, class TOut>
__device__ __forceinline__ void causal_swa_block(const BlockRef<TIn, TOut>& cur, const BlockRef<TIn, TOut>& nxt, int skv, int W, char* lds, Seam<TIn>& S, const float* __restrict__ biasG) {
    constexpr bool F32 = same_t<TIn, float>::v;
    const int tid = threadIdx.x, wid = __builtin_amdgcn_readfirstlane(tid >> 6), lane = tid & 63, r32 = lane & 31, hi = lane >> 5;
    const int j_lo = swa_jlo(cur.P0, W);
    int j_hi = (cur.P0 + QB - 1) / KVBLK + 1; if (j_hi > skv / KVBLK) j_hi = skv / KVBLK;
    const int NT = j_hi - j_lo;
    {
        float* bl = (float*)(lds + LDS_BYTES);
        unsigned t0 = (unsigned)tid; asm volatile("" : "+v"(t0));
        for (unsigned i4 = t0; i4 < (unsigned)(j_hi * 16); i4 += 512u) *(f32x4*)(bl + 4u * i4) = *(const f32x4*)((const char*)biasG + 16u * i4);
        __syncthreads(); }
    const int biaL = (int)(uintptr_t)(lds + LDS_BYTES) + 16 * hi;
    const int kbn = swa_jlo(nxt.P0, W) * KVBLK;
    const int qlo = cur.P0 + wid * QBLK, qm = qlo + r32 - 4 * hi;
    char* V_lds = lds; char* K_lds = lds + 2 * SHM_V;
    float* ws = (float*)(lds + 2 * SHM_V + 2 * SHM_K) + wid * 64; float* li_l = ws, * al_l = ws + 32;
    float m_reg = -1e30f, l_reg = 0; f32x16 o[4] = {};
    const int sr = tid >> 4, sc = (tid & 15) * 8, vst0 = v_st(sr, sc), vst1 = v_st(32 + sr, sc), kws = KSWZ(sr, sc * 2);
    const int vb0 = (int)(uintptr_t)V_lds + v_rd_base(lane);
    const TIn* Kh = cur.K; const TIn* Vh = cur.V;
#define RESC(a) do { if (__any((a) < 1.f)) { if (hi == 0) al_l[r32] = (a); asm volatile("s_waitcnt lgkmcnt(0)" ::: "memory");              \
                     for (int d_ = 0; d_ < 4; ++d_) for (int r = 0; r < 16; ++r) o[d_][r] *= al_l[crow(r, hi)]; } } while (0)
#define KBASE(t) ((j_lo + (t)) * KVBLK)
#define ACT(t) (KBASE(t) <= qlo + QBLK - 1 && KBASE(t) + KVBLK - 1 >= qlo - W + 1)
#define MASKT(P0_, P1_, t) do { const int kb_ = KBASE(t); if ((!SK || ACT(t)) && (kb_ + KVBLK - 1 > qlo || kb_ <= qlo + QBLK - 1 - W)) mask_tile(P0_, P1_, qm - kb_, (unsigned)W); } while (0)
    constexpr int NQL = F32 ? 16 : 8;
    constexpr bool SK = WSKIP && !F32;
#define SEAM_K0() do { VMWN(NQL); if constexpr (F32) { SWRITE_KF(0); SBAR(); SLOAD_F((const float*)nxt.V, kbn); } else { SWRITE_HK(0); } SBAR(); } while (0)
    f32x16 pA0, pA1, pB0, pB1; float mnA, mnB, alA, alB; bf16x8 pa0, pa1, pa2, pa3;
    if constexpr (F32) { VMW(); SWRITE_VF(0); SBAR(); } else { SWRITE_HV(0); SBAR(); }
    if (NT > 1) { if constexpr (F32) SLOAD_F((const float*)Kh, KBASE(1)); else SLOAD_H(Kh, Vh, KBASE(1)); }
    SBAR(); qkt<0, SK>(pA0, pA1, K_lds, r32, hi, S.qr, ACT(0), biaL + 4 * KBASE(0));
    if constexpr (F32) { if (NT > 1) { VMW(); SWRITE_KF(1); SBAR(); SLOAD_F((const float*)Vh, KBASE(1)); } }
    MASKT(pA0, pA1, 0); partialSM(pA0, pA1, m_reg, mnA, alA);
    if (NT > 1) { VMW(); if constexpr (F32) { SWRITE_VF(1); SBAR(); if (NT > 2) SLOAD_F((const float*)Kh, KBASE(2)); } else SWRITE_H(1); }
    __syncthreads();
#define HALF_STEP(PX0, PX1, mnX, alX, PY0, PY1, alY, t, KB, VB, SB) do {                                                      \
        SBAR(); qkt<KB, SK>(PX0, PX1, K_lds, r32, hi, S.qr, ACT(t), biaL + 4 * KBASE(t));                                             \
        finishSM(PY0, PY1, alY, l_reg, pa0, pa1, pa2, pa3); SBAR();                                                           \
        if ((t) + 1 < NT) { if constexpr (F32) { VMW(); SWRITE_KF(SB); SBAR(); SLOAD_F((const float*)Vh, KBASE((t) + 1)); }  \
                            else { SLOAD_H(Kh, Vh, KBASE((t) + 1)); } SBAR(); }                                               \
        pv_tile<VB, SK>(o, vb0, pa0, pa1, pa2, pa3, ACT((t) - 1)); MASKT(PX0, PX1, (t)); partialSM(PX0, PX1, m_reg, mnX, alX);                                        \
        __syncthreads();                                                                                                      \
        if ((t) + 1 < NT) { VMW(); if constexpr (F32) { SWRITE_VF(SB); SBAR(); if ((t) + 2 < NT) SLOAD_F((const float*)Kh, KBASE((t) + 2)); } \
                            else { SWRITE_H(SB); } }                                                                          \
        RESC(alX); __syncthreads(); } while (0)
    for (int t = 1; t + 1 < NT; t += 2) {
        HALF_STEP(pB0, pB1, mnB, alB, pA0, pA1, alA, t, 1, 0, 0);
        HALF_STEP(pA0, pA1, mnA, alA, pB0, pB1, alB, t + 1, 0, 1, 1);
    }
    const bool even = (NT & 1) == 0;
    if (even) { SBAR(); qkt<1, SK>(pB0, pB1, K_lds, r32, hi, S.qr, ACT(NT - 1), biaL + 4 * KBASE(NT - 1)); SBAR(); }
#define QROW(e) (nxt.Q + (size_t)(wid * QBLK + r32) * RS + ((e) >> 1) * 16 + hi * 8 + ((e) & 1) * 4)
    if constexpr (F32) { SLOAD_F((const float*)nxt.K, kbn); SBAR();
#pragma unroll
        for (int e = 0; e < 8; ++e) S.tq[e] = *(const f32x4*)QROW(e); }
    else { SLOAD_H(nxt.K, nxt.V, kbn); SBAR();
#pragma unroll
        for (int d0 = 0; d0 < 8; ++d0) S.qr[d0] = load8<TIn>(nxt.Q + (size_t)(wid * QBLK + r32) * RS + d0 * 16 + hi * 8); }
    SBAR();
    finishSM(pA0, pA1, alA, l_reg, pa0, pa1, pa2, pa3); SBAR();
    if constexpr (F32) {
#pragma unroll
        for (int e = 8; e < 16; ++e) S.tq[e] = *(const f32x4*)QROW(e); SBAR(); }
#undef QROW
    pv_tile<0, SK>(o, vb0, pa0, pa1, pa2, pa3, ACT(even ? NT - 2 : NT - 1));
    if (even) { MASKT(pB0, pB1, NT - 1); partialSM(pB0, pB1, m_reg, mnB, alB); __syncthreads(); RESC(alB);
        finishSM(pB0, pB1, alB, l_reg, pa0, pa1, pa2, pa3); SBAR(); pv_tile<1, SK>(o, vb0, pa0, pa1, pa2, pa3, ACT(NT - 1)); }
    SBAR(); SEAM_K0();
    if (hi == 0) li_l[r32] = l_reg; asm volatile("s_waitcnt lgkmcnt(0)" ::: "memory");
    float rli[16];
#pragma unroll
    for (int r = 0; r < 16; ++r) rli[r] = __builtin_amdgcn_rcpf(li_l[crow(r, hi)]);
    TOut* Ow = cur.O + (size_t)(wid * QBLK) * RS;
#pragma unroll
    for (int r = 0; r < 16; ++r) { const int orow = crow(r, hi);
#pragma unroll
        for (int d0 = 0; d0 < 4; ++d0) { const float v = o[d0][r] * rli[r];
            if constexpr (same_t<TOut, float>::v) { Ow[(size_t)orow * RS + d0 * 32 + r32] = v; }
            else { const float vn = __shfl_xor(v, 1);
                   if ((r32 & 1) == 0) *(unsigned*)(Ow + (size_t)orow * RS + d0 * 32 + r32) = cvtpk(v, vn); } } }
    if constexpr (F32) {
#pragma unroll
        for (int d0 = 0; d0 < 8; ++d0) S.qr[d0] = pack8(S.tq[2 * d0], S.tq[2 * d0 + 1]); }
    __syncthreads();
#undef RESC
#undef KBASE
#undef ACT
#undef MASKT
#undef SEAM_K0
#undef HALF_STEP
}
#undef ROW
#undef VMW
#undef VMWN
#undef SLOAD_H
#undef SWRITE_HK
#undef SWRITE_HV
#undef SWRITE_H
#undef SLOAD_F
#undef SWRITE_KF
#undef SWRITE_VF
}
#ifndef MK_SPLIT
#define MK_SPLIT 0
#endif
#define LAS __attribute__((address_space(3)))
typedef unsigned short bf16_t;
typedef float v4f __attribute__((ext_vector_type(4)));
typedef float v2f __attribute__((ext_vector_type(2)));
typedef unsigned v4u __attribute__((ext_vector_type(4)));
typedef unsigned v2u __attribute__((ext_vector_type(2)));
typedef short h8 __attribute__((ext_vector_type(8)));

constexpr int DM = 2048, SEQ = 8192, NMETA = 16, NH = 8, HD = 128, DATT = 1024, DSSM = 1024, NG = 64, NP = 64, DFF = 5632, NIN = 8200;
constexpr int MREAL = 2 * SEQ;
constexpr int MROWS = MREAL + NMETA;
constexpr int RPAD = 16640;
constexpr int PPOS = 8256;
constexpr float EPS = 1e-6f;
constexpr float INV_SCALE = 11.313708498984761f;
constexpr int LDS_BYTES = 147456;

constexpr size_t MiB = 1u << 20;
constexpr size_t OFF_WT_UP = 0, OFF_WT_DOWN = 44 * MiB, OFF_WT_OUT = 66 * MiB, OFF_WT_IN = 74 * MiB, OFF_WT_O = 106 * MiB, OFF_WT_GLU = 110 * MiB;
constexpr size_t OFF_KT = 118 * MiB, OFF_WTS = 120 * MiB, OFF_VTS = 136 * MiB, OFF_MISC = 152 * MiB;
constexpr size_t OFF_GP = OFF_MISC, OFF_RSTD0 = OFF_MISC + 640 * 1024, OFF_SUMSQ1 = OFF_MISC + 768 * 1024, OFF_SUMSQ2 = OFF_MISC + 896 * 1024,
                 OFF_LF = OFF_MISC + 1024 * 1024, OFF_BIAS = OFF_MISC + 1664 * 1024;
constexpr size_t OFF_H0B = 156 * MiB, OFF_OB = 156 * MiB, OFF_YG = OFF_OB + (size_t)RPAD * 1024 * 2;
constexpr size_t OFF_Q = 221 * MiB, OFF_K = 254 * MiB, OFF_V = 287 * MiB, OFF_UB = 320 * MiB, OFF_SGA = 353 * MiB, OFF_SGB = 418 * MiB;
constexpr size_t OFF_M1 = 221 * MiB, OFF_MERGED = 286 * MiB, OFF_H1B = 74 * MiB, OFF_G = 156 * MiB, OFF_U = 333 * MiB;
constexpr size_t WS_NEED = OFF_U + (size_t)MROWS * DFF * 2;
static_assert(WS_NEED <= 512 * MiB, "ws map");
static_assert(OFF_YG + (size_t)RPAD * 1024 * 2 <= OFF_Q && OFF_G + (size_t)MROWS * DFF * 2 <= OFF_U, "ws map 2");

struct Args { const float* in[22]; float* out; unsigned char* ws; int ph_lo, ph_hi; };
static_assert(sizeof(Args) == 22 * 8 + 8 + 8 + 8, "no padding");
enum { I_X = 0, I_META, I_GMIX, I_WIN, I_BF, I_LRE, I_LIM, I_LOGDT, I_BRE, I_BIM, I_CRE, I_CIM, I_DSKIP, I_WGLU, I_WATTO, I_WOUT, I_GFFN, I_WUP, I_CONVW, I_CONVB, I_WDOWN, I_GFINAL };

__device__ __forceinline__ float bf2f(unsigned short h) { return __uint_as_float((unsigned)h << 16); }
__device__ __forceinline__ float bflo(unsigned w) { return __uint_as_float(w << 16); }
__device__ __forceinline__ float bfhi(unsigned w) { return __uint_as_float(w & 0xffff0000u); }
__device__ __forceinline__ unsigned pk2(float lo, float hi) { return pg8::cvt_pk_bf16(lo, hi); }
__device__ __forceinline__ float sigmoidf_(float x) { return __builtin_amdgcn_rcpf(1.f + __expf(-x)); }
__device__ __forceinline__ float gelu_tanh(float x) { const float u = 0.7978845608028654f * (x + 0.044715f * x * x * x); return x * sigmoidf_(2.f * u); }
__device__ __forceinline__ float wave_sum(float v) {
#pragma unroll
    for (int o = 1; o < 64; o <<= 1) v += __shfl_xor(v, o);
    return v;
}
#define LDS_WAIT() asm volatile("s_waitcnt lgkmcnt(0)" ::: "memory")
#if defined(__HIP_DEVICE_COMPILE__)
#define KARG_PTR(p_) unsigned long long p_ = (unsigned long long)__builtin_amdgcn_kernarg_segment_ptr(); asm volatile("" : "+s"(p_))
#define LOAD_ARGS(name) Args name; { KARG_PTR(p_); name = *(const __attribute__((address_space(4))) Args*)p_; } unsigned char* ws = name.ws
__device__ __forceinline__ bool ph_in(int k) { KARG_PTR(p_); const __attribute__((address_space(4))) Args* q = (const __attribute__((address_space(4))) Args*)p_; return q->ph_lo <= k && k < q->ph_hi; }
#else
#define LOAD_ARGS(name) Args name{}; unsigned char* ws = name.ws
__device__ __forceinline__ bool ph_in(int k) { return false; }
#endif

__device__ __forceinline__ void tr_item(const float* __restrict__ W, int K, int Nsrc, int nsrc0, bf16_t* __restrict__ WT, int ndst0, int k0, const float* __restrict__ ksc, LAS float* scr, int lane) {
#pragma unroll 8
    for (int i = 0; i < 32; ++i) { const int kk = 2 * i + (lane >> 5); float v = W[(size_t)(k0 + kk) * Nsrc + nsrc0 + (lane & 31)]; if (ksc) v *= ksc[k0 + kk]; scr[kk * 33 + (lane & 31)] = v; }
    LDS_WAIT(); asm volatile("" ::: "memory");
    const int c = lane & 7;
#pragma unroll
    for (int j = 0; j < 4; ++j) { const int n = (lane >> 3) + 8 * j; const LAS float* s = scr + (8 * c) * 33 + n;
        v4u o; o.x = pk2(s[0 * 33], s[1 * 33]); o.y = pk2(s[2 * 33], s[3 * 33]); o.z = pk2(s[4 * 33], s[5 * 33]); o.w = pk2(s[6 * 33], s[7 * 33]);
        *(v4u*)(WT + (size_t)(ndst0 + n) * K + k0 + 8 * c) = o; }
    LDS_WAIT(); asm volatile("" ::: "memory");
}
__device__ __forceinline__ int ilv_src(int n, int half) { const int t = n >> 8, w = n & 255; return w < 128 ? 128 * t + w : half + 128 * t + (w - 128); }

__device__ __forceinline__ void p0_transposes(const Args& a, LAS unsigned char* lds, int gw, int NGW, int wid, int lane) {
    LAS float* scr = (LAS float*)(lds + wid * 8448);
    unsigned char* ws = a.ws;
    constexpr int I_IN = (DM / 64) * (8192 / 32), I_O = (DATT / 64) * (DM / 32), I_GLU = (DSSM / 64) * (4096 / 32), I_OUT = (DM / 64) * (DM / 32), I_UP = (DM / 64) * (2 * DFF / 32), I_DN = (DFF / 64) * (DM / 32);
    constexpr int NIT = I_IN + I_O + I_GLU + I_OUT + I_UP + I_DN;
    for (int it = gw; it < NIT; it += NGW) {
        int r = it;
        if (r < I_UP) { const int nb = r % (2 * DFF / 32), kb = r / (2 * DFF / 32), nd = 32 * nb; tr_item(a.in[I_WUP], DM, 2 * DFF, ilv_src(nd, DFF), (bf16_t*)(ws + OFF_WT_UP), nd, 64 * kb, a.in[I_GFFN], scr, lane); continue; } r -= I_UP;
        if (r < I_IN) { const int nb = r % 256, kb = r / 256, nd = 32 * nb; tr_item(a.in[I_WIN], DM, NIN, nd < 3072 ? nd : nd + 8, (bf16_t*)(ws + OFF_WT_IN), nd, 64 * kb, a.in[I_GMIX], scr, lane); continue; } r -= I_IN;
        if (r < I_DN) { const int nb = r % 64, kb = r / 64; tr_item(a.in[I_WDOWN], DFF, DM, 32 * nb, (bf16_t*)(ws + OFF_WT_DOWN), 32 * nb, 64 * kb, nullptr, scr, lane); continue; } r -= I_DN;
        if (r < I_GLU) { const int nb = r % 128, kb = r / 128, nd = 32 * nb; tr_item(a.in[I_WGLU], DSSM, 4096, ilv_src(nd, 2048), (bf16_t*)(ws + OFF_WT_GLU), nd, 64 * kb, nullptr, scr, lane); continue; } r -= I_GLU;
        if (r < I_OUT) { const int nb = r % 64, kb = r / 64; tr_item(a.in[I_WOUT], DM, DM, 32 * nb, (bf16_t*)(ws + OFF_WT_OUT), 32 * nb, 64 * kb, nullptr, scr, lane); continue; } r -= I_OUT;
        { const int nb = r % 64, kb = r / 64; tr_item(a.in[I_WATTO], DATT, DM, 32 * nb, (bf16_t*)(ws + OFF_WT_O), 32 * nb, 64 * kb, nullptr, scr, lane); }
    }
}

constexpr int WF_OFF = 69632;
__device__ __forceinline__ void p0_rows(const Args& a, LAS unsigned char* lds, int gw, int NGW, int lane) {
    unsigned char* ws = a.ws;
    LAS float* wf = (LAS float*)(lds + WF_OFF);
    bf16_t* H0B = (bf16_t*)(ws + OFF_H0B); float* RSTD0 = (float*)(ws + OFF_RSTD0); float* LF = (float*)(ws + OFF_LF);
    const float* bfp = a.in[I_BF];
    for (int r = gw; r < RPAD; r += NGW) {
        v2u* o8 = (v2u*)(H0B + (size_t)r * DM) + lane;
        if (r >= MROWS) {
#pragma unroll
            for (int j = 0; j < 8; ++j) o8[64 * j] = (v2u){0u, 0u};
            if (lane == 0) RSTD0[r] = 0.f;
            continue;
        }
        const float* src = r < MREAL ? a.in[I_X] + (size_t)r * DM : a.in[I_META] + (size_t)(r - MREAL) * DM;
        const v4f* xr = (const v4f*)src + lane;
        v4f v[8]; float s2 = 0.f;
#pragma unroll
        for (int j = 0; j < 8; ++j) { v[j] = xr[64 * j]; s2 += (v[j].x * v[j].x + v[j].y * v[j].y) + (v[j].z * v[j].z + v[j].w * v[j].w); }
        float f[8];
#pragma unroll
        for (int h = 0; h < 8; ++h) { float acc = 0.f;
#pragma unroll
            for (int j = 0; j < 8; ++j) { const v4f w = *(const LAS v4f*)(wf + h * 2048 + 256 * j + 4 * lane); acc += (v[j].x * w.x + v[j].y * w.y) + (v[j].z * w.z + v[j].w * w.w); }
            f[h] = acc; }
        s2 = wave_sum(s2);
        const float rstd = 1.0f / sqrtf(s2 * (1.f / DM) + EPS);
#pragma unroll
        for (int h = 0; h < 8; ++h) f[h] = wave_sum(f[h]);
#pragma unroll
        for (int j = 0; j < 8; ++j) o8[64 * j] = (v2u){pk2(v[j].x, v[j].y), pk2(v[j].z, v[j].w)};
        if (lane == 0) RSTD0[r] = rstd;
        if (lane < 8) {
            float fv = f[0];
#pragma unroll
            for (int h = 1; h < 8; ++h) fv = (lane == h) ? f[h] : fv;
            const float y = fv * rstd + bfp[lane];
            const float lf = fminf(y, 0.f) - log1pf(__expf(-fabsf(y)));
            if (r < MREAL) { const int b = r >> 13, i = r & 8191; LF[(size_t)(b * 8 + lane) * PPOS + 64 + i] = lf; }
            else { const int j = r - MREAL; LF[(size_t)lane * PPOS + 48 + j] = lf; LF[(size_t)(8 + lane) * PPOS + 48 + j] = lf; }
        }
    }
}

__device__ __forceinline__ void ssm_gen(LAS unsigned char* lds, int g, int tid) {
    LAS float* TBr = (LAS float*)lds; LAS float* TBi = TBr + 65 * 64; LAS float* BBr = TBi + 65 * 64; LAS float* BBi = BBr + 1024; LAS float* CTr = BBi + 1024; LAS float* CTi = CTr + 1024;
    { LOAD_ARGS(a); float* GP = (float*)(ws + OFF_GP) + (size_t)g * 2304;
      const double dt = exp((double)a.in[I_LOGDT][g]);
#pragma unroll 1
      for (int e = tid; e < 65 * 64; e += 512) { const int j = e >> 6, p = e & 63;
        const double lr = (double)a.in[I_LRE][g * 64 + p], li = (double)a.in[I_LIM][g * 64 + p];
        const double mag = exp(lr * dt * (double)j); double sn, cs; sincos(li * dt * (double)j, &sn, &cs);
        TBr[e] = (float)(mag * cs); TBi[e] = (float)(mag * sn);
        if (j == 1) { GP[p] = (float)(mag * cs); GP[64 + p] = (float)(mag * sn); }
        if (j == 64) { GP[128 + p] = (float)(mag * cs); GP[192 + p] = (float)(mag * sn); } } }
    { LOAD_ARGS(a); float* GP = (float*)(ws + OFF_GP) + (size_t)g * 2304;
      const double dt = exp((double)a.in[I_LOGDT][g]);
#pragma unroll 1
      for (int e = tid; e < 1024; e += 512) { const int p = e >> 4;
        const double lr = (double)a.in[I_LRE][g * 64 + p], li = (double)a.in[I_LIM][g * 64 + p];
        const double mag = exp(lr * dt); double sn, cs; sincos(li * dt, &sn, &cs);
        const double are = mag * cs, aim = mag * sn, den = lr * lr + li * li, nr = are - 1.0;
        const double zr = (nr * lr + aim * li) / den, zi = (aim * lr - nr * li) / den;
        const double br = (double)a.in[I_BRE][(size_t)g * 1024 + e], bi = (double)a.in[I_BIM][(size_t)g * 1024 + e];
        const float bbr = (float)(zr * br - zi * bi), bbi = (float)(zr * bi + zi * br);
        BBr[e] = bbr; BBi[e] = bbi; GP[256 + e] = bbr; GP[1280 + e] = bbi; } }
    { LOAD_ARGS(a); (void)ws;
#pragma unroll 1
      for (int e = tid; e < 1024; e += 512) { const int co = e >> 6, p = e & 63;
        CTr[p * 16 + co] = a.in[I_CRE][(size_t)g * 1024 + e]; CTi[p * 16 + co] = a.in[I_CIM][(size_t)g * 1024 + e]; } }
    __syncthreads();
    { LOAD_ARGS(a); (void)a; bf16_t* KT = (bf16_t*)(ws + OFF_KT) + (size_t)g * 16384;
#pragma unroll 1
      for (int o = tid; o < 16384; o += 512) { const int j = o >> 8, co = (o >> 4) & 15, ci = o & 15; float acc = 0.f;
#pragma unroll 4
        for (int p = 0; p < 64; ++p) { const float tr = TBr[j * 64 + p], ti = TBi[j * 64 + p], br = BBr[p * 16 + ci], bi = BBi[p * 16 + ci];
            const float mr = tr * br - ti * bi, mi = tr * bi + ti * br; acc += CTr[p * 16 + co] * mr - CTi[p * 16 + co] * mi; }
        KT[o] = (bf16_t)(pk2(acc, 0.f) & 0xffffu); } }
    { LOAD_ARGS(a); (void)a; bf16_t* WTS = (bf16_t*)(ws + OFF_WTS) + (size_t)g * 131072;
#pragma unroll 1
      for (int it = tid; it < 16384; it += 512) { const int n = it >> 7, k8 = it & 127, p = n >> 1, ri = n & 1, s = k8 >> 1, c0 = (k8 & 1) * 8;
        const float tr = TBr[(63 - s) * 64 + p], ti = TBi[(63 - s) * 64 + p]; float v[8];
#pragma unroll
        for (int e = 0; e < 8; ++e) { const float br = BBr[p * 16 + c0 + e], bi = BBi[p * 16 + c0 + e]; v[e] = ri ? (tr * bi + ti * br) : (tr * br - ti * bi); }
        *(v4u*)(WTS + (size_t)n * 1024 + 8 * k8) = (v4u){pk2(v[0], v[1]), pk2(v[2], v[3]), pk2(v[4], v[5]), pk2(v[6], v[7])}; } }
    { LOAD_ARGS(a); (void)a; bf16_t* VTS = (bf16_t*)(ws + OFF_VTS) + (size_t)g * 131072;
#pragma unroll 1
      for (int it = tid; it < 16384; it += 512) { const int n = it >> 4, k8 = it & 15, t = n >> 4, co = n & 15; float v[8];
#pragma unroll
        for (int e = 0; e < 4; ++e) { const int p = 4 * k8 + e; const float tr = TBr[(t + 1) * 64 + p], ti = TBi[(t + 1) * 64 + p], cr = CTr[p * 16 + co], ci = CTi[p * 16 + co];
            v[2 * e] = cr * tr - ci * ti; v[2 * e + 1] = -(cr * ti + ci * tr); }
        *(v4u*)(VTS + (size_t)n * 128 + 8 * k8) = (v4u){pk2(v[0], v[1]), pk2(v[2], v[3]), pk2(v[4], v[5]), pk2(v[6], v[7])}; } }
    __syncthreads();
}

__device__ __forceinline__ void cumsum_seq(const Args& a, LAS unsigned char* lds, int seq, int tid) {
    const float* LF = (const float*)(a.ws + OFF_LF) + (size_t)seq * PPOS; float* BI = (float*)(a.ws + OFF_BIAS) + (size_t)seq * PPOS;
    LAS float* wsum = (LAS float*)lds;
    const int base = 48 + 17 * tid; float s = 0.f;
    for (int i = 0; i < 17; ++i) { if (base + i < PPOS) s += LF[base + i]; }
    float inc = s;
#pragma unroll
    for (int o = 1; o < 64; o <<= 1) { const float t = __shfl_up(inc, o); if ((tid & 63) >= o) inc += t; }
    if ((tid & 63) == 63) wsum[tid >> 6] = inc;
    __syncthreads();
    float off = 0.f;
    for (int w = 0; w < (tid >> 6); ++w) off += wsum[w];
    float run = off + inc - s;
    for (int i = 0; i < 17; ++i) { if (base + i < PPOS) { run += LF[base + i]; BI[base + i] = -run * INV_SCALE; } }
    if (tid < 48) BI[tid] = -__builtin_inff();
    __syncthreads();
}

struct EpiZ {
    static constexpr bool PERM = true, AFTER_DRAIN = false;
    const float* rstd; bf16_t *Q, *K, *V, *U, *SGA, *SGB;
    __device__ __forceinline__ void operator()(const pg8::f32x4 (&acc)[2][2][4][2], const pg8::Unit& u, int wr, int wc, int fr, int fq) const {
        const int pn = u.pn, sec = pn < 16 ? (pn >> 2) : (pn < 24 ? 4 : 5), colt = (pn < 16 ? (pn & 3) : (pn & 7)) * 256 + wc * 32 + 8 * fq;
        bf16_t* base = sec == 0 ? Q : (sec == 1 ? K : (sec == 2 ? V : (sec == 3 ? U : (sec == 4 ? SGA : SGB))));
        const int ld = sec >= 4 ? 2048 : 1024; const bool pos = sec >= 1 && sec <= 3, sg = sec >= 4;
#pragma unroll
        for (int ai = 0; ai < 2; ++ai)
#pragma unroll
            for (int m = 0; m < 4; ++m) { const int row = u.pm * 256 + ai * 128 + wr * 64 + m * 16 + fr; const float rs = rstd[row];
                int d1 = row, d2 = -1;
                if (pos) { const int j = row - MREAL; d1 = j < 0 ? (row >> 13) * PPOS + 64 + (row & 8191) : (j < NMETA ? 48 + j : -1); d2 = (j >= 0 && j < NMETA) ? PPOS + 48 + j : -1; }
#pragma unroll
                for (int bj = 0; bj < 2; ++bj) { const int col = colt + bj * 128; pg8::f32x4 v0 = acc[ai][bj][m][0] * rs, v1 = acc[ai][bj][m][1] * rs;
                    if (sg) { v0[0] = sigmoidf_(v0[0]); v0[1] = sigmoidf_(v0[1]); v0[2] = sigmoidf_(v0[2]); v0[3] = sigmoidf_(v0[3]); v1[0] = sigmoidf_(v1[0]); v1[1] = sigmoidf_(v1[1]); v1[2] = sigmoidf_(v1[2]); v1[3] = sigmoidf_(v1[3]); }
                    const v4u w = {pk2(v0[0], v0[1]), pk2(v0[2], v0[3]), pk2(v1[0], v1[1]), pk2(v1[2], v1[3])};
                    if (d1 >= 0) *(v4u*)(base + (size_t)d1 * ld + col) = w;
                    if (d2 >= 0) *(v4u*)(base + (size_t)d2 * ld + col) = w; } }
    }
};
__device__ __forceinline__ void unpack8(const v4u w, float (&f)[8]) { f[0] = bflo(w.x); f[1] = bfhi(w.x); f[2] = bflo(w.y); f[3] = bfhi(w.y); f[4] = bflo(w.z); f[5] = bfhi(w.z); f[6] = bflo(w.w); f[7] = bfhi(w.w); }
struct EpiO {
    static constexpr bool PERM = true, AFTER_DRAIN = false;
    const bf16_t* SGB; bf16_t* M1;
    __device__ __forceinline__ void operator()(const pg8::f32x4 (&acc)[2][2][4][2], const pg8::Unit& u, int wr, int wc, int fr, int fq) const {
#pragma unroll
        for (int ai = 0; ai < 2; ++ai)
#pragma unroll
            for (int m = 0; m < 4; ++m) { const int row = u.pm * 256 + ai * 128 + wr * 64 + m * 16 + fr;
#pragma unroll
                for (int bj = 0; bj < 2; ++bj) { const size_t off = (size_t)row * 2048 + u.pn * 256 + bj * 128 + wc * 32 + 8 * fq; float s[8]; unpack8(*(const v4u*)(SGB + off), s);
                    const pg8::f32x4 v0 = acc[ai][bj][m][0], v1 = acc[ai][bj][m][1];
                    *(v4u*)(M1 + off) = (v4u){pk2(v0[0] * s[0], v0[1] * s[1]), pk2(v0[2] * s[2], v0[3] * s[3]), pk2(v1[0] * s[4], v1[1] * s[5]), pk2(v1[2] * s[6], v1[3] * s[7])}; } }
    }
};
struct EpiGlu {
    static constexpr bool PERM = true, AFTER_DRAIN = false;
    const bf16_t* SGA; const bf16_t* M1; bf16_t* MG;
    __device__ __forceinline__ void operator()(const pg8::f32x4 (&acc)[2][2][4][2], const pg8::Unit& u, int wr, int wc, int fr, int fq) const {
#pragma unroll
        for (int ai = 0; ai < 2; ++ai)
#pragma unroll
            for (int m = 0; m < 4; ++m) { const int row = u.pm * 256 + ai * 128 + wr * 64 + m * 16 + fr; const size_t off = (size_t)row * 2048 + u.pn * 128 + wc * 32 + 8 * fq;
                float ga[8], m1[8], o[8]; unpack8(*(const v4u*)(SGA + off), ga); unpack8(*(const v4u*)(M1 + off), m1);
#pragma unroll
                for (int e = 0; e < 8; ++e) { const float ya = acc[ai][0][m][e >> 2][e & 3], yb = acc[ai][1][m][e >> 2][e & 3]; o[e] = m1[e] + ga[e] * ya * sigmoidf_(yb); }
                *(v4u*)(MG + off) = (v4u){pk2(o[0], o[1]), pk2(o[2], o[3]), pk2(o[4], o[5]), pk2(o[6], o[7])}; }
    }
};
struct EpiOut {
    static constexpr bool PERM = true, AFTER_DRAIN = false;
    const float* X; const float* META; float* OUT; bf16_t* H1B; float* SS;
    __device__ __forceinline__ void operator()(const pg8::f32x4 (&acc)[2][2][4][2], const pg8::Unit& u, int wr, int wc, int fr, int fq) const {
#pragma unroll
        for (int ai = 0; ai < 2; ++ai)
#pragma unroll
            for (int m = 0; m < 4; ++m) { const int row = u.pm * 256 + ai * 128 + wr * 64 + m * 16 + fr; float ss = 0.f;
                const float* h0 = row < MREAL ? X + (size_t)row * DM : (row < MROWS ? META + (size_t)(row - MREAL) * DM : nullptr);
#pragma unroll
                for (int bj = 0; bj < 2; ++bj) { const int col = u.pn * 256 + bj * 128 + wc * 32 + 8 * fq; pg8::f32x4 v0 = acc[ai][bj][m][0], v1 = acc[ai][bj][m][1];
                    if (h0) { v0 += *(const pg8::f32x4*)(h0 + col); v1 += *(const pg8::f32x4*)(h0 + col + 4); }
                    if (row < MREAL) { *(pg8::f32x4*)(OUT + (size_t)row * DM + col) = v0; *(pg8::f32x4*)(OUT + (size_t)row * DM + col + 4) = v1; }
                    *(v4u*)(H1B + (size_t)row * DM + col) = (v4u){pk2(v0[0], v0[1]), pk2(v0[2], v0[3]), pk2(v1[0], v1[1]), pk2(v1[2], v1[3])};
                    ss += (v0[0] * v0[0] + v0[1] * v0[1]) + (v0[2] * v0[2] + v0[3] * v0[3]) + (v1[0] * v1[0] + v1[1] * v1[1]) + (v1[2] * v1[2] + v1[3] * v1[3]); }
                ss += __shfl_xor(ss, 16); ss += __shfl_xor(ss, 32);
                if (fq == 0) atomicAdd(SS + row, ss); }
    }
};
struct EpiUp {
    static constexpr bool PERM = true, AFTER_DRAIN = false;
    const float* SS; bf16_t* G; bf16_t* U;
    __device__ __forceinline__ void operator()(const pg8::f32x4 (&acc)[2][2][4][2], const pg8::Unit& u, int wr, int wc, int fr, int fq) const {
#pragma unroll
        for (int ai = 0; ai < 2; ++ai)
#pragma unroll
            for (int m = 0; m < 4; ++m) { const int row = u.pm * 256 + ai * 128 + wr * 64 + m * 16 + fr; if (row >= MROWS) continue;
                const float rs = 1.0f / sqrtf(SS[row] * (1.f / DM) + EPS); const size_t off = (size_t)row * DFF + u.pn * 128 + wc * 32 + 8 * fq;
                const pg8::f32x4 g0 = acc[ai][0][m][0] * rs, g1 = acc[ai][0][m][1] * rs, u0 = acc[ai][1][m][0] * rs, u1 = acc[ai][1][m][1] * rs;
                *(v4u*)(G + off) = (v4u){pk2(g0[0], g0[1]), pk2(g0[2], g0[3]), pk2(g1[0], g1[1]), pk2(g1[2], g1[3])};
                *(v4u*)(U + off) = (v4u){pk2(u0[0], u0[1]), pk2(u0[2], u0[3]), pk2(u1[0], u1[1]), pk2(u1[2], u1[3])}; }
    }
};
struct EpiDown {
    static constexpr bool PERM = true, AFTER_DRAIN = false;
    float* OUT; float* SS;
    __device__ __forceinline__ void operator()(const pg8::f32x4 (&acc)[2][2][4][2], const pg8::Unit& u, int wr, int wc, int fr, int fq) const {
#pragma unroll
        for (int ai = 0; ai < 2; ++ai)
#pragma unroll
            for (int m = 0; m < 4; ++m) { const int row = u.pm * 256 + ai * 128 + wr * 64 + m * 16 + fr; float ss = 0.f;
#pragma unroll
                for (int bj = 0; bj < 2; ++bj) { float* p = OUT + (size_t)row * DM + u.pn * 256 + bj * 128 + wc * 32 + 8 * fq;
                    const pg8::f32x4 v0 = acc[ai][bj][m][0] + *(const pg8::f32x4*)p, v1 = acc[ai][bj][m][1] + *(const pg8::f32x4*)(p + 4);
                    *(pg8::f32x4*)p = v0; *(pg8::f32x4*)(p + 4) = v1;
                    ss += (v0[0] * v0[0] + v0[1] * v0[1]) + (v0[2] * v0[2] + v0[3] * v0[3]) + (v1[0] * v1[0] + v1[1] * v1[1]) + (v1[2] * v1[2] + v1[3] * v1[3]); }
                ss += __shfl_xor(ss, 16); ss += __shfl_xor(ss, 32);
                if (fq == 0) atomicAdd(SS + row, ss); }
    }
};

#define MFMA16(a, b, c) __builtin_amdgcn_mfma_f32_16x16x32_bf16(a, b, c, 0, 0, 0)
constexpr int SS_KT = 0, SS_S = 32768, SS_SROW = 132, SS_H = SS_S + 128 * SS_SROW * 4, SS_HROW = 136, SS_MISC = SS_H + 128 * SS_HROW * 2;
static_assert(SS_MISC + 1024 <= LDS_BYTES, "ssm lds");
__device__ __forceinline__ void ssm_unit(const Args& a, LAS unsigned char* lds, int b, int g, int tid) {
    const int wid = __builtin_amdgcn_readfirstlane(tid >> 6), lane = tid & 63, fr = lane & 15, fq = lane >> 4;
    unsigned char* ws = a.ws;
    const bf16_t* UB = (const bf16_t*)(ws + OFF_UB) + (size_t)b * PPOS * 1024 + 16 * g;
    const float* GP = (const float*)(ws + OFF_GP) + (size_t)g * 2304;
    bf16_t* YG = (bf16_t*)(ws + OFF_YG);
    LAS float* Sst = (LAS float*)(lds + SS_S); LAS bf16_t* Hb = (LAS bf16_t*)(lds + SS_H); LAS float* hsc = (LAS float*)(lds + SS_MISC);
    { const v4u* src = (const v4u*)((const bf16_t*)(ws + OFF_KT) + (size_t)g * 16384); LAS v4u* dst = (LAS v4u*)(lds + SS_KT);
#pragma unroll
      for (int i = 0; i < 4; ++i) dst[tid + 512 * i] = src[tid + 512 * i]; }
    float hr = 0.f, hi_ = 0.f;
    if (wid == 0) {
        const float are = GP[lane], aim = GP[64 + lane]; float bbr[16], bbi[16];
#pragma unroll
        for (int q = 0; q < 4; ++q) { const v4f r4 = *(const v4f*)(GP + 256 + lane * 16 + 4 * q), i4 = *(const v4f*)(GP + 1280 + lane * 16 + 4 * q);
            bbr[4 * q] = r4.x; bbr[4 * q + 1] = r4.y; bbr[4 * q + 2] = r4.z; bbr[4 * q + 3] = r4.w; bbi[4 * q] = i4.x; bbi[4 * q + 1] = i4.y; bbi[4 * q + 2] = i4.z; bbi[4 * q + 3] = i4.w; }
        for (int t = 0; t < 16; ++t) {
            const bf16_t* up = UB + (size_t)(48 + t) * 1024; float uu[16]; { float t0[8], t1[8]; unpack8(*(const v4u*)up, t0); unpack8(*(const v4u*)(up + 8), t1);
#pragma unroll
                for (int e = 0; e < 8; ++e) { uu[e] = t0[e]; uu[8 + e] = t1[e]; } }
            float br = 0.f, bi = 0.f;
#pragma unroll
            for (int c = 0; c < 16; ++c) { br += bbr[c] * uu[c]; bi += bbi[c] * uu[c]; }
            const float nr = are * hr - aim * hi_ + br, ni = are * hi_ + aim * hr + bi; hr = nr; hi_ = ni;
            if (b == 0 && t >= 14) {
                hsc[2 * lane] = hr; hsc[2 * lane + 1] = hi_; LDS_WAIT(); asm volatile("" ::: "memory");
                if (lane < 16) { const float* cr = a.in[I_CRE] + ((size_t)g * 16 + lane) * 64; const float* ci = a.in[I_CIM] + ((size_t)g * 16 + lane) * 64; float y = 0.f;
                    for (int p = 0; p < 64; ++p) y += cr[p] * hsc[2 * p] - ci[p] * hsc[2 * p + 1];
                    y += a.in[I_DSKIP][16 * g + lane] * bf2f(up[lane]);
                    YG[(size_t)(MREAL + t) * 1024 + 16 * g + lane] = (bf16_t)(pk2(gelu_tanh(y), 0.f) & 0xffffu); }
                LDS_WAIT(); asm volatile("" ::: "memory");
            }
        }
    }
    const bf16_t* ubw = UB + (size_t)(64 + 64 * (16 * wid + fr)) * 1024 + 8 * (fq & 1);
    {
        pg8::f32x4 sacc[8];
#pragma unroll
        for (int i = 0; i < 8; ++i) sacc[i] = (pg8::f32x4){0.f, 0.f, 0.f, 0.f};
        const bf16_t* wt = (const bf16_t*)(ws + OFF_WTS) + (size_t)g * 131072 + (size_t)fr * 1024 + 8 * fq;
#pragma unroll 2
        for (int ks = 0; ks < 32; ++ks) { const h8 A = *(const h8*)(ubw + (size_t)(2 * ks + (fq >> 1)) * 1024);
#pragma unroll
            for (int nt = 0; nt < 8; ++nt) { const h8 B = *(const h8*)(wt + (size_t)nt * 16 * 1024 + 32 * ks); sacc[nt] = MFMA16(B, A, sacc[nt]); } }
#pragma unroll
        for (int nt = 0; nt < 8; ++nt) *(LAS pg8::f32x4*)(Sst + (16 * wid + fr) * SS_SROW + 16 * nt + 4 * fq) = sacc[nt];
    }
    __syncthreads();
    if (wid == 0) { const float a64r = GP[128 + lane], a64i = GP[192 + lane];
        for (int c = 0; c < 128; ++c) { *(LAS unsigned*)(Hb + c * SS_HROW + 2 * lane) = pk2(hr, hi_); const v2f s = *(const LAS v2f*)(Sst + c * SS_SROW + 2 * lane);
            const float nr = a64r * hr - a64i * hi_ + s.x, ni = a64r * hi_ + a64i * hr + s.y; hr = nr; hi_ = ni; } }
    __syncthreads();
    const LAS bf16_t* KTl = (const LAS bf16_t*)(lds + SS_KT) + fr * 16 + 8 * (fq & 1);
    const bf16_t* vt = (const bf16_t*)(ws + OFF_VTS) + (size_t)g * 131072 + (size_t)fr * 128 + 8 * fq;
    const float* dsk = a.in[I_DSKIP] + 16 * g + 4 * fq; const v4f dv = *(const v4f*)dsk;
    for (int q = 0; q < 4; ++q) {
        pg8::f32x4 acc[16];
#pragma unroll
        for (int i = 0; i < 16; ++i) acc[i] = (pg8::f32x4){0.f, 0.f, 0.f, 0.f};
        for (int ks = 0; ks <= 8 * q + 7; ++ks) { const int s0 = 2 * ks, sA = s0 + (fq >> 1); const h8 A = *(const h8*)(ubw + (size_t)sA * 1024);
#pragma unroll
            for (int i = 0; i < 16; ++i) { const int t = 16 * q + i; if (t >= s0) { const int j = t - sA; h8 B = *(const LAS h8*)(KTl + (j < 0 ? 0 : j) * 256); if (j < 0) B = (h8){0, 0, 0, 0, 0, 0, 0, 0}; acc[i] = MFMA16(B, A, acc[i]); } } }
#pragma unroll
        for (int k2 = 0; k2 < 4; ++k2) { const h8 A = *(const LAS h8*)(Hb + (16 * wid + fr) * SS_HROW + 32 * k2 + 8 * fq);
#pragma unroll
            for (int i = 0; i < 16; ++i) { const h8 B = *(const h8*)(vt + (size_t)(16 * (16 * q + i)) * 128 + 32 * k2); acc[i] = MFMA16(B, A, acc[i]); } }
#pragma unroll
        for (int i = 0; i < 16; ++i) { const int tok = 64 * (16 * wid + fr) + 16 * q + i;
            const v2u uw = *(const v2u*)(UB + (size_t)(64 + tok) * 1024 + 4 * fq);
            const float y0 = acc[i][0] + dv.x * bflo(uw.x), y1 = acc[i][1] + dv.y * bfhi(uw.x), y2 = acc[i][2] + dv.z * bflo(uw.y), y3 = acc[i][3] + dv.w * bfhi(uw.y);
            *(v2u*)(YG + (size_t)(b * SEQ + tok) * 1024 + 16 * g + 4 * fq) = (v2u){pk2(gelu_tanh(y0), gelu_tanh(y1)), pk2(gelu_tanh(y2), gelu_tanh(y3))}; }
    }
    __syncthreads();
}

__device__ __forceinline__ void meta_attn(const Args& a, int tid) {
    const int h = tid >> 6, lane = tid & 63, qi = lane >> 2, part = lane & 3;
    unsigned char* ws = a.ws;
    const bf16_t* Qm = (const bf16_t*)(ws + OFF_Q) + (size_t)(MREAL + qi) * 1024 + h * 128 + 32 * part;
    const bf16_t* Km = (const bf16_t*)(ws + OFF_K) + (size_t)48 * 1024 + h * 128 + 32 * part;
    const bf16_t* Vm = (const bf16_t*)(ws + OFF_V) + (size_t)48 * 1024 + h * 128 + 32 * part;
    const float* BI = (const float*)(ws + OFF_BIAS) + (size_t)h * PPOS + 48;
    float q[32];
#pragma unroll
    for (int c = 0; c < 4; ++c) { float t8[8]; unpack8(*(const v4u*)(Qm + 8 * c), t8);
#pragma unroll
        for (int e = 0; e < 8; ++e) q[8 * c + e] = t8[e]; }
    float sc[16]; float mx = -1e30f;
#pragma unroll
    for (int kj = 0; kj < 16; ++kj) { float d = 0.f;
#pragma unroll
        for (int c = 0; c < 4; ++c) { float t8[8]; unpack8(*(const v4u*)(Km + (size_t)kj * 1024 + 8 * c), t8);
#pragma unroll
            for (int e = 0; e < 8; ++e) d += q[8 * c + e] * t8[e]; }
        d += __shfl_xor(d, 1); d += __shfl_xor(d, 2);
        sc[kj] = (kj <= qi) ? (d + BI[kj]) * att::SCALE : -__builtin_inff(); mx = fmaxf(mx, sc[kj]); }
    float l = 0.f;
#pragma unroll
    for (int kj = 0; kj < 16; ++kj) { sc[kj] = __expf(sc[kj] - mx); l += sc[kj]; }
    const float rl = 1.f / l;
    float o[32];
#pragma unroll
    for (int e = 0; e < 32; ++e) o[e] = 0.f;
#pragma unroll
    for (int kj = 0; kj < 16; ++kj) {
#pragma unroll
        for (int c = 0; c < 4; ++c) { float t8[8]; unpack8(*(const v4u*)(Vm + (size_t)kj * 1024 + 8 * c), t8);
#pragma unroll
            for (int e = 0; e < 8; ++e) o[8 * c + e] += sc[kj] * t8[e]; } }
    bf16_t* Om = (bf16_t*)(ws + OFF_OB) + (size_t)(MREAL + qi) * 1024 + h * 128 + 32 * part;
#pragma unroll
    for (int c = 0; c < 4; ++c) *(v4u*)(Om + 8 * c) = (v4u){pk2(o[8 * c] * rl, o[8 * c + 1] * rl), pk2(o[8 * c + 2] * rl, o[8 * c + 3] * rl), pk2(o[8 * c + 4] * rl, o[8 * c + 5] * rl), pk2(o[8 * c + 6] * rl, o[8 * c + 7] * rl)};
}

__device__ __forceinline__ att::BlockRef<att::bf16, att::bf16> att_ref(const Args& a, int bh, int qb) {
    att::BlockRef<att::bf16, att::bf16> r; const int b = bh >> 3, h = bh & 7;
    r.Q = (const att::bf16*)(a.ws + OFF_Q) + (size_t)(b * SEQ + qb * 256) * 1024 + h * 128;
    r.O = (att::bf16*)(a.ws + OFF_OB) + (size_t)(b * SEQ + qb * 256) * 1024 + h * 128;
    r.K = (const att::bf16*)(a.ws + OFF_K) + (size_t)b * PPOS * 1024 + h * 128;
    r.V = (const att::bf16*)(a.ws + OFF_V) + (size_t)b * PPOS * 1024 + h * 128;
    r.P0 = 64 + qb * 256;
    return r;
}
__device__ __forceinline__ void attn_phase(const Args& a, char* lds, int vcu, int G) {
    typedef att::BlockRef<att::bf16, att::bf16> Ref;
    constexpr int TOTAL = 256, W = 1 << 20;
    int L = vcu; if (L >= TOTAL) return;
    int bh = L >> 4, x = L & 15, pass = 0;
    const float* BIAS = (const float*)(a.ws + OFF_BIAS);
    Ref cur = att_ref(a, bh, x);
    att::Seam<att::bf16> S;
    att::causal_swa_prime<att::bf16, att::bf16>(cur, W, lds, S);
    for (;;) {
        const bool more_pass = pass == 0, more_item = L + G < TOTAL, last = !more_pass && !more_item;
        int bhn = bh, xn = x, passn = pass + 1, Ln = L;
        if (!more_pass) { passn = 0; Ln = more_item ? L + G : L; bhn = Ln >> 4; xn = Ln & 15; }
        const Ref nxt = last ? cur : att_ref(a, bhn, passn ? 31 - xn : xn);
        att::causal_swa_block<att::bf16, att::bf16>(cur, nxt, PPOS, W, lds, S, BIAS + (size_t)bh * PPOS);
        if (last) break;
        cur = nxt; bh = bhn; x = xn; pass = passn; L = Ln;
    }
}

__device__ __forceinline__ void conv_phase(const Args& a, int gt, int NT) {
    const bf16_t* G = (const bf16_t*)(a.ws + OFF_G); bf16_t* U = (bf16_t*)(a.ws + OFF_U);
    const float* cw = a.in[I_CONVW]; const float* cb = a.in[I_CONVB];
    constexpr int NCG = DFF / 8, NITEM = (MREAL / 32) * NCG;
    for (int it = gt; it < NITEM; it += NT) { const int rc = it / NCG, cgp = it - rc * NCG, r0 = 32 * rc, c0 = 8 * cgp;
        float w0[8], w1[8], w2[8], bb[8];
#pragma unroll
        for (int h = 0; h < 2; ++h) { const v4f x0 = *(const v4f*)(cw + c0 + 4 * h), x1 = *(const v4f*)(cw + DFF + c0 + 4 * h), x2 = *(const v4f*)(cw + 2 * DFF + c0 + 4 * h), x3 = *(const v4f*)(cb + c0 + 4 * h);
#pragma unroll
            for (int e = 0; e < 4; ++e) { w0[4 * h + e] = x0[e]; w1[4 * h + e] = x1[e]; w2[4 * h + e] = x2[e]; bb[4 * h + e] = x3[e]; } }
        const bool first = (r0 & 8191) == 0;
        float p2[8], p1[8];
        unpack8(*(const v4u*)(G + (size_t)(first ? MREAL + 14 : r0 - 2) * DFF + c0), p2);
        unpack8(*(const v4u*)(G + (size_t)(first ? MREAL + 15 : r0 - 1) * DFF + c0), p1);
#pragma unroll 4
        for (int r = r0; r < r0 + 32; ++r) { float gv[8], uv[8], o[8]; unpack8(*(const v4u*)(G + (size_t)r * DFF + c0), gv); unpack8(*(const v4u*)(U + (size_t)r * DFF + c0), uv);
#pragma unroll
            for (int e = 0; e < 8; ++e) { const float gc = bb[e] + w0[e] * p2[e] + w1[e] * p1[e] + w2[e] * gv[e]; o[e] = gc * sigmoidf_(gc) * uv[e]; p2[e] = p1[e]; p1[e] = gv[e]; }
            *(v4u*)(U + (size_t)r * DFF + c0) = (v4u){pk2(o[0], o[1]), pk2(o[2], o[3]), pk2(o[4], o[5]), pk2(o[6], o[7])}; }
    }
}

__global__ void __launch_bounds__(512, 2) mk_fwd(Args a0) {
    extern __shared__ __attribute__((aligned(16))) unsigned char lds_raw[];
    LAS unsigned char* lds = (LAS unsigned char*)lds_raw;
    const int tid = threadIdx.x, lane = tid & 63, wid = __builtin_amdgcn_readfirstlane(tid >> 6);
    const int G = gridDim.x, bx = blockIdx.x;
#define VCU() ((G % 8 == 0) ? (bx % 8) * (G / 8) + bx / 8 : bx)
    const int gw = bx * 8 + wid, NGW = G * 8;
#ifndef PH_MASK
#define PH_MASK 0x3ff
#endif
#define IN(k) (((PH_MASK >> (k)) & 1) && ph_in(k))
#define SEAM(k) do { if (IN(k) && IN((k) + 1)) cg::this_grid().sync(); } while (0)

    if (IN(0)) { LOAD_ARGS(a);
        { LAS float* wf = (LAS float*)(lds + WF_OFF); const float* win = a.in[I_WIN]; const float* gm = a.in[I_GMIX];
          for (int k = tid; k < DM; k += 512) { const float g = gm[k]; const v4f w0 = *(const v4f*)(win + (size_t)k * NIN + 3072), w1 = *(const v4f*)(win + (size_t)k * NIN + 3076);
              wf[0 * 2048 + k] = w0.x * g; wf[1 * 2048 + k] = w0.y * g; wf[2 * 2048 + k] = w0.z * g; wf[3 * 2048 + k] = w0.w * g;
              wf[4 * 2048 + k] = w1.x * g; wf[5 * 2048 + k] = w1.y * g; wf[6 * 2048 + k] = w1.z * g; wf[7 * 2048 + k] = w1.w * g; } }
        { const int gt = bx * 512 + tid, NT = G * 512;
          float* s1 = (float*)(ws + OFF_SUMSQ1); float* s2 = (float*)(ws + OFF_SUMSQ2);
          for (int i = gt; i < RPAD; i += NT) { s1[i] = 0.f; s2[i] = 0.f; }
          constexpr int NZ = 48 * 1024 * 2 / 16;
          for (int i = gt; i < 6 * NZ; i += NT) { const int w = i / NZ, j = i - w * NZ; const size_t base = (w >> 1) == 0 ? OFF_K : ((w >> 1) == 1 ? OFF_V : OFF_UB);
              *(v4u*)(ws + base + (size_t)(w & 1) * PPOS * 1024 * 2 + (size_t)j * 16) = (v4u){0u, 0u, 0u, 0u}; } }
        __syncthreads();
        p0_rows(a, lds, gw, NGW, lane);
        { LOAD_ARGS(a2); (void)ws; p0_transposes(a2, lds, gw, NGW, wid, lane); }
        __syncthreads();
        for (int g = bx; g < NG; g += G) ssm_gen(lds, g, tid);
    }
    SEAM(0);
    if (IN(1)) { LOAD_ARGS(a);
        if (bx >= G - 16) cumsum_seq(a, lds, bx - (G - 16), tid);
        pg8::Gemm g{(const bf16_t*)(ws + OFF_H0B), (const bf16_t*)(ws + OFF_WT_IN), RPAD, 8192, DM}; pg8::StaticOrder S; S.init(RPAD, 8192, G, bx);
        EpiZ E{(const float*)(ws + OFF_RSTD0), (bf16_t*)(ws + OFF_Q), (bf16_t*)(ws + OFF_K), (bf16_t*)(ws + OFF_V), (bf16_t*)(ws + OFF_UB), (bf16_t*)(ws + OFF_SGA), (bf16_t*)(ws + OFF_SGB)};
        pg8::gemm_phase<EpiZ, pg8::StaticOrder, true, true>(lds, g, S, E);
    }
    SEAM(1);
    if (IN(2)) { LOAD_ARGS(a);
#ifndef P2_PARTS
#define P2_PARTS 7
#endif
        const int vcu = VCU();
        if ((P2_PARTS & 1) && vcu < 128) ssm_unit(a, lds, vcu >> 6, vcu & 63, tid);
        if ((P2_PARTS & 2) && bx == G - 1) meta_attn(a, tid);
        __syncthreads();
        if (P2_PARTS & 4) attn_phase(a, (char*)lds_raw, vcu, G);
    }
    SEAM(2);
    if (IN(3)) { LOAD_ARGS(a);
        pg8::Gemm g{(const bf16_t*)(ws + OFF_OB), (const bf16_t*)(ws + OFF_WT_O), RPAD, DM, DATT}; pg8::StaticOrder S; S.init(RPAD, DM, G, bx);
        EpiO E{(const bf16_t*)(ws + OFF_SGB), (bf16_t*)(ws + OFF_M1)};
        pg8::gemm_phase<EpiO, pg8::StaticOrder, true, true>(lds, g, S, E);
    }
    SEAM(3);
    if (IN(4)) { LOAD_ARGS(a);
        pg8::Gemm g{(const bf16_t*)(ws + OFF_YG), (const bf16_t*)(ws + OFF_WT_GLU), RPAD, 4096, DSSM}; pg8::StaticOrder S; S.init(RPAD, 4096, G, bx);
        EpiGlu E{(const bf16_t*)(ws + OFF_SGA), (const bf16_t*)(ws + OFF_M1), (bf16_t*)(ws + OFF_MERGED)};
        pg8::gemm_phase<EpiGlu, pg8::StaticOrder, true, true>(lds, g, S, E);
    }
    SEAM(4);
    if (IN(5)) { LOAD_ARGS(a);
        pg8::Gemm g{(const bf16_t*)(ws + OFF_MERGED), (const bf16_t*)(ws + OFF_WT_OUT), RPAD, DM, DM}; pg8::StaticOrder S; S.init(RPAD, DM, G, bx);
        EpiOut E{a.in[I_X], a.in[I_META], a.out, (bf16_t*)(ws + OFF_H1B), (float*)(ws + OFF_SUMSQ1)};
        pg8::gemm_phase<EpiOut, pg8::StaticOrder, true, true>(lds, g, S, E);
    }
    SEAM(5);
    if (IN(6)) { LOAD_ARGS(a);
        pg8::Gemm g{(const bf16_t*)(ws + OFF_H1B), (const bf16_t*)(ws + OFF_WT_UP), RPAD, 2 * DFF, DM}; pg8::StaticOrder S; S.init(RPAD, 2 * DFF, G, bx);
        EpiUp E{(const float*)(ws + OFF_SUMSQ1), (bf16_t*)(ws + OFF_G), (bf16_t*)(ws + OFF_U)};
        pg8::gemm_phase<EpiUp, pg8::StaticOrder, true, true>(lds, g, S, E);
    }
    SEAM(6);
    if (IN(7)) { LOAD_ARGS(a); (void)ws; conv_phase(a, bx * 512 + tid, G * 512); }
    SEAM(7);
    if (IN(8)) { LOAD_ARGS(a);
        pg8::Gemm g{(const bf16_t*)(ws + OFF_U), (const bf16_t*)(ws + OFF_WT_DOWN), MREAL, DM, DFF}; pg8::StaticOrder S; S.init(MREAL, DM, G, bx);
        EpiDown E{a.out, (float*)(ws + OFF_SUMSQ2)};
        pg8::gemm_phase<EpiDown, pg8::StaticOrder, true, true>(lds, g, S, E);
    }
    SEAM(8);
    if (IN(9)) { LOAD_ARGS(a);
        const float* ss = (const float*)(ws + OFF_SUMSQ2); const float* gf = a.in[I_GFINAL];
        v4f gv[8];
#pragma unroll
        for (int j = 0; j < 8; ++j) gv[j] = *((const v4f*)gf + lane + 64 * j);
        for (int r = gw; r < MREAL; r += NGW) { const float rs = 1.0f / sqrtf(ss[r] * (1.f / DM) + EPS); v4f* p = (v4f*)(a.out + (size_t)r * DM) + lane;
#pragma unroll
            for (int j = 0; j < 8; ++j) p[64 * j] = p[64 * j] * rs * gv[j]; }
    }
#undef IN
#undef SEAM
}

extern "C" void kernel_launch(void* const* d_in, const int* in_sizes, int n_in, void* d_out, int out_size, void* d_ws, size_t ws_size, hipStream_t stream) {
    static int grid = 0;
    if (grid == 0) {
        if (n_in != 22 || out_size != MREAL * DM || ws_size < WS_NEED) { fprintf(stderr, "kernel_launch: unexpected shapes (n_in %d out %d ws %zu need %zu)\n", n_in, out_size, ws_size, (size_t)WS_NEED); grid = -1; return; }
        int dev = 0, cus = 0, per_cu = 0;
        (void)hipGetDevice(&dev); (void)hipDeviceGetAttribute(&cus, hipDeviceAttributeMultiprocessorCount, dev);
        if (hipFuncSetAttribute((const void*)mk_fwd, hipFuncAttributeMaxDynamicSharedMemorySize, LDS_BYTES) != hipSuccess) { fprintf(stderr, "kernel_launch: hipFuncSetAttribute failed\n"); grid = -1; return; }
        if (hipOccupancyMaxActiveBlocksPerMultiprocessor(&per_cu, (const void*)mk_fwd, 512, LDS_BYTES) != hipSuccess || per_cu < 1) { fprintf(stderr, "kernel_launch: occupancy query says %d\n", per_cu); per_cu = 1; }
        (void)hipGetLastError();
        grid = cus > 0 ? cus : 256;
    }
    if (grid < 0) return;
    Args a{};
    for (int i = 0; i < 22; ++i) a.in[i] = (const float*)d_in[i];
    a.out = (float*)d_out; a.ws = (unsigned char*)d_ws;
#if MK_SPLIT
    for (int p = 0; p < 10; ++p) { a.ph_lo = p; a.ph_hi = p + 1; hipLaunchKernelGGL(mk_fwd, dim3(grid), dim3(512), LDS_BYTES, stream, a); }
#else
    a.ph_lo = 0; a.ph_hi = 10;
    void* args[] = {&a};
    const hipError_t e = hipLaunchCooperativeKernel((const void*)mk_fwd, dim3(grid), dim3(512), args, LDS_BYTES, stream);
    if (e != hipSuccess) fprintf(stderr, "kernel_launch: cooperative launch failed: %s (grid %d)\n", hipGetErrorString(e), grid);
#endif
}
```

```cpp
#include <hip/hip_runtime.h>
#include <hip/hip_bf16.h>
#include <hip/hip_cooperative_groups.h>
#include <cstdio>
#include <cstdint>
namespace cg = cooperative_groups;
namespace pg8 {
#define PG8_LAS __attribute__((address_space(3)))
typedef unsigned short bf16_t;
typedef short bf16x8 __attribute__((ext_vector_type(8)));
typedef float f32x4 __attribute__((ext_vector_type(4)));
typedef unsigned u32x4 __attribute__((ext_vector_type(4)));
constexpr int BM = 256, BK = 64, HALF = 128, HTB = HALF * BK * 2  , STAGE_BYTES = 8 * HTB, NXCD = 8, WGM = 8;

__host__ __device__ __forceinline__ int lds_byte(int r, int c) { const int st = (r >> 4) * 2 + (c >> 5), rr = r & 15, cc = c & 31, ob = rr * 64 + cc * 2; return st * 1024 + (ob ^ (((ob >> 9) & 1) << 5)); }
__host__ __device__ __forceinline__ void stage_rc(int b, int& R, int& C) { const int st = b / 1024, sb = b % 1024, swz = sb ^ (((sb >> 9) & 1) << 5); R = (st >> 1) * 16 + swz / 64; C = (st & 1) * 32 + (swz % 64) / 2; }
__host__ __device__ __forceinline__ int perm32(int rho) { const int n = rho >> 4, i = rho & 15; return 8 * (i >> 2) + 4 * n + (i & 3); }

struct Unit { int pm, pn, kind; };
struct Gemm { const bf16_t* A; const bf16_t* Bt; int M, N, K; };

struct StaticOrder {
    int nM, nN, nwg, G, c;
    __host__ __device__ void init(int M, int N, int G_, int c_) { nM = M / BM; nN = N / BM; nwg = nM * nN; G = G_; c = c_; }
    __host__ __device__ bool next(int i, Unit& u) const {
        const long L = (long)i * G + c; if (L >= nwg) return false;
        int wgid = (int)L; { const int q = nwg / NXCD, r = nwg % NXCD, xcd = wgid % NXCD, off = wgid / NXCD; wgid = (xcd < r ? xcd * (q + 1) : r * (q + 1) + (xcd - r) * q) + off; }
        const int nig = WGM * nN, gid = wgid / nig, fm = gid * WGM, gsz = (nM - fm) < WGM ? (nM - fm) : WGM;
        u.pm = fm + ((wgid % nig) % gsz); u.pn = (wgid % nig) / gsz; return true;
    }
    template <class G_> __device__ __forceinline__ const char* abase(const G_& g, const Unit&) const { return (const char*)g.A; }
    template <class G_> __device__ __forceinline__ const char* bbase(const G_& g, const Unit&) const { return (const char*)g.Bt; }
    __device__ __forceinline__ void a_ready(const Unit&) const {}
    __device__ __forceinline__ void done(const Unit&) const {}
};

__device__ __forceinline__ unsigned cvt_pk_bf16(float lo, float hi) { unsigned r; asm volatile("v_cvt_pk_bf16_f32 %0, %1, %2" : "=v"(r) : "v"(lo), "v"(hi)); return r; }
typedef float f32x2 __attribute__((ext_vector_type(2)));
template <class Epi, class Sched, bool ALIGN_EPI = false, bool SP2 = false>
__device__ __forceinline__ void gemm_phase(PG8_LAS unsigned char* lds, const Gemm g, const Sched& S, const Epi& E) {
    const int tid = threadIdx.x, wid = __builtin_amdgcn_readfirstlane(tid >> 6), lane = tid & 63, wr = wid >> 2, wc = wid & 3, fr = lane & 15, fq = lane >> 4;
    const int K = g.K, nt = K / BK;
    unsigned voffA[2], voffB[2];
#pragma unroll
    for (int i = 0; i < 2; ++i) { int R, C; stage_rc(tid * 16 + i * 8192, R, C); const int Rb = Epi::PERM ? ((R & ~31) + perm32(R & 31)) : R;
        voffA[i] = (unsigned)(R * K + C) * 2u; voffB[i] = (unsigned)(Rb * K + C) * 2u; }
    const size_t kstep = (size_t)(BK * 2);
    const size_t hstep = (size_t)HALF * K * 2;
    const size_t tstep = 2 * hstep;
    const unsigned ldsw = (unsigned)wid * 1024u;
    const int aoff = lds_byte(wr * 64 + fr, fq * 8), boff = lds_byte(wc * 32 + fr, fq * 8);
#define PG8_SA(b, h) (((b) * 2 + (h)) * HTB)
#define PG8_SB(b, h) ((4 + (b) * 2 + (h)) * HTB)
#define PG8_STAGE(bufoff, gbase, voff) do { _Pragma("unroll") for (int _i = 0; _i < 2; ++_i) \
        __builtin_amdgcn_global_load_lds((const unsigned*)((const char*)(gbase) + (voff)[_i]), (PG8_LAS unsigned*)(lds + (bufoff) + ldsw + _i * 8192), 16, 0, 0); } while (0)
#define PG8_LDA(dst, b, h) do { _Pragma("unroll") for (int m = 0; m < 4; ++m) _Pragma("unroll") for (int k = 0; k < 2; ++k) dst[m][k] = *(const PG8_LAS bf16x8*)(lds + PG8_SA(b, h) + aoff + m * 2048 + k * 1024); } while (0)
#define PG8_LDB(dst, b, h) do { _Pragma("unroll") for (int n = 0; n < 2; ++n) _Pragma("unroll") for (int k = 0; k < 2; ++k) dst[n][k] = *(const PG8_LAS bf16x8*)(lds + PG8_SB(b, h) + boff + n * 2048 + k * 1024); } while (0)
#define PG8_MMA(ai, bj, At, Bt) do { __builtin_amdgcn_s_setprio(1); _Pragma("unroll") for (int m = 0; m < 4; ++m) _Pragma("unroll") for (int n = 0; n < 2; ++n) _Pragma("unroll") for (int k = 0; k < 2; ++k) \
        acc[ai][bj][m][n] = __builtin_amdgcn_mfma_f32_16x16x32_bf16(Bt[n][k], At[m][k], acc[ai][bj][m][n], 0, 0, 0); __builtin_amdgcn_s_setprio(0); } while (0)
#define PG8_WAIT_V(n) asm volatile("s_waitcnt vmcnt(" #n ")" ::: "memory")
#define PG8_WAIT_L(n) asm volatile("s_waitcnt lgkmcnt(" #n ")" ::: "memory")
#define PG8_BAR __builtin_amdgcn_s_barrier()
#define PG8_SCHED __builtin_amdgcn_sched_barrier(0)
    Unit cur, nxt; int ui = 0;
    if (!S.next(0, cur)) return;
    f32x4 acc[2][2][4][2];
#pragma unroll
    for (int a = 0; a < 2; ++a)
#pragma unroll
        for (int b = 0; b < 2; ++b)
#pragma unroll
            for (int m = 0; m < 4; ++m)
#pragma unroll
                for (int n = 0; n < 2; ++n) acc[a][b][m][n] = (f32x4){0.f, 0.f, 0.f, 0.f};
    bf16x8 At[4][2], B0[2][2], B1[2][2];
    const char* cA = S.abase(g, cur) + (size_t)cur.pm * tstep; const char* cB = S.bbase(g, cur) + (size_t)cur.pn * tstep;
    S.a_ready(cur);
    if constexpr (SP2) {
        PG8_STAGE(PG8_SB(0, 0), cB, voffB); PG8_STAGE(PG8_SB(0, 1), cB + hstep, voffB); PG8_STAGE(PG8_SA(0, 0), cA, voffA); PG8_STAGE(PG8_SA(0, 1), cA + hstep, voffA);
        if (wr == 1) PG8_BAR;
        PG8_WAIT_V(2); PG8_BAR;
        PG8_STAGE(PG8_SB(1, 0), cB + kstep, voffB); PG8_STAGE(PG8_SA(1, 0), cA + kstep, voffA); PG8_STAGE(PG8_SB(1, 1), cB + hstep + kstep, voffB);
        PG8_WAIT_V(6); PG8_BAR;
    } else {
        PG8_STAGE(PG8_SB(0, 0), cB, voffB); PG8_STAGE(PG8_SA(0, 0), cA, voffA); PG8_STAGE(PG8_SB(0, 1), cB + hstep, voffB); PG8_STAGE(PG8_SA(0, 1), cA + hstep, voffA);
        if (wr == 1) PG8_BAR;
        PG8_WAIT_V(4); PG8_BAR;
        PG8_STAGE(PG8_SB(1, 0), cB + kstep, voffB); PG8_STAGE(PG8_SA(1, 0), cA + kstep, voffA); PG8_STAGE(PG8_SB(1, 1), cB + hstep + kstep, voffB);
        PG8_WAIT_V(6); PG8_BAR;
    }
    for (;;) {
        const bool has_next = S.next(ui + 1, nxt);
        const char* nA = has_next ? S.abase(g, nxt) + (size_t)nxt.pm * tstep : cA; const char* nB = has_next ? S.bbase(g, nxt) + (size_t)nxt.pn * tstep : cB;
        for (int t = 0; t < nt; t += 2) {
            const bool last = (t == nt - 2);
            const char* a1 = cA + (size_t)(t + 1) * kstep;
            const char* a2 = last ? nA : cA + (size_t)(t + 2) * kstep; const char* b2 = last ? nB : cB + (size_t)(t + 2) * kstep;
            const char* a3 = a2 + kstep; const char* b3 = b2 + kstep;
            if (last && has_next) S.a_ready(nxt);
            if constexpr (SP2) {
            PG8_LDB(B0, 0, 0); PG8_LDB(B1, 0, 1); PG8_SCHED; PG8_LDA(At, 0, 0); PG8_STAGE(PG8_SA(1, 1), a1 + hstep, voffA);
            PG8_WAIT_V(8); PG8_WAIT_L(0); PG8_BAR; PG8_MMA(0, 0, At, B0); PG8_MMA(0, 1, At, B1); PG8_BAR; PG8_SCHED;
            PG8_LDA(At, 0, 1); PG8_STAGE(PG8_SB(0, 0), b2, voffB); PG8_STAGE(PG8_SB(0, 1), b2 + hstep, voffB); PG8_STAGE(PG8_SA(0, 0), a2, voffA);
            PG8_WAIT_V(8); PG8_WAIT_L(0); PG8_BAR; PG8_MMA(1, 0, At, B0); PG8_MMA(1, 1, At, B1); PG8_BAR; PG8_SCHED;
            PG8_LDB(B0, 1, 0); PG8_LDB(B1, 1, 1); PG8_SCHED; PG8_LDA(At, 1, 0); PG8_STAGE(PG8_SA(0, 1), a2 + hstep, voffA);
            PG8_WAIT_V(8); PG8_WAIT_L(0); PG8_BAR; PG8_MMA(0, 0, At, B0); PG8_MMA(0, 1, At, B1); PG8_BAR; PG8_SCHED;
            PG8_LDA(At, 1, 1); PG8_STAGE(PG8_SB(1, 0), b3, voffB); PG8_STAGE(PG8_SB(1, 1), b3 + hstep, voffB); PG8_STAGE(PG8_SA(1, 0), a3, voffA);
            PG8_WAIT_V(8); PG8_WAIT_L(0); PG8_BAR; PG8_MMA(1, 0, At, B0); PG8_MMA(1, 1, At, B1); PG8_BAR; PG8_SCHED;
            } else {
            PG8_LDB(B0, 0, 0); PG8_SCHED; PG8_LDA(At, 0, 0); PG8_STAGE(PG8_SA(1, 1), a1 + hstep, voffA);
            PG8_WAIT_L(8); PG8_BAR; PG8_WAIT_L(0); PG8_MMA(0, 0, At, B0); PG8_BAR; PG8_SCHED;
            PG8_LDB(B1, 0, 1); PG8_STAGE(PG8_SB(0, 0), b2, voffB);
            PG8_BAR; PG8_WAIT_L(0); PG8_MMA(0, 1, At, B1); PG8_BAR;
            PG8_LDA(At, 0, 1); PG8_STAGE(PG8_SA(0, 0), a2, voffA);
            PG8_BAR; PG8_WAIT_L(0); PG8_MMA(1, 0, At, B0); PG8_BAR; PG8_SCHED;
            PG8_STAGE(PG8_SB(0, 1), b2 + hstep, voffB);
            PG8_WAIT_V(6); PG8_BAR; PG8_MMA(1, 1, At, B1); PG8_BAR;
            PG8_LDB(B0, 1, 0); PG8_SCHED; PG8_LDA(At, 1, 0); PG8_STAGE(PG8_SA(0, 1), a2 + hstep, voffA);
            PG8_WAIT_L(8); PG8_BAR; PG8_WAIT_L(0); PG8_MMA(0, 0, At, B0); PG8_BAR; PG8_SCHED;
            PG8_LDB(B1, 1, 1); PG8_STAGE(PG8_SB(1, 0), b3, voffB);
            PG8_BAR; PG8_WAIT_L(0); PG8_MMA(0, 1, At, B1); PG8_BAR;
            PG8_LDA(At, 1, 1); PG8_STAGE(PG8_SA(1, 0), a3, voffA);
            PG8_BAR; PG8_WAIT_L(0); PG8_MMA(1, 0, At, B0); PG8_BAR; PG8_SCHED;
            PG8_STAGE(PG8_SB(1, 1), b3 + hstep, voffB);
            PG8_WAIT_V(6); PG8_BAR; PG8_MMA(1, 1, At, B1); PG8_BAR;
            }
        }
        if constexpr (ALIGN_EPI) { if (wr == 0) PG8_BAR; }
        if constexpr (!Epi::AFTER_DRAIN) { E(acc, cur, wr, wc, fr, fq); S.done(cur); }
        if (!has_next) break;
#pragma unroll
        for (int a = 0; a < 2; ++a)
#pragma unroll
            for (int b = 0; b < 2; ++b)
#pragma unroll
                for (int m = 0; m < 4; ++m)
#pragma unroll
                    for (int n = 0; n < 2; ++n) acc[a][b][m][n] = (f32x4){0.f, 0.f, 0.f, 0.f};
        cur = nxt; cA = nA; cB = nB; ++ui;
        if constexpr (ALIGN_EPI) { if (wr == 1) PG8_BAR; }
    }
    PG8_WAIT_V(0);
    if constexpr (!ALIGN_EPI) { if (wr == 0) PG8_BAR; }
    PG8_BAR;
    if constexpr (Epi::AFTER_DRAIN) { E.fused(acc, cur, wr, wc, fr, fq, lds, wid, lane); S.done(cur); }
#undef PG8_SA
#undef PG8_SB
#undef PG8_STAGE
#undef PG8_LDA
#undef PG8_LDB
#undef PG8_MMA
#undef PG8_WAIT_V
#undef PG8_WAIT_L
#undef PG8_BAR
#undef PG8_SCHED
}
}
namespace att {
constexpr int D = 128, RS = 1024;
constexpr float THR = 8.f; constexpr bool WSKIP = false;
constexpr float SCALE = 0.08838834764831845f;
constexpr int NW = 8, QBLK = 32, KVBLK = 64, QB = NW * QBLK;
constexpr int SHM_V = KVBLK * D * 2, SHM_K = KVBLK * D * 2;
constexpr int LDS_BYTES = 2 * SHM_V + 2 * SHM_K + NW * 64 * 4;

using bf16 = __hip_bfloat16;
typedef short bf16x8 __attribute__((ext_vector_type(8)));
typedef short s16x4 __attribute__((ext_vector_type(4)));
typedef float f32x16 __attribute__((ext_vector_type(16)));
typedef float f32x4 __attribute__((ext_vector_type(4)));
typedef unsigned u32x4 __attribute__((ext_vector_type(4)));
template <class A, class Bt> struct same_t { static constexpr bool v = false; };
template <class A> struct same_t<A, A> { static constexpr bool v = true; };

#define KSWZ(row, colB) ((row) * 256 + ((colB) ^ (((row) & 7) << 4)))
#define SBAR() __builtin_amdgcn_sched_barrier(0)
__device__ __forceinline__ int att_tid() { int t = threadIdx.x; asm volatile("" : "+v"(t)); return t; }
__device__ __forceinline__ int v_st(int k, int c) { const int kk = (k & ~0xC) | ((k & 4) << 1) | ((k & 8) >> 1); return ((kk >> 3) * 4 + (c >> 5)) * 512 + ((kk & 7) * 32 + (c & 31)) * 2; }
__device__ __forceinline__ int v_rd_base(int lane) { return ((lane & 3) << 3) | (((lane >> 2) & 3) << 6) | (((lane >> 4) & 1) << 5) | (((lane >> 5) & 1) << 8); }
constexpr int v_rd_off(int d0, int ks, int half) { return d0 * 512 + ks * 4096 + half * 2048; }
__device__ __forceinline__ int crow(int r, int hi) { return (r & 3) + 8 * (r >> 2) + 4 * hi; }
__device__ __forceinline__ unsigned cvtpk(float lo, float hi) {
    unsigned r; asm volatile("v_cvt_pk_bf16_f32 %0, %1, %2" : "=v"(r) : "v"(lo), "v"(hi)); return r;
}
__device__ __forceinline__ bf16x8 pack8(f32x4 a, f32x4 b) {
    u32x4 w = {cvtpk(a[0], a[1]), cvtpk(a[2], a[3]), cvtpk(b[0], b[1]), cvtpk(b[2], b[3])};
    return *reinterpret_cast<bf16x8*>(&w);
}
template <class T> __device__ __forceinline__ bf16x8 load8(const T* p) {
    if constexpr (same_t<T, float>::v) { return pack8(*(const f32x4*)p, *(const f32x4*)(p + 4)); }
    else { return *reinterpret_cast<const bf16x8*>(p); }
}
__device__ __forceinline__ void mask_tile(f32x16& p0, f32x16& p1, int dq, unsigned W) {
    const float NEG = -__builtin_inff();
#pragma unroll
    for (int r = 0; r < 16; ++r) {
        const int c = (r & 3) + 8 * (r >> 2);
        if ((unsigned)(dq - c) >= W) p0[r] = NEG;
        if ((unsigned)(dq - c - 32) >= W) p1[r] = NEG;
    }
}
__device__ __forceinline__ void partialSM(f32x16& p0, f32x16& p1, float& m_reg, float& mn, float& alpha) {
    float pmax = p0[0]; for (int r = 1; r < 16; ++r) pmax = fmaxf(pmax, p0[r]); for (int r = 0; r < 16; ++r) pmax = fmaxf(pmax, p1[r]);
    { auto rr = __builtin_amdgcn_permlane32_swap(__float_as_uint(pmax), __float_as_uint(pmax), false, false);
      pmax = fmaxf(__uint_as_float(rr[0]), __uint_as_float(rr[1])); }
    constexpr float C2 = 1.4426950408889634f * SCALE;
    if (__builtin_expect(__all((pmax - m_reg) * SCALE <= THR), 1)) { mn = m_reg; alpha = 1.f; }
    else { mn = fmaxf(m_reg, pmax); alpha = __builtin_amdgcn_exp2f((m_reg - mn) * C2); m_reg = mn; }
    const float mnL = -mn * C2;
    for (int r = 0; r < 16; ++r) p0[r] = fmaf(p0[r], C2, mnL); for (int r = 0; r < 16; ++r) p1[r] = fmaf(p1[r], C2, mnL);
    for (int r = 0; r < 16; ++r) p0[r] = __builtin_amdgcn_exp2f(p0[r]);
}
__device__ __forceinline__ void finishSM(f32x16& p0, f32x16& p1, float alpha, float& l_reg, bf16x8& pa0, bf16x8& pa1, bf16x8& pa2, bf16x8& pa3) {
    for (int r = 0; r < 16; ++r) p1[r] = __builtin_amdgcn_exp2f(p1[r]);
    float ps = 0; for (int r = 0; r < 16; ++r) ps += p0[r]; for (int r = 0; r < 16; ++r) ps += p1[r];
    { auto rr = __builtin_amdgcn_permlane32_swap(__float_as_uint(ps), __float_as_uint(ps), false, false);
      ps = __uint_as_float(rr[0]) + __uint_as_float(rr[1]); }
    l_reg = l_reg * alpha + ps;
#define PK4(P, B_, OUT) do { unsigned a0 = cvtpk(P[B_+0], P[B_+1]), a1 = cvtpk(P[B_+2], P[B_+3]);                          \
        unsigned b0 = cvtpk(P[B_+4], P[B_+5]), b1 = cvtpk(P[B_+6], P[B_+7]);                                             \
        auto r0 = __builtin_amdgcn_permlane32_swap(a0, b0, false, false); auto r1 = __builtin_amdgcn_permlane32_swap(a1, b1, false, false); \
        u32x4 w = {r0[0], r1[0], r0[1], r1[1]}; OUT = *reinterpret_cast<bf16x8*>(&w); } while (0)
    PK4(p0, 0, pa0); PK4(p0, 8, pa1); PK4(p1, 0, pa2); PK4(p1, 8, pa3);
#undef PK4
}
template <int KB, bool SK>
__device__ __forceinline__ void qkt(f32x16& p0, f32x16& p1, const char* K_lds, int r32, int hi, const bf16x8* qr, bool act, int bia) {
    if (SK && !act) { const float NEG = -__builtin_inff();
#pragma unroll
        for (int r = 0; r < 16; ++r) { p0[r] = NEG; p1[r] = NEG; } return; }
    {
#pragma unroll
        for (int g = 0; g < 4; ++g) { typedef const __attribute__((address_space(3))) f32x4* lp4; const f32x4 a = *(lp4)(uintptr_t)(unsigned)(bia + 32 * g), b = *(lp4)(uintptr_t)(unsigned)(bia + 128 + 32 * g);
            p0[4 * g] = a[0]; p0[4 * g + 1] = a[1]; p0[4 * g + 2] = a[2]; p0[4 * g + 3] = a[3];
            p1[4 * g] = b[0]; p1[4 * g + 1] = b[1]; p1[4 * g + 2] = b[2]; p1[4 * g + 3] = b[3]; } }
    const char* kb[4];
#pragma unroll
    for (int dd = 0; dd < 4; ++dd) kb[dd] = K_lds + KB * SHM_K + KSWZ(r32, (dd * 16 + hi * 8) * 2);
#pragma unroll
    for (int d0 = 0; d0 < 8; ++d0) { const char* a = kb[d0 & 3] + (d0 >> 2) * 128;
        bf16x8 b0 = *reinterpret_cast<const bf16x8*>(a);
        bf16x8 b1 = *reinterpret_cast<const bf16x8*>(a + 32 * 256);
        p0 = __builtin_amdgcn_mfma_f32_32x32x16_bf16(b0, qr[d0], p0, 0, 0, 0);
        p1 = __builtin_amdgcn_mfma_f32_32x32x16_bf16(b1, qr[d0], p1, 0, 0, 0); }
}
template <int VB, bool SK>
__device__ __forceinline__ void pv_tile(f32x16* o, int vb0, bf16x8 pa0, bf16x8 pa1, bf16x8 pa2, bf16x8 pa3, bool act) {
    if (SK && !act) return;
#define TRRD(dst, off) asm volatile("ds_read_b64_tr_b16 %0, %1 offset:%2" : "=&v"(dst) : "v"(vb0), "i"(off) : "memory")
#define PV_D0(d0) do { s16x4 l0, l1, l2, l3, h0, h1, h2, h3; constexpr int b_ = VB * SHM_V + v_rd_off(d0, 0, 0);     \
        TRRD(l0, b_); TRRD(h0, b_ + 2048); TRRD(l1, b_ + 4096); TRRD(h1, b_ + 6144); TRRD(l2, b_ + 8192); TRRD(h2, b_ + 10240); TRRD(l3, b_ + 12288); TRRD(h3, b_ + 14336); \
        asm volatile("s_waitcnt lgkmcnt(0)" ::: "memory"); SBAR();                 \
        o[d0] = __builtin_amdgcn_mfma_f32_32x32x16_bf16(pa0, (bf16x8){l0[0], l0[1], l0[2], l0[3], h0[0], h0[1], h0[2], h0[3]}, o[d0], 0, 0, 0);   \
        o[d0] = __builtin_amdgcn_mfma_f32_32x32x16_bf16(pa1, (bf16x8){l1[0], l1[1], l1[2], l1[3], h1[0], h1[1], h1[2], h1[3]}, o[d0], 0, 0, 0);   \
        o[d0] = __builtin_amdgcn_mfma_f32_32x32x16_bf16(pa2, (bf16x8){l2[0], l2[1], l2[2], l2[3], h2[0], h2[1], h2[2], h2[3]}, o[d0], 0, 0, 0);   \
        o[d0] = __builtin_amdgcn_mfma_f32_32x32x16_bf16(pa3, (bf16x8){l3[0], l3[1], l3[2], l3[3], h3[0], h3[1], h3[2], h3[3]}, o[d0], 0, 0, 0); } while (0)
    PV_D0(0); PV_D0(1); PV_D0(2); PV_D0(3);
#undef PV_D0
#undef TRRD
}

template <class TIn, class TOut> struct BlockRef { const TIn* Q; const TIn* K; const TIn* V; TOut* O; int P0; };
template <class TIn> struct Seam {
    bf16x8 qr[8];
    bf16x8 st_v0, st_v1, st_k0, st_k1; f32x4 sf0, sf1, sf2, sf3;
    f32x4 tq[16];
};
__device__ __forceinline__ int swa_jlo(int P0, int W) { const int lowk = P0 - W + 1; return lowk > 0 ? lowk / KVBLK : 0; }
#define ROW(p, k0, rr) ((p) + (size_t)((k0) + (rr)) * RS + sc)
#define VMW() asm volatile("s_waitcnt vmcnt(0)" ::: "memory")
#define VMWN(n) asm volatile("s_waitcnt vmcnt(%0)" :: "i"(n) : "memory")
#define SLOAD_H(Kp, Vp, k0) do { S.st_v0 = load8<TIn>(ROW(Vp, k0, sr)); S.st_v1 = load8<TIn>(ROW(Vp, k0, 32 + sr));              \
                         S.st_k0 = load8<TIn>(ROW(Kp, k0, sr)); S.st_k1 = load8<TIn>(ROW(Kp, k0, 32 + sr)); } while (0)
#define SWRITE_HK(bf) do { *(bf16x8*)(K_lds + (bf) * SHM_K + kws) = S.st_k0; *(bf16x8*)(K_lds + (bf) * SHM_K + kws + 32 * 256) = S.st_k1; } while (0)
#define SWRITE_HV(bf) do { *(bf16x8*)(V_lds + (bf) * SHM_V + vst0) = S.st_v0; *(bf16x8*)(V_lds + (bf) * SHM_V + vst1) = S.st_v1; } while (0)
#define SWRITE_H(bf) do { SWRITE_HV(bf); SWRITE_HK(bf); } while (0)
#define SLOAD_F(p, k0) do { S.sf0 = *(const f32x4*)ROW(p, k0, sr); S.sf1 = *(const f32x4*)(ROW(p, k0, sr) + 4);                \
                            S.sf2 = *(const f32x4*)ROW(p, k0, 32 + sr); S.sf3 = *(const f32x4*)(ROW(p, k0, 32 + sr) + 4); } while (0)
#define SWRITE_KF(bf) do { *(bf16x8*)(K_lds + (bf) * SHM_K + kws) = pack8(S.sf0, S.sf1); *(bf16x8*)(K_lds + (bf) * SHM_K + kws + 32 * 256) = pack8(S.sf2, S.sf3); } while (0)
#define SWRITE_VF(bf) do { *(bf16x8*)(V_lds + (bf) * SHM_V + vst0) = pack8(S.sf0, S.sf1); *(bf16x8*)(V_lds + (bf) * SHM_V + vst1) = pack8(S.sf2, S.sf3); } while (0)
template <class TIn, class TOut>
__device__ __forceinline__ void causal_swa_prime(const BlockRef<TIn, TOut>& cur, int W, char* lds, Seam<TIn>& S) {
    constexpr bool F32 = same_t<TIn, float>::v;
    const int tid = att_tid(), wid = __builtin_amdgcn_readfirstlane(tid >> 6), lane = tid & 63, r32 = lane & 31, hi = lane >> 5;
    const int sr = tid >> 4, sc = (tid & 15) * 8, kws = KSWZ(sr, sc * 2); char* K_lds = lds + 2 * SHM_V;
    const int kb0 = swa_jlo(cur.P0, W) * KVBLK;
    for (int d0 = 0; d0 < 8; ++d0) S.qr[d0] = load8<TIn>(cur.Q + (size_t)(wid * QBLK + r32) * RS + d0 * 16 + hi * 8);
    if constexpr (F32) { SLOAD_F((const float*)cur.K, kb0); VMW(); SWRITE_KF(0); SBAR(); SLOAD_F((const float*)cur.V, kb0); }
    else { SLOAD_H(cur.K, cur.V, kb0); VMW(); SWRITE_HK(0); }
    __syncthreads();
}
template <class TIn, class TOut>
__device__ __forceinline__ void causal_swa_block(const BlockRef<TIn, TOut>& cur, const BlockRef<TIn, TOut>& nxt, int skv, int W, char* lds, Seam<TIn>& S, const float* __restrict__ biasG) {
    constexpr bool F32 = same_t<TIn, float>::v;
    const int tid = att_tid(), wid = __builtin_amdgcn_readfirstlane(tid >> 6), lane = tid & 63, r32 = lane & 31, hi = lane >> 5;
    const int j_lo = swa_jlo(cur.P0, W);
    int j_hi = (cur.P0 + QB - 1) / KVBLK + 1; if (j_hi > skv / KVBLK) j_hi = skv / KVBLK;
    const int NT = j_hi - j_lo;
    {
        float* bl = (float*)(lds + LDS_BYTES);
        unsigned t0 = (unsigned)tid; asm volatile("" : "+v"(t0));
        for (unsigned i4 = t0; i4 < (unsigned)(j_hi * 16); i4 += 512u) *(f32x4*)(bl + 4u * i4) = *(const f32x4*)((const char*)biasG + 16u * i4);
        __syncthreads(); }
    const int biaL = (int)(uintptr_t)(lds + LDS_BYTES) + 16 * hi;
    const int kbn = swa_jlo(nxt.P0, W) * KVBLK;
    const int qlo = cur.P0 + wid * QBLK, qm = qlo + r32 - 4 * hi;
    char* V_lds = lds; char* K_lds = lds + 2 * SHM_V;
    float* ws = (float*)(lds + 2 * SHM_V + 2 * SHM_K) + wid * 64; float* li_l = ws, * al_l = ws + 32;
    float m_reg = -1e30f, l_reg = 0; f32x16 o[4] = {};
    const int sr = tid >> 4, sc = (tid & 15) * 8, vst0 = v_st(sr, sc), vst1 = v_st(32 + sr, sc), kws = KSWZ(sr, sc * 2);
    const int vb0 = (int)(uintptr_t)V_lds + v_rd_base(lane);
    const TIn* Kh = cur.K; const TIn* Vh = cur.V;
#define RESC(a) do { if (__any((a) < 1.f)) { if (hi == 0) al_l[r32] = (a); asm volatile("s_waitcnt lgkmcnt(0)" ::: "memory");              \
                     for (int d_ = 0; d_ < 4; ++d_) for (int r = 0; r < 16; ++r) o[d_][r] *= al_l[crow(r, hi)]; } } while (0)
#define KBASE(t) ((j_lo + (t)) * KVBLK)
#define ACT(t) (KBASE(t) <= qlo + QBLK - 1 && KBASE(t) + KVBLK - 1 >= qlo - W + 1)
#define MASKT(P0_, P1_, t) do { const int kb_ = KBASE(t); if ((!SK || ACT(t)) && (kb_ + KVBLK - 1 > qlo || kb_ <= qlo + QBLK - 1 - W)) mask_tile(P0_, P1_, qm - kb_, (unsigned)W); } while (0)
    constexpr int NQL = F32 ? 16 : 8;
    constexpr bool SK = WSKIP && !F32;
#define SEAM_K0() do { VMWN(NQL); if constexpr (F32) { SWRITE_KF(0); SBAR(); SLOAD_F((const float*)nxt.V, kbn); } else { SWRITE_HK(0); } SBAR(); } while (0)
    f32x16 pA0, pA1, pB0, pB1; float mnA, mnB, alA, alB; bf16x8 pa0, pa1, pa2, pa3;
    if constexpr (F32) { VMW(); SWRITE_VF(0); SBAR(); } else { SWRITE_HV(0); SBAR(); }
    if (NT > 1) { if constexpr (F32) SLOAD_F((const float*)Kh, KBASE(1)); else SLOAD_H(Kh, Vh, KBASE(1)); }
    SBAR(); qkt<0, SK>(pA0, pA1, K_lds, r32, hi, S.qr, ACT(0), biaL + 4 * KBASE(0));
    if constexpr (F32) { if (NT > 1) { VMW(); SWRITE_KF(1); SBAR(); SLOAD_F((const float*)Vh, KBASE(1)); } }
    MASKT(pA0, pA1, 0); partialSM(pA0, pA1, m_reg, mnA, alA);
    if (NT > 1) { VMW(); if constexpr (F32) { SWRITE_VF(1); SBAR(); if (NT > 2) SLOAD_F((const float*)Kh, KBASE(2)); } else SWRITE_H(1); }
    __syncthreads();
#define HALF_STEP(PX0, PX1, mnX, alX, PY0, PY1, alY, t, KB, VB, SB) do {                                                      \
        SBAR(); qkt<KB, SK>(PX0, PX1, K_lds, r32, hi, S.qr, ACT(t), biaL + 4 * KBASE(t));                                             \
        finishSM(PY0, PY1, alY, l_reg, pa0, pa1, pa2, pa3); SBAR();                                                           \
        if ((t) + 1 < NT) { if constexpr (F32) { VMW(); SWRITE_KF(SB); SBAR(); SLOAD_F((const float*)Vh, KBASE((t) + 1)); }  \
                            else { SLOAD_H(Kh, Vh, KBASE((t) + 1)); } SBAR(); }                                               \
        pv_tile<VB, SK>(o, vb0, pa0, pa1, pa2, pa3, ACT((t) - 1)); MASKT(PX0, PX1, (t)); partialSM(PX0, PX1, m_reg, mnX, alX);                                        \
        __syncthreads();                                                                                                      \
        if ((t) + 1 < NT) { VMW(); if constexpr (F32) { SWRITE_VF(SB); SBAR(); if ((t) + 2 < NT) SLOAD_F((const float*)Kh, KBASE((t) + 2)); } \
                            else { SWRITE_H(SB); } }                                                                          \
        RESC(alX); __syncthreads(); } while (0)
    for (int t = 1; t + 1 < NT; t += 2) {
        HALF_STEP(pB0, pB1, mnB, alB, pA0, pA1, alA, t, 1, 0, 0);
        HALF_STEP(pA0, pA1, mnA, alA, pB0, pB1, alB, t + 1, 0, 1, 1);
    }
    const bool even = (NT & 1) == 0;
    if (even) { SBAR(); qkt<1, SK>(pB0, pB1, K_lds, r32, hi, S.qr, ACT(NT - 1), biaL + 4 * KBASE(NT - 1)); SBAR(); }
#define QROW(e) (nxt.Q + (size_t)(wid * QBLK + r32) * RS + ((e) >> 1) * 16 + hi * 8 + ((e) & 1) * 4)
    if constexpr (F32) { SLOAD_F((const float*)nxt.K, kbn); SBAR();
#pragma unroll
        for (int e = 0; e < 8; ++e) S.tq[e] = *(const f32x4*)QROW(e); }
    else { SLOAD_H(nxt.K, nxt.V, kbn); SBAR();
#pragma unroll
        for (int d0 = 0; d0 < 8; ++d0) S.qr[d0] = load8<TIn>(nxt.Q + (size_t)(wid * QBLK + r32) * RS + d0 * 16 + hi * 8); }
    SBAR();
    finishSM(pA0, pA1, alA, l_reg, pa0, pa1, pa2, pa3); SBAR();
    if constexpr (F32) {
#pragma unroll
        for (int e = 8; e < 16; ++e) S.tq[e] = *(const f32x4*)QROW(e); SBAR(); }
#undef QROW
    pv_tile<0, SK>(o, vb0, pa0, pa1, pa2, pa3, ACT(even ? NT - 2 : NT - 1));
    if (even) { MASKT(pB0, pB1, NT - 1); partialSM(pB0, pB1, m_reg, mnB, alB); __syncthreads(); RESC(alB);
        finishSM(pB0, pB1, alB, l_reg, pa0, pa1, pa2, pa3); SBAR(); pv_tile<1, SK>(o, vb0, pa0, pa1, pa2, pa3, ACT(NT - 1)); }
    SBAR(); SEAM_K0();
    if (hi == 0) li_l[r32] = l_reg; asm volatile("s_waitcnt lgkmcnt(0)" ::: "memory");
    float rli[16];
#pragma unroll
    for (int r = 0; r < 16; ++r) rli[r] = __builtin_amdgcn_rcpf(li_l[crow(r, hi)]);
    TOut* Ow = cur.O + (size_t)(wid * QBLK) * RS;
#pragma unroll
    for (int r = 0; r < 16; ++r) { const int orow = crow(r, hi);
#pragma unroll
        for (int d0 = 0; d0 < 4; ++d0) { const float v = o[d0][r] * rli[r];
            if constexpr (same_t<TOut, float>::v) { Ow[(size_t)orow * RS + d0 * 32 + r32] = v; }
            else { const float vn = __shfl_xor(v, 1);
                   if ((r32 & 1) == 0) *(unsigned*)(Ow + (size_t)orow * RS + d0 * 32 + r32) = cvtpk(v, vn); } } }
    if constexpr (F32) {
#pragma unroll
        for (int d0 = 0; d0 < 8; ++d0) S.qr[d0] = pack8(S.tq[2 * d0], S.tq[2 * d0 + 1]); }
    __syncthreads();
#undef RESC
#undef KBASE
#undef ACT
#undef MASKT
#undef SEAM_K0
#undef HALF_STEP
}
#undef ROW
#undef VMW
#undef VMWN
#undef SLOAD_H
#undef SWRITE_HK
#undef SWRITE_HV
#undef SWRITE_H
#undef SLOAD_F
#undef SWRITE_KF
#undef SWRITE_VF
}
#ifndef MK_SPLIT
#define MK_SPLIT 0
#endif
#define LAS __attribute__((address_space(3)))
typedef unsigned short bf16_t;
typedef float v4f __attribute__((ext_vector_type(4)));
typedef float v2f __attribute__((ext_vector_type(2)));
typedef unsigned v4u __attribute__((ext_vector_type(4)));
typedef unsigned v2u __attribute__((ext_vector_type(2)));
typedef short h8 __attribute__((ext_vector_type(8)));

constexpr int DM = 2048, SEQ = 8192, NMETA = 16, NH = 8, HD = 128, DATT = 1024, DSSM = 1024, NG = 64, NP = 64, DFF = 5632, NIN = 8200;
constexpr int MREAL = 2 * SEQ;
constexpr int MROWS = MREAL + NMETA;
constexpr int RPAD = 16640;
constexpr int PPOS = 8256;
constexpr float EPS = 1e-6f;
constexpr float INV_SCALE = 11.313708498984761f;
constexpr int LDS_BYTES = 147456;

constexpr size_t MiB = 1u << 20;
constexpr size_t OFF_WT_UP = 0, OFF_WT_DOWN = 44 * MiB, OFF_WT_OUT = 66 * MiB, OFF_WT_IN = 74 * MiB, OFF_WT_O = 106 * MiB, OFF_WT_GLU = 110 * MiB;
constexpr size_t OFF_KT = 118 * MiB, OFF_WTS = 120 * MiB, OFF_VTS = 136 * MiB, OFF_MISC = 152 * MiB;
constexpr size_t OFF_GP = OFF_MISC, OFF_RSTD0 = OFF_MISC + 640 * 1024, OFF_SUMSQ1 = OFF_MISC + 768 * 1024, OFF_SUMSQ2 = OFF_MISC + 896 * 1024,
                 OFF_LF = OFF_MISC + 1024 * 1024, OFF_BIAS = OFF_MISC + 1664 * 1024, OFF_GP2 = OFF_MISC + 2560 * 1024, OFF_BAR = OFF_MISC + 3072 * 1024;
constexpr size_t OFF_H0B = 156 * MiB, OFF_OB = 156 * MiB, OFF_YG = OFF_OB + (size_t)RPAD * 1024 * 2;
constexpr size_t OFF_Q = 221 * MiB, OFF_K = 254 * MiB, OFF_V = 287 * MiB, OFF_UB = 320 * MiB, OFF_SGA = 353 * MiB, OFF_SGB = 418 * MiB;
constexpr size_t OFF_M1 = 221 * MiB, OFF_MERGED = 286 * MiB, OFF_H1B = 74 * MiB, OFF_G = 156 * MiB, OFF_U = 333 * MiB;
constexpr size_t WS_NEED = OFF_U + (size_t)MROWS * DFF * 2;
static_assert(WS_NEED <= 512 * MiB, "ws map");
static_assert(OFF_YG + (size_t)RPAD * 1024 * 2 <= OFF_Q && OFF_G + (size_t)MROWS * DFF * 2 <= OFF_U, "ws map 2");

struct Args { const float* in[22]; float* out; unsigned char* ws; int ph_lo, ph_hi; };
static_assert(sizeof(Args) == 22 * 8 + 8 + 8 + 8, "no padding");
enum { I_X = 0, I_META, I_GMIX, I_WIN, I_BF, I_LRE, I_LIM, I_LOGDT, I_BRE, I_BIM, I_CRE, I_CIM, I_DSKIP, I_WGLU, I_WATTO, I_WOUT, I_GFFN, I_WUP, I_CONVW, I_CONVB, I_WDOWN, I_GFINAL };

__device__ __forceinline__ float bf2f(unsigned short h) { return __uint_as_float((unsigned)h << 16); }
__device__ __forceinline__ float bflo(unsigned w) { return __uint_as_float(w << 16); }
__device__ __forceinline__ float bfhi(unsigned w) { return __uint_as_float(w & 0xffff0000u); }
__device__ __forceinline__ unsigned pk2(float lo, float hi) { return pg8::cvt_pk_bf16(lo, hi); }
__device__ __forceinline__ unsigned pk2n(float lo, float hi) { unsigned r; asm("v_cvt_pk_bf16_f32 %0, %1, %2" : "=v"(r) : "v"(lo), "v"(hi)); return r; }
__device__ __forceinline__ float sigmoidf_(float x) { return __builtin_amdgcn_rcpf(1.f + __expf(-x)); }
__device__ __forceinline__ float gelu_tanh(float x) { const float u = 0.7978845608028654f * (x + 0.044715f * x * x * x); return x * sigmoidf_(2.f * u); }
__device__ __forceinline__ float wave_sum(float v) {
#pragma unroll
    for (int o = 1; o < 64; o <<= 1) v += __shfl_xor(v, o);
    return v;
}
#define LDS_WAIT() asm volatile("s_waitcnt lgkmcnt(0)" ::: "memory")
#if defined(__HIP_DEVICE_COMPILE__)
#define KARG_PTR(p_) unsigned long long p_ = (unsigned long long)__builtin_amdgcn_kernarg_segment_ptr(); asm volatile("" : "+s"(p_))
#define LOAD_ARGS(name) Args name; { KARG_PTR(p_); name = *(const __attribute__((address_space(4))) Args*)p_; } unsigned char* ws = name.ws
__device__ __forceinline__ bool ph_in(int k) { KARG_PTR(p_); const __attribute__((address_space(4))) Args* q = (const __attribute__((address_space(4))) Args*)p_; return q->ph_lo <= k && k < q->ph_hi; }
#else
#define LOAD_ARGS(name) Args name{}; unsigned char* ws = name.ws
__device__ __forceinline__ bool ph_in(int k) { return false; }
#endif

__device__ __forceinline__ void tr_item(const float* __restrict__ W, int K, int Nsrc, int nsrc0, bf16_t* __restrict__ WT, int ndst0, int k0, const float* __restrict__ ksc, LAS float* scr, int lane) {
    const float* src = W + (size_t)k0 * Nsrc + nsrc0 + lane;
    float v[64];
#pragma unroll
    for (int i = 0; i < 64; ++i) v[i] = __builtin_nontemporal_load(src + (size_t)i * Nsrc);
    if (ksc) { const float sc = ksc[k0 + lane];
#pragma unroll
        for (int i = 0; i < 64; ++i) v[i] *= __uint_as_float(__builtin_amdgcn_readlane(__float_as_uint(sc), i)); }
#pragma unroll
    for (int i = 0; i < 64; ++i) scr[i * 65 + lane] = v[i];
    LDS_WAIT(); asm volatile("" ::: "memory");
    const int c = lane & 7;
#pragma unroll
    for (int j = 0; j < 8; ++j) { const int n = (lane >> 3) + 8 * j; const LAS float* q = scr + (8 * c) * 65 + n;
        v4u o; o.x = pk2(q[0 * 65], q[1 * 65]); o.y = pk2(q[2 * 65], q[3 * 65]); o.z = pk2(q[4 * 65], q[5 * 65]); o.w = pk2(q[6 * 65], q[7 * 65]);
        *(v4u*)(WT + (size_t)(ndst0 + n) * K + k0 + 8 * c) = o; }
    LDS_WAIT(); asm volatile("" ::: "memory");
}
__device__ __forceinline__ int ilv_src(int n, int half) { const int t = n >> 8, w = n & 255; return w < 128 ? 128 * t + w : half + 128 * t + (w - 128); }

__device__ __forceinline__ void p0_transposes(const Args& a, LAS unsigned char* lds, int gw, int NGW, int wid, int lane) {
    LAS float* scr = (LAS float*)(lds + wid * 16640);
    unsigned char* ws = a.ws;
    constexpr int I_IN = (DM / 64) * (8192 / 64), I_O = (DATT / 64) * (DM / 64), I_GLU = (DSSM / 64) * (4096 / 64), I_OUT = (DM / 64) * (DM / 64), I_UP = (DM / 64) * (2 * DFF / 64), I_DN = (DFF / 64) * (DM / 64);
    constexpr int NIT = I_IN + I_O + I_GLU + I_OUT + I_UP + I_DN;
    for (int it = gw; it < NIT; it += NGW) {
        int r = it;
        if (r < I_UP) { const int nb = r % (2 * DFF / 64), kb = r / (2 * DFF / 64), nd = 64 * nb; tr_item(a.in[I_WUP], DM, 2 * DFF, ilv_src(nd, DFF), (bf16_t*)(ws + OFF_WT_UP), nd, 64 * kb, a.in[I_GFFN], scr, lane); continue; } r -= I_UP;
        if (r < I_IN) { const int nb = r % 128, kb = r / 128, nd = 64 * nb; tr_item(a.in[I_WIN], DM, NIN, nd < 3072 ? nd : nd + 8, (bf16_t*)(ws + OFF_WT_IN), nd, 64 * kb, a.in[I_GMIX], scr, lane); continue; } r -= I_IN;
        if (r < I_DN) { const int nb = r % 32, kb = r / 32; tr_item(a.in[I_WDOWN], DFF, DM, 64 * nb, (bf16_t*)(ws + OFF_WT_DOWN), 64 * nb, 64 * kb, nullptr, scr, lane); continue; } r -= I_DN;
        if (r < I_GLU) { const int nb = r % 64, kb = r / 64, nd = 64 * nb; tr_item(a.in[I_WGLU], DSSM, 4096, ilv_src(nd, 2048), (bf16_t*)(ws + OFF_WT_GLU), nd, 64 * kb, nullptr, scr, lane); continue; } r -= I_GLU;
        if (r < I_OUT) { const int nb = r % 32, kb = r / 32; tr_item(a.in[I_WOUT], DM, DM, 64 * nb, (bf16_t*)(ws + OFF_WT_OUT), 64 * nb, 64 * kb, nullptr, scr, lane); continue; } r -= I_OUT;
        { const int nb = r % 32, kb = r / 32; tr_item(a.in[I_WATTO], DATT, DM, 64 * nb, (bf16_t*)(ws + OFF_WT_O), 64 * nb, 64 * kb, nullptr, scr, lane); }
    }
}

constexpr int WF_OFF = 69632;
__device__ __forceinline__ void p0_rows(const Args& a, LAS unsigned char* lds, int gw, int NGW, int lane) {
    unsigned char* ws = a.ws;
    LAS float* wf = (LAS float*)(lds + WF_OFF);
    bf16_t* H0B = (bf16_t*)(ws + OFF_H0B); float* RSTD0 = (float*)(ws + OFF_RSTD0); float* LF = (float*)(ws + OFF_LF);
    const float* bfp = a.in[I_BF];
    for (int r = gw; r < RPAD; r += NGW) {
        v2u* o8 = (v2u*)(H0B + (size_t)r * DM) + lane;
        if (r >= MROWS) {
#pragma unroll
            for (int j = 0; j < 8; ++j) o8[64 * j] = (v2u){0u, 0u};
            if (lane == 0) RSTD0[r] = 0.f;
            continue;
        }
        const float* src = r < MREAL ? a.in[I_X] + (size_t)r * DM : a.in[I_META] + (size_t)(r - MREAL) * DM;
        const v4f* xr = (const v4f*)src + lane;
        v4f v[8]; float s2 = 0.f;
#pragma unroll
        for (int j = 0; j < 8; ++j) { v[j] = __builtin_nontemporal_load(xr + 64 * j); s2 += (v[j].x * v[j].x + v[j].y * v[j].y) + (v[j].z * v[j].z + v[j].w * v[j].w); }
        float f[8];
#pragma unroll
        for (int h = 0; h < 8; ++h) { float acc = 0.f;
#pragma unroll
            for (int j = 0; j < 8; ++j) { const v4f w = *(const LAS v4f*)(wf + h * 2048 + 256 * j + 4 * lane); acc += (v[j].x * w.x + v[j].y * w.y) + (v[j].z * w.z + v[j].w * w.w); }
            f[h] = acc; }
        s2 = wave_sum(s2);
        const float rstd = 1.0f / sqrtf(s2 * (1.f / DM) + EPS);
#pragma unroll
        for (int h = 0; h < 8; ++h) f[h] = wave_sum(f[h]);
#pragma unroll
        for (int j = 0; j < 8; ++j) o8[64 * j] = (v2u){pk2(v[j].x, v[j].y), pk2(v[j].z, v[j].w)};
        if (lane == 0) RSTD0[r] = rstd;
        if (lane < 8) {
            float fv = f[0];
#pragma unroll
            for (int h = 1; h < 8; ++h) fv = (lane == h) ? f[h] : fv;
            const float y = fv * rstd + bfp[lane];
            const float lf = fminf(y, 0.f) - log1pf(__expf(-fabsf(y)));
            if (r < MREAL) { const int b = r >> 13, i = r & 8191; LF[(size_t)(b * 8 + lane) * PPOS + 64 + i] = lf; }
            else { const int j = r - MREAL; LF[(size_t)lane * PPOS + 48 + j] = lf; LF[(size_t)(8 + lane) * PPOS + 48 + j] = lf; }
        }
    }
}

__device__ __forceinline__ void ssm_gen(LAS unsigned char* lds, int g, int part, int tid) {
    LAS float* TBr = (LAS float*)lds; LAS float* TBi = TBr + 65 * 64; LAS float* BBr = TBi + 65 * 64; LAS float* BBi = BBr + 1024; LAS float* CTr = BBi + 1024; LAS float* CTi = CTr + 1024;
    LAS double* AZ = (LAS double*)(CTi + 1024);
    if (tid < 64) { LOAD_ARGS(a); (void)ws; const int p = tid;
        const double dt = exp((double)a.in[I_LOGDT][g]);
        const double lr = (double)a.in[I_LRE][g * 64 + p], li = (double)a.in[I_LIM][g * 64 + p];
        const double mag = exp(lr * dt); double sn, cs; sincos(li * dt, &sn, &cs);
        const double are = mag * cs, aim = mag * sn, den = lr * lr + li * li, nr = are - 1.0;
        AZ[4 * p] = are; AZ[4 * p + 1] = aim; AZ[4 * p + 2] = (nr * lr + aim * li) / den; AZ[4 * p + 3] = (aim * lr - nr * li) / den; }
    __syncthreads();
    { LOAD_ARGS(a); float* GP = (float*)(ws + OFF_GP) + (size_t)g * 2304;
#pragma unroll 1
      for (int e = tid; e < 65 * 64; e += 512) { const int j = e >> 6, p = e & 63;
        double br = AZ[4 * p], bi = AZ[4 * p + 1], rr = 1.0, ri = 0.0;
#pragma unroll
        for (int bit = 0; bit < 7; ++bit) { if ((j >> bit) & 1) { const double t = rr * br - ri * bi; ri = rr * bi + ri * br; rr = t; } const double t2 = br * br - bi * bi; bi = 2.0 * br * bi; br = t2; }
        TBr[e] = (float)rr; TBi[e] = (float)ri;
        if (part == 0 && j == 1) { GP[p] = (float)rr; GP[64 + p] = (float)ri; }
        if (part == 0 && j == 64) { GP[128 + p] = (float)rr; GP[192 + p] = (float)ri; }
        if (part == 0 && (j == 16 || j == 32 || j == 48)) { float* G2 = (float*)(ws + OFF_GP2) + (size_t)g * 384 + ((j >> 4) - 1) * 128 + 2 * p; G2[0] = (float)rr; G2[1] = (float)ri; } }
#pragma unroll 1
      for (int e = tid; e < 1024; e += 512) { const int p = e >> 4; const double zr = AZ[4 * p + 2], zi = AZ[4 * p + 3];
        const double br = (double)a.in[I_BRE][(size_t)g * 1024 + e], bi = (double)a.in[I_BIM][(size_t)g * 1024 + e];
        const float bbr = (float)(zr * br - zi * bi), bbi = (float)(zr * bi + zi * br);
        BBr[e] = bbr; BBi[e] = bbi; if (part == 0) { GP[256 + e] = bbr; GP[1280 + e] = bbi; } }
#pragma unroll 1
      for (int e = tid; e < 1024; e += 512) { const int co = e >> 6, p = e & 63;
        CTr[p * 16 + co] = a.in[I_CRE][(size_t)g * 1024 + e]; CTi[p * 16 + co] = a.in[I_CIM][(size_t)g * 1024 + e]; } }
    __syncthreads();
    { LOAD_ARGS(a); (void)a; bf16_t* KT = (bf16_t*)(ws + OFF_KT) + (size_t)g * 16384;
      const int pair = tid & 255, co = pair >> 4, ci = pair & 15, j0 = 16 * part + 8 * (tid >> 8); float acc[8];
#pragma unroll
      for (int jj = 0; jj < 8; ++jj) acc[jj] = 0.f;
#pragma unroll 4
      for (int p = 0; p < 64; ++p) { const float cr = CTr[p * 16 + co], cim = CTi[p * 16 + co], br = BBr[p * 16 + ci], bi = BBi[p * 16 + ci], wr = cr * br - cim * bi, wi = cr * bi + cim * br;
#pragma unroll
          for (int jj = 0; jj < 8; ++jj) acc[jj] += wr * TBr[(j0 + jj) * 64 + p] - wi * TBi[(j0 + jj) * 64 + p]; }
#pragma unroll
      for (int jj = 0; jj < 8; ++jj) KT[(j0 + jj) * 256 + pair] = (bf16_t)(pk2(acc[jj], 0.f) & 0xffffu); }
    { LOAD_ARGS(a); (void)a; bf16_t* WTS = (bf16_t*)(ws + OFF_WTS) + (size_t)g * 131072;
#pragma unroll 1
      for (int it = 1024 * part + tid; it < 1024 * (part + 1); it += 512) { const int n = it >> 5, k8 = 96 + (it & 31), p = n >> 1, ri = n & 1, sx = k8 >> 1, c0 = (k8 & 1) * 8;
        const float tr = TBr[(63 - sx) * 64 + p], ti = TBi[(63 - sx) * 64 + p]; float v[8];
#pragma unroll
        for (int e = 0; e < 8; ++e) { const float br = BBr[p * 16 + c0 + e], bi = BBi[p * 16 + c0 + e]; v[e] = ri ? (tr * bi + ti * br) : (tr * br - ti * bi); }
        *(v4u*)(WTS + (size_t)n * 1024 + 8 * k8) = (v4u){pk2(v[0], v[1]), pk2(v[2], v[3]), pk2(v[4], v[5]), pk2(v[6], v[7])}; } }
    { LOAD_ARGS(a); (void)a; bf16_t* VTS = (bf16_t*)(ws + OFF_VTS) + (size_t)g * 131072;
#pragma unroll 1
      for (int it = 1024 * part + tid; it < 1024 * (part + 1); it += 512) { const int n = it >> 4, k8 = it & 15, t = n >> 4, co = n & 15; float v[8];
#pragma unroll
        for (int e = 0; e < 4; ++e) { const int p = 4 * k8 + e; const float tr = TBr[(t + 1) * 64 + p], ti = TBi[(t + 1) * 64 + p], cr = CTr[p * 16 + co], ci = CTi[p * 16 + co];
            v[2 * e] = cr * tr - ci * ti; v[2 * e + 1] = -(cr * ti + ci * tr); }
        *(v4u*)(VTS + (size_t)n * 128 + 8 * k8) = (v4u){pk2(v[0], v[1]), pk2(v[2], v[3]), pk2(v[4], v[5]), pk2(v[6], v[7])}; } }
    __syncthreads();
}

__device__ __forceinline__ void cumsum_seq(const Args& a, LAS unsigned char* lds, int seq, int tid) {
    const float* LF = (const float*)(a.ws + OFF_LF) + (size_t)seq * PPOS; float* BI = (float*)(a.ws + OFF_BIAS) + (size_t)seq * PPOS;
    LAS float* wsum = (LAS float*)lds;
    const int base = 48 + 17 * tid; float s = 0.f; float v[17];
#pragma unroll
    for (int i = 0; i < 17; ++i) v[i] = (base + i < PPOS) ? LF[base + i] : 0.f;
#pragma unroll
    for (int i = 0; i < 17; ++i) s += v[i];
    float inc = s;
#pragma unroll
    for (int o = 1; o < 64; o <<= 1) { const float t = __shfl_up(inc, o); if ((tid & 63) >= o) inc += t; }
    if ((tid & 63) == 63) wsum[tid >> 6] = inc;
    __syncthreads();
    float off = 0.f;
    for (int w = 0; w < (tid >> 6); ++w) off += wsum[w];
    float run = off + inc - s;
#pragma unroll
    for (int i = 0; i < 17; ++i) { run += v[i]; if (base + i < PPOS) BI[base + i] = -run * INV_SCALE; }
    if (tid < 48) BI[tid] = -__builtin_inff();
    __syncthreads();
}

struct EpiZ {
    static constexpr bool PERM = true, AFTER_DRAIN = false;
    const float* rstd; bf16_t *Q, *K, *V, *U, *SGA, *SGB;
    __device__ __forceinline__ void operator()(const pg8::f32x4 (&acc)[2][2][4][2], const pg8::Unit& u, int wr, int wc, int fr, int fq) const {
        const int pn = u.pn, sec = pn < 16 ? (pn >> 2) : (pn < 24 ? 4 : 5), colt = (pn < 16 ? (pn & 3) : (pn & 7)) * 256 + wc * 32 + 8 * fq;
        bf16_t* base = sec == 0 ? Q : (sec == 1 ? K : (sec == 2 ? V : (sec == 3 ? U : (sec == 4 ? SGA : SGB))));
        const int ld = sec >= 4 ? 2048 : 1024; const bool pos = sec >= 1 && sec <= 3, sg = sec >= 4;
#pragma unroll
        for (int ai = 0; ai < 2; ++ai)
#pragma unroll
            for (int m = 0; m < 4; ++m) { const int row = u.pm * 256 + ai * 128 + wr * 64 + m * 16 + fr; const float rs = rstd[row];
                int d1 = row, d2 = -1;
                if (pos) { const int j = row - MREAL; d1 = j < 0 ? (row >> 13) * PPOS + 64 + (row & 8191) : (j < NMETA ? 48 + j : -1); d2 = (j >= 0 && j < NMETA) ? PPOS + 48 + j : -1; }
#pragma unroll
                for (int bj = 0; bj < 2; ++bj) { const int col = colt + bj * 128; pg8::f32x4 v0 = acc[ai][bj][m][0] * rs, v1 = acc[ai][bj][m][1] * rs;
                    if (sg) { v0[0] = sigmoidf_(v0[0]); v0[1] = sigmoidf_(v0[1]); v0[2] = sigmoidf_(v0[2]); v0[3] = sigmoidf_(v0[3]); v1[0] = sigmoidf_(v1[0]); v1[1] = sigmoidf_(v1[1]); v1[2] = sigmoidf_(v1[2]); v1[3] = sigmoidf_(v1[3]); }
                    const v4u w = {pk2n(v0[0], v0[1]), pk2n(v0[2], v0[3]), pk2n(v1[0], v1[1]), pk2n(v1[2], v1[3])};
                    if (d1 >= 0) *(v4u*)(base + (size_t)d1 * ld + col) = w;
                    if (d2 >= 0) *(v4u*)(base + (size_t)d2 * ld + col) = w; } }
    }
};
__device__ __forceinline__ void unpack8(const v4u w, float (&f)[8]) { f[0] = bflo(w.x); f[1] = bfhi(w.x); f[2] = bflo(w.y); f[3] = bfhi(w.y); f[4] = bflo(w.z); f[5] = bfhi(w.z); f[6] = bflo(w.w); f[7] = bfhi(w.w); }
struct EpiO {
    static constexpr bool PERM = true, AFTER_DRAIN = false;
    const bf16_t* SGB; bf16_t* M1;
    __device__ __forceinline__ void operator()(const pg8::f32x4 (&acc)[2][2][4][2], const pg8::Unit& u, int wr, int wc, int fr, int fq) const {
        const size_t off0 = (size_t)(u.pm * 256 + wr * 64 + fr) * 2048 + u.pn * 256 + wc * 32 + 8 * fq;
        v4u sg[2][4][2];
#pragma unroll
        for (int ai = 0; ai < 2; ++ai)
#pragma unroll
            for (int m = 0; m < 4; ++m)
#pragma unroll
                for (int bj = 0; bj < 2; ++bj) sg[ai][m][bj] = *(const v4u*)(SGB + off0 + (size_t)(ai * 128 + m * 16) * 2048 + bj * 128);
#pragma unroll
        for (int ai = 0; ai < 2; ++ai)
#pragma unroll
            for (int m = 0; m < 4; ++m)
#pragma unroll
                for (int bj = 0; bj < 2; ++bj) { float sf[8]; unpack8(sg[ai][m][bj], sf); const pg8::f32x4 v0 = acc[ai][bj][m][0], v1 = acc[ai][bj][m][1];
                    *(v4u*)(M1 + off0 + (size_t)(ai * 128 + m * 16) * 2048 + bj * 128) = (v4u){pk2n(v0[0] * sf[0], v0[1] * sf[1]), pk2n(v0[2] * sf[2], v0[3] * sf[3]), pk2n(v1[0] * sf[4], v1[1] * sf[5]), pk2n(v1[2] * sf[6], v1[3] * sf[7])}; }
    }
};
struct EpiGlu {
    static constexpr bool PERM = true, AFTER_DRAIN = false;
    const bf16_t* SGA; const bf16_t* M1; bf16_t* MG;
    __device__ __forceinline__ void operator()(const pg8::f32x4 (&acc)[2][2][4][2], const pg8::Unit& u, int wr, int wc, int fr, int fq) const {
        const size_t off0 = (size_t)(u.pm * 256 + wr * 64 + fr) * 2048 + u.pn * 128 + wc * 32 + 8 * fq;
        v4u gav[2][4], m1v[2][4];
#pragma unroll
        for (int ai = 0; ai < 2; ++ai)
#pragma unroll
            for (int m = 0; m < 4; ++m) { const size_t off = off0 + (size_t)(ai * 128 + m * 16) * 2048; gav[ai][m] = *(const v4u*)(SGA + off); m1v[ai][m] = *(const v4u*)(M1 + off); }
#pragma unroll
        for (int ai = 0; ai < 2; ++ai)
#pragma unroll
            for (int m = 0; m < 4; ++m) { float ga[8], m1[8], o[8]; unpack8(gav[ai][m], ga); unpack8(m1v[ai][m], m1);
#pragma unroll
                for (int e = 0; e < 8; ++e) { const float ya = acc[ai][0][m][e >> 2][e & 3], yb = acc[ai][1][m][e >> 2][e & 3]; o[e] = m1[e] + ga[e] * ya * sigmoidf_(yb); }
                *(v4u*)(MG + off0 + (size_t)(ai * 128 + m * 16) * 2048) = (v4u){pk2n(o[0], o[1]), pk2n(o[2], o[3]), pk2n(o[4], o[5]), pk2n(o[6], o[7])}; }
    }
};
struct EpiOut {
    static constexpr bool PERM = true, AFTER_DRAIN = false;
    const float* X; float* OUT; bf16_t* H1B; float* SS;
    __device__ __forceinline__ void operator()(const pg8::f32x4 (&acc)[2][2][4][2], const pg8::Unit& u, int wr, int wc, int fr, int fq) const {
#pragma unroll
        for (int ai = 0; ai < 2; ++ai) { const size_t off0 = (size_t)(u.pm * 256 + ai * 128 + wr * 64 + fr) * DM + u.pn * 256 + wc * 32 + 8 * fq;
            pg8::f32x4 h0[4][2][2];
#pragma unroll
            for (int m = 0; m < 4; ++m)
#pragma unroll
                for (int bj = 0; bj < 2; ++bj) { const float* p = X + off0 + (size_t)(m * 16) * DM + bj * 128; h0[m][bj][0] = *(const pg8::f32x4*)p; h0[m][bj][1] = *(const pg8::f32x4*)(p + 4); }
#pragma unroll
            for (int m = 0; m < 4; ++m) { float ss = 0.f;
#pragma unroll
                for (int bj = 0; bj < 2; ++bj) { const size_t off = off0 + (size_t)(m * 16) * DM + bj * 128; const pg8::f32x4 v0 = acc[ai][bj][m][0] + h0[m][bj][0], v1 = acc[ai][bj][m][1] + h0[m][bj][1];
                    *(pg8::f32x4*)(OUT + off) = v0; *(pg8::f32x4*)(OUT + off + 4) = v1;
                    *(v4u*)(H1B + off) = (v4u){pk2n(v0[0], v0[1]), pk2n(v0[2], v0[3]), pk2n(v1[0], v1[1]), pk2n(v1[2], v1[3])};
                    ss += (v0[0] * v0[0] + v0[1] * v0[1]) + (v0[2] * v0[2] + v0[3] * v0[3]) + (v1[0] * v1[0] + v1[1] * v1[1]) + (v1[2] * v1[2] + v1[3] * v1[3]); }
                ss += __shfl_xor(ss, 16); ss += __shfl_xor(ss, 32);
                if (fq == 0) atomicAdd(SS + u.pm * 256 + ai * 128 + wr * 64 + m * 16 + fr, ss); } }
    }
};
struct EpiUp {
    static constexpr bool PERM = true, AFTER_DRAIN = false;
    const float* SS; bf16_t* G; bf16_t* U; const float* CW; const float* CB;
    __device__ __forceinline__ void operator()(const pg8::f32x4 (&acc)[2][2][4][2], const pg8::Unit& u, int wr, int wc, int fr, int fq) const {
        const int oc = u.pn * 128 + wc * 32 + 8 * fq, lm1 = (fq << 4) | ((fr - 1) & 15), lm2 = (fq << 4) | ((fr - 2) & 15);
        float w0[8], w1[8], w2[8], cb[8];
#pragma unroll
        for (int h = 0; h < 2; ++h) { const v4f x0 = *(const v4f*)(CW + oc + 4 * h), x1 = *(const v4f*)(CW + DFF + oc + 4 * h), x2 = *(const v4f*)(CW + 2 * DFF + oc + 4 * h), x3 = *(const v4f*)(CB + oc + 4 * h);
#pragma unroll
            for (int e = 0; e < 4; ++e) { w0[4 * h + e] = x0[e]; w1[4 * h + e] = x1[e]; w2[4 * h + e] = x2[e]; cb[4 * h + e] = x3[e]; } }
#pragma unroll
        for (int ai = 0; ai < 2; ++ai) { const int rbase = u.pm * 256 + ai * 128 + wr * 64; float gs[4][8], rs[4];
#pragma unroll
            for (int m = 0; m < 4; ++m) { rs[m] = 1.0f / sqrtf(SS[rbase + 16 * m + fr] * (1.f / DM) + EPS);
#pragma unroll
                for (int e = 0; e < 8; ++e) gs[m][e] = acc[ai][0][m][e >> 2][e & 3] * rs[m]; }
#pragma unroll
            for (int m = 0; m < 4; ++m) { const size_t off = (size_t)(rbase + 16 * m + fr) * DFF + oc; float o[8];
#pragma unroll
                for (int e = 0; e < 8; ++e) { const float a1 = __shfl(gs[m][e], lm1), a2 = __shfl(gs[m][e], lm2); float b1 = 0.f, b2 = 0.f;
                    if (m > 0) { b1 = __shfl(gs[m - 1][e], lm1); b2 = __shfl(gs[m - 1][e], lm2); }
                    const float p1 = fr >= 1 ? a1 : b1, p2 = fr >= 2 ? a2 : b2, gc = cb[e] + w0[e] * p2 + w1[e] * p1 + w2[e] * gs[m][e];
                    o[e] = gc * sigmoidf_(gc) * (acc[ai][1][m][e >> 2][e & 3] * rs[m]); }
                const v4u gw = {pk2n(gs[m][0], gs[m][1]), pk2n(gs[m][2], gs[m][3]), pk2n(gs[m][4], gs[m][5]), pk2n(gs[m][6], gs[m][7])};
                if (m == 0 && fr < 2) {
                    const pg8::f32x4 u0 = acc[ai][1][m][0] * rs[m], u1 = acc[ai][1][m][1] * rs[m];
                    *(v4u*)(G + off) = gw; *(v4u*)(U + off) = (v4u){pk2n(u0[0], u0[1]), pk2n(u0[2], u0[3]), pk2n(u1[0], u1[1]), pk2n(u1[2], u1[3])}; }
                else { *(v4u*)(U + off) = (v4u){pk2n(o[0], o[1]), pk2n(o[2], o[3]), pk2n(o[4], o[5]), pk2n(o[6], o[7])}; if (m == 3 && fr >= 14) *(v4u*)(G + off) = gw; } } }
    }
};
struct EpiDown {
    static constexpr bool PERM = true, AFTER_DRAIN = false;
    float* OUT; float* SS;
    __device__ __forceinline__ void operator()(const pg8::f32x4 (&acc)[2][2][4][2], const pg8::Unit& u, int wr, int wc, int fr, int fq) const {
#pragma unroll
        for (int ai = 0; ai < 2; ++ai) { const size_t off0 = (size_t)(u.pm * 256 + ai * 128 + wr * 64 + fr) * DM + u.pn * 256 + wc * 32 + 8 * fq;
            pg8::f32x4 h1[4][2][2];
#pragma unroll
            for (int m = 0; m < 4; ++m)
#pragma unroll
                for (int bj = 0; bj < 2; ++bj) { const float* p = OUT + off0 + (size_t)(m * 16) * DM + bj * 128; h1[m][bj][0] = *(const pg8::f32x4*)p; h1[m][bj][1] = *(const pg8::f32x4*)(p + 4); }
#pragma unroll
            for (int m = 0; m < 4; ++m) { float ss = 0.f;
#pragma unroll
                for (int bj = 0; bj < 2; ++bj) { float* p = OUT + off0 + (size_t)(m * 16) * DM + bj * 128; const pg8::f32x4 v0 = acc[ai][bj][m][0] + h1[m][bj][0], v1 = acc[ai][bj][m][1] + h1[m][bj][1];
                    *(pg8::f32x4*)p = v0; *(pg8::f32x4*)(p + 4) = v1;
                    ss += (v0[0] * v0[0] + v0[1] * v0[1]) + (v0[2] * v0[2] + v0[3] * v0[3]) + (v1[0] * v1[0] + v1[1] * v1[1]) + (v1[2] * v1[2] + v1[3] * v1[3]); }
                ss += __shfl_xor(ss, 16); ss += __shfl_xor(ss, 32);
                if (fq == 0) atomicAdd(SS + u.pm * 256 + ai * 128 + wr * 64 + m * 16 + fr, ss); } }
    }
};

struct ChainOrder {
    pg8::StaticOrder base; const char *A0, *B0, *A1, *B1;
    __device__ void init(int M, int G_, int c_) { base.init(M, DM, G_, c_); }
    __device__ bool next(int i, pg8::Unit& u) const { pg8::Unit t; const int ti = i / 3, k = i - 3 * ti; if (!base.next(ti, t)) return false; u.pm = t.pm; u.kind = k ? 1 : 0; u.pn = k ? 2 * t.pn + (k - 1) : t.pn; return true; }
    template <class G_> __device__ __forceinline__ const char* abase(const G_&, const pg8::Unit& u) const { return u.kind ? A1 : A0; }
    template <class G_> __device__ __forceinline__ const char* bbase(const G_&, const pg8::Unit& u) const { return u.kind ? B1 : B0; }
    __device__ __forceinline__ void a_ready(const pg8::Unit&) const {}
    __device__ __forceinline__ void done(const pg8::Unit&) const {}
};
struct EpiOG {
    static constexpr bool PERM = true, AFTER_DRAIN = false;
    EpiO o; EpiGlu g;
    __device__ __forceinline__ void operator()(const pg8::f32x4 (&acc)[2][2][4][2], const pg8::Unit& u, int wr, int wc, int fr, int fq) const { if (u.kind == 0) o(acc, u, wr, wc, fr, fq); else g(acc, u, wr, wc, fr, fq); }
};

#define MFMA16(a, b, c) __builtin_amdgcn_mfma_f32_16x16x32_bf16(a, b, c, 0, 0, 0)
constexpr int SX_KT = 0, SX_W16 = 0, SX_HB = 32768, SX_Y = 69632, SX_TAB = 139264, SX_HSC = SX_TAB + 2048;
constexpr int W16ROW = 264, V16ROW = 136, SS_SROW = 132, SS_HROW = 136;
static_assert(SX_HB + 128 * SS_HROW * 2 <= SX_Y && 128 * W16ROW * 2 <= SX_Y && SX_Y + 256 * V16ROW * 2 <= SX_TAB && SX_Y + 128 * SS_SROW * 4 <= SX_TAB && SX_HSC + 512 <= LDS_BYTES, "ssm lds");
__device__ __forceinline__ void ssm_unit(const Args& a, LAS unsigned char* lds, int b, int g, int tid) {
    const int wid = __builtin_amdgcn_readfirstlane(tid >> 6), lane = tid & 63, fr = lane & 15, fq = lane >> 4;
    unsigned char* ws = a.ws;
    const bf16_t* UB = (const bf16_t*)(ws + OFF_UB) + (size_t)b * PPOS * 1024 + 16 * g;
    const float* GP = (const float*)(ws + OFF_GP) + (size_t)g * 2304;
    bf16_t* YG = (bf16_t*)(ws + OFF_YG);
    LAS float* Sst = (LAS float*)(lds + SX_Y); LAS bf16_t* Hb = (LAS bf16_t*)(lds + SX_HB); LAS float* hsc = (LAS float*)(lds + SX_HSC);
    LAS bf16_t* W16 = (LAS bf16_t*)(lds + SX_W16); LAS bf16_t* V16 = (LAS bf16_t*)(lds + SX_Y); LAS v2f* TAB = (LAS v2f*)(lds + SX_TAB);
    const bf16_t* ubw = UB + (size_t)(64 + 64 * (16 * wid + fr)) * 1024 + 8 * (fq & 1);
    h8 A[32];
#pragma unroll
    for (int ks = 0; ks < 32; ++ks) A[ks] = *(const h8*)(ubw + (size_t)(2 * ks + (fq >> 1)) * 1024);
    { const bf16_t* wsrc = (const bf16_t*)(ws + OFF_WTS) + (size_t)g * 131072 + 768;
#pragma unroll
      for (int i = 0; i < 8; ++i) { const int it = tid + 512 * i, n = it >> 5, c = it & 31; *(LAS v4u*)(W16 + n * W16ROW + 8 * c) = *(const v4u*)(wsrc + (size_t)n * 1024 + 8 * c); }
      if (tid < 192) TAB[64 + tid] = *(const v2f*)((const float*)(ws + OFF_GP2) + (size_t)g * 384 + 2 * tid); }
    float hr = 0.f, hi_ = 0.f;
    if (wid == 0) {
        const float are = GP[lane], aim = GP[64 + lane]; float bbr[16], bbi[16];
#pragma unroll
        for (int q = 0; q < 4; ++q) { const v4f r4 = *(const v4f*)(GP + 256 + lane * 16 + 4 * q), i4 = *(const v4f*)(GP + 1280 + lane * 16 + 4 * q);
            bbr[4 * q] = r4.x; bbr[4 * q + 1] = r4.y; bbr[4 * q + 2] = r4.z; bbr[4 * q + 3] = r4.w; bbi[4 * q] = i4.x; bbi[4 * q + 1] = i4.y; bbi[4 * q + 2] = i4.z; bbi[4 * q + 3] = i4.w; }
        const v2u uw_ = *(const v2u*)(UB + (size_t)(48 + (lane >> 2)) * 1024 + 4 * (lane & 3));
#pragma unroll 1
        for (int t = 0; t < 16; ++t) {
            float br = 0.f, bi = 0.f;
#pragma unroll
            for (int c4 = 0; c4 < 4; ++c4) { const unsigned sx = __builtin_amdgcn_readlane(uw_.x, 4 * t + c4), sy = __builtin_amdgcn_readlane(uw_.y, 4 * t + c4);
                const float u0 = bflo(sx), u1 = bfhi(sx), u2 = bflo(sy), u3 = bfhi(sy);
                br += bbr[4 * c4] * u0 + bbr[4 * c4 + 1] * u1 + bbr[4 * c4 + 2] * u2 + bbr[4 * c4 + 3] * u3;
                bi += bbi[4 * c4] * u0 + bbi[4 * c4 + 1] * u1 + bbi[4 * c4 + 2] * u2 + bbi[4 * c4 + 3] * u3; }
            const float nr = are * hr - aim * hi_ + br, ni = are * hi_ + aim * hr + bi; hr = nr; hi_ = ni;
            if (b == 0 && t >= 14) {
                hsc[2 * lane] = hr; hsc[2 * lane + 1] = hi_; LDS_WAIT(); asm volatile("" ::: "memory");
                if (lane < 16) { const float* cr = a.in[I_CRE] + ((size_t)g * 16 + lane) * 64; const float* ci = a.in[I_CIM] + ((size_t)g * 16 + lane) * 64; float y = 0.f;
#pragma unroll 16
                    for (int p = 0; p < 64; ++p) y += cr[p] * hsc[2 * p] - ci[p] * hsc[2 * p + 1];
                    y += a.in[I_DSKIP][16 * g + lane] * bf2f(UB[(size_t)(48 + t) * 1024 + lane]);
                    YG[(size_t)(MREAL + t) * 1024 + 16 * g + lane] = (bf16_t)(pk2(gelu_tanh(y), 0.f) & 0xffffu); }
                LDS_WAIT(); asm volatile("" ::: "memory");
            }
        }
    }
    __syncthreads();
#pragma unroll
    for (int nt = 0; nt < 8; ++nt) { pg8::f32x4 srun = {0.f, 0.f, 0.f, 0.f};
#pragma unroll
        for (int sub = 0; sub < 4; ++sub) { pg8::f32x4 ac = {0.f, 0.f, 0.f, 0.f};
#pragma unroll
            for (int kk = 0; kk < 8; ++kk) { const h8 B = *(const LAS h8*)(W16 + (16 * nt + fr) * W16ROW + 32 * kk + 8 * fq); ac = MFMA16(B, A[8 * sub + kk], ac); }
            if (sub == 0) srun = ac;
            else { const v2f f0 = TAB[64 + 8 * nt + 2 * fq], f1 = TAB[64 + 8 * nt + 2 * fq + 1]; const pg8::f32x4 o = srun;
                srun = (pg8::f32x4){f0.x * o[0] - f0.y * o[1] + ac[0], f0.x * o[1] + f0.y * o[0] + ac[1], f1.x * o[2] - f1.y * o[3] + ac[2], f1.x * o[3] + f1.y * o[2] + ac[3]}; } }
        *(LAS pg8::f32x4*)(Sst + (16 * wid + fr) * SS_SROW + 16 * nt + 4 * fq) = srun; }
    __syncthreads();
    { const v4u* src = (const v4u*)((const bf16_t*)(ws + OFF_KT) + (size_t)g * 16384); LAS v4u* dst = (LAS v4u*)(lds + SX_KT);
#pragma unroll
      for (int i = 0; i < 4; ++i) dst[tid + 512 * i] = src[tid + 512 * i]; }
    if (wid == 0) { const float a64r = GP[128 + lane], a64i = GP[192 + lane];
        for (int c = 0; c < 128; ++c) { *(LAS unsigned*)(Hb + c * SS_HROW + 2 * lane) = pk2(hr, hi_); const v2f sv = *(const LAS v2f*)(Sst + c * SS_SROW + 2 * lane);
            const float nr = a64r * hr - a64i * hi_ + sv.x, ni = a64r * hi_ + a64i * hr + sv.y; hr = nr; hi_ = ni; } }
    __syncthreads();
    { const bf16_t* vsrc = (const bf16_t*)(ws + OFF_VTS) + (size_t)g * 131072;
#pragma unroll
      for (int i = 0; i < 8; ++i) { const int it = tid + 512 * i, n = it >> 4, c = it & 15; *(LAS v4u*)(V16 + n * V16ROW + 8 * c) = *(const v4u*)(vsrc + (size_t)n * 128 + 8 * c); } }
    __syncthreads();
    const LAS bf16_t* KTl = (const LAS bf16_t*)(lds + SX_KT) + fr * 16 + 8 * (fq & 1);
    const v4f dv = *(const v4f*)(a.in[I_DSKIP] + 16 * g + 4 * fq);
#pragma unroll
    for (int q8 = 0; q8 < 8; ++q8) {
        pg8::f32x4 acc[8];
#pragma unroll
        for (int i = 0; i < 8; ++i) acc[i] = (pg8::f32x4){0.f, 0.f, 0.f, 0.f};
#pragma unroll
        for (int ks = 0; ks < 4 * q8 + 4; ++ks) {
#pragma unroll
            for (int i = 0; i < 8; ++i) { const int t = 8 * q8 + i, s0 = 2 * ks;
                if (t > s0) { const h8 B = *(const LAS h8*)(KTl + (t - s0 - (fq >> 1)) * 256); acc[i] = MFMA16(B, A[ks], acc[i]); }
                else if (t == s0) { h8 B = *(const LAS h8*)KTl; if (fq >> 1) B = (h8){0, 0, 0, 0, 0, 0, 0, 0}; acc[i] = MFMA16(B, A[ks], acc[i]); } } }
#pragma unroll
        for (int k2 = 0; k2 < 4; ++k2) { v4u hw = *(const LAS v4u*)(Hb + (16 * wid + fr) * SS_HROW + 32 * k2 + 8 * fq);
            if (q8 >= 2) { const LAS v2f* tb = TAB + 64 * (q8 >> 1) + 16 * k2 + 4 * fq; const v2f f0 = tb[0], f1 = tb[1], f2 = tb[2], f3 = tb[3];
                hw.x = pk2(f0.x * bflo(hw.x) - f0.y * bfhi(hw.x), f0.x * bfhi(hw.x) + f0.y * bflo(hw.x)); hw.y = pk2(f1.x * bflo(hw.y) - f1.y * bfhi(hw.y), f1.x * bfhi(hw.y) + f1.y * bflo(hw.y));
                hw.z = pk2(f2.x * bflo(hw.z) - f2.y * bfhi(hw.z), f2.x * bfhi(hw.z) + f2.y * bflo(hw.z)); hw.w = pk2(f3.x * bflo(hw.w) - f3.y * bfhi(hw.w), f3.x * bfhi(hw.w) + f3.y * bflo(hw.w)); }
            const h8 Ah = __builtin_bit_cast(h8, hw);
#pragma unroll
            for (int i = 0; i < 8; ++i) { const h8 B = *(const LAS h8*)(V16 + (16 * (8 * (q8 & 1) + i) + fr) * V16ROW + 32 * k2 + 8 * fq); acc[i] = MFMA16(B, Ah, acc[i]); } }
#pragma unroll
        for (int i = 0; i < 8; ++i) { const int tok = 64 * (16 * wid + fr) + 8 * q8 + i;
            const v2u uw = *(const v2u*)(UB + (size_t)(64 + tok) * 1024 + 4 * fq);
            const float y0 = acc[i][0] + dv.x * bflo(uw.x), y1 = acc[i][1] + dv.y * bfhi(uw.x), y2 = acc[i][2] + dv.z * bflo(uw.y), y3 = acc[i][3] + dv.w * bfhi(uw.y);
            *(v2u*)(YG + (size_t)(b * SEQ + tok) * 1024 + 16 * g + 4 * fq) = (v2u){pk2(gelu_tanh(y0), gelu_tanh(y1)), pk2(gelu_tanh(y2), gelu_tanh(y3))}; }
    }
    __syncthreads();
}

__device__ __forceinline__ void meta_attn(const Args& a, int tid) {
    const int h = tid >> 6, lane = tid & 63, qi = lane >> 2, part = lane & 3;
    unsigned char* ws = a.ws;
    const bf16_t* Qm = (const bf16_t*)(ws + OFF_Q) + (size_t)(MREAL + qi) * 1024 + h * 128 + 32 * part;
    const bf16_t* Km = (const bf16_t*)(ws + OFF_K) + (size_t)48 * 1024 + h * 128 + 32 * part;
    const bf16_t* Vm = (const bf16_t*)(ws + OFF_V) + (size_t)48 * 1024 + h * 128 + 32 * part;
    const float* BI = (const float*)(ws + OFF_BIAS) + (size_t)h * PPOS + 48;
    float q[32];
#pragma unroll
    for (int c = 0; c < 4; ++c) { float t8[8]; unpack8(*(const v4u*)(Qm + 8 * c), t8);
#pragma unroll
        for (int e = 0; e < 8; ++e) q[8 * c + e] = t8[e]; }
    float sc[16]; float mx = -1e30f;
#pragma unroll
    for (int kj = 0; kj < 16; ++kj) { float d = 0.f;
#pragma unroll
        for (int c = 0; c < 4; ++c) { float t8[8]; unpack8(*(const v4u*)(Km + (size_t)kj * 1024 + 8 * c), t8);
#pragma unroll
            for (int e = 0; e < 8; ++e) d += q[8 * c + e] * t8[e]; }
        d += __shfl_xor(d, 1); d += __shfl_xor(d, 2);
        sc[kj] = (kj <= qi) ? (d + BI[kj]) * att::SCALE : -__builtin_inff(); mx = fmaxf(mx, sc[kj]); }
    float l = 0.f;
#pragma unroll
    for (int kj = 0; kj < 16; ++kj) { sc[kj] = __expf(sc[kj] - mx); l += sc[kj]; }
    const float rl = 1.f / l;
    float o[32];
#pragma unroll
    for (int e = 0; e < 32; ++e) o[e] = 0.f;
#pragma unroll
    for (int kj = 0; kj < 16; ++kj) {
#pragma unroll
        for (int c = 0; c < 4; ++c) { float t8[8]; unpack8(*(const v4u*)(Vm + (size_t)kj * 1024 + 8 * c), t8);
#pragma unroll
            for (int e = 0; e < 8; ++e) o[8 * c + e] += sc[kj] * t8[e]; } }
    bf16_t* Om = (bf16_t*)(ws + OFF_OB) + (size_t)(MREAL + qi) * 1024 + h * 128 + 32 * part;
#pragma unroll
    for (int c = 0; c < 4; ++c) *(v4u*)(Om + 8 * c) = (v4u){pk2(o[8 * c] * rl, o[8 * c + 1] * rl), pk2(o[8 * c + 2] * rl, o[8 * c + 3] * rl), pk2(o[8 * c + 4] * rl, o[8 * c + 5] * rl), pk2(o[8 * c + 6] * rl, o[8 * c + 7] * rl)};
}

__device__ __forceinline__ att::BlockRef<att::bf16, att::bf16> att_ref(const Args& a, int bh, int qb) {
    att::BlockRef<att::bf16, att::bf16> r; const int b = bh >> 3, h = bh & 7;
    r.Q = (const att::bf16*)(a.ws + OFF_Q) + (size_t)(b * SEQ + qb * 256) * 1024 + h * 128;
    r.O = (att::bf16*)(a.ws + OFF_OB) + (size_t)(b * SEQ + qb * 256) * 1024 + h * 128;
    r.K = (const att::bf16*)(a.ws + OFF_K) + (size_t)b * PPOS * 1024 + h * 128;
    r.V = (const att::bf16*)(a.ws + OFF_V) + (size_t)b * PPOS * 1024 + h * 128;
    r.P0 = 64 + qb * 256;
    return r;
}
__device__ const signed char ATT_BINS[16][4] = {{4, 19, -1, -1}, {5, 21, -1, -1}, {11, 14, -1, -1}, {1, 25, -1, -1}, {10, 16, -1, -1}, {26, -1, -1, -1}, {7, 18, -1, -1}, {27, -1, -1, -1},
                                                {2, 3, 30, -1}, {17, 20, -1, -1}, {13, 24, -1, -1}, {15, 22, -1, -1}, {8, 29, -1, -1}, {6, 31, -1, -1}, {0, 12, 23, -1}, {9, 28, -1, -1}};
__device__ __forceinline__ void attn_phase(const Args& a, char* lds, int vcu, int G) {
    typedef att::BlockRef<att::bf16, att::bf16> Ref;
    constexpr int W = 1 << 20;
    const float* BIAS = (const float*)(a.ws + OFF_BIAS);
    att::Seam<att::bf16> S;
    if (G == 256) {
        const int bh = (vcu & 127) >> 3, bin = (vcu & 7) + (vcu >= 128 ? 8 : 0);
        int idx = 0;
        Ref cur = att_ref(a, bh, ATT_BINS[bin][0]);
        att::causal_swa_prime<att::bf16, att::bf16>(cur, W, lds, S);
        for (;;) {
            const int nq = idx < 3 ? (int)ATT_BINS[bin][idx + 1] : -1; const bool last = nq < 0;
            const Ref nxt = last ? cur : att_ref(a, bh, nq);
            att::causal_swa_block<att::bf16, att::bf16>(cur, nxt, PPOS, W, lds, S, BIAS + (size_t)bh * PPOS);
            if (last) break;
            cur = nxt; ++idx;
        }
        return;
    }
    constexpr int TOTAL = 256;
    int L = vcu; if (L >= TOTAL) return;
    int bh = L >> 4, x = L & 15, pass = 0;
    Ref cur = att_ref(a, bh, x);
    att::causal_swa_prime<att::bf16, att::bf16>(cur, W, lds, S);
    for (;;) {
        const bool more_pass = pass == 0, more_item = L + G < TOTAL, last = !more_pass && !more_item;
        int bhn = bh, xn = x, passn = pass + 1, Ln = L;
        if (!more_pass) { passn = 0; Ln = more_item ? L + G : L; bhn = Ln >> 4; xn = Ln & 15; }
        const Ref nxt = last ? cur : att_ref(a, bhn, passn ? 31 - xn : xn);
        att::causal_swa_block<att::bf16, att::bf16>(cur, nxt, PPOS, W, lds, S, BIAS + (size_t)bh * PPOS);
        if (last) break;
        cur = nxt; bh = bhn; x = xn; pass = passn; L = Ln;
    }
}

template <int NACC, int K>
__device__ __forceinline__ void thin_tile(const bf16_t* __restrict__ A, const bf16_t* __restrict__ Bt, const int (&n0)[NACC], pg8::f32x4 (&acc)[NACC], LAS unsigned char* lds, int wid, int lane) {
    constexpr int KS = K / 32 / 8; const int fr = lane & 15, fq = lane >> 4;
    const bf16_t* ap = A + (size_t)(MREAL + fr) * K + 8 * fq + 32 * KS * wid; h8 av[KS], bv[NACC][KS];
#pragma unroll
    for (int ks = 0; ks < KS; ++ks) { av[ks] = *(const h8*)(ap + 32 * ks);
#pragma unroll
        for (int j = 0; j < NACC; ++j) bv[j][ks] = *(const h8*)(Bt + (size_t)(n0[j] + fr) * K + 8 * fq + 32 * KS * wid + 32 * ks); }
#pragma unroll
    for (int j = 0; j < NACC; ++j) { acc[j] = (pg8::f32x4){0.f, 0.f, 0.f, 0.f};
#pragma unroll
        for (int ks = 0; ks < KS; ++ks) acc[j] = MFMA16(bv[j][ks], av[ks], acc[j]); }
    LAS pg8::f32x4* red = (LAS pg8::f32x4*)lds;
#pragma unroll
    for (int j = 0; j < NACC; ++j) red[(wid * NACC + j) * 64 + lane] = acc[j];
    __syncthreads();
    if (wid == 0) {
#pragma unroll
        for (int j = 0; j < NACC; ++j) { pg8::f32x4 t = red[j * 64 + lane];
#pragma unroll
            for (int w = 1; w < 8; ++w) t += red[(w * NACC + j) * 64 + lane];
            acc[j] = t; } }
    __syncthreads();
}
__device__ __forceinline__ void unpack4(const v2u w, float (&f)[4]) { f[0] = bflo(w.x); f[1] = bfhi(w.x); f[2] = bflo(w.y); f[3] = bfhi(w.y); }
__device__ __forceinline__ void thin_z(const Args& a, LAS unsigned char* lds, int bx, int G, int wid, int lane) {
    unsigned char* ws = a.ws; const int fr = lane & 15, fq = lane >> 4, row = MREAL + fr;
    for (int grp = bx; grp < 512; grp += G) { const int n0[1] = {16 * grp}; pg8::f32x4 acc[1];
        thin_tile<1, DM>((const bf16_t*)(ws + OFF_H0B), (const bf16_t*)(ws + OFF_WT_IN), n0, acc, lds, wid, lane);
        if (wid != 0) continue;
        const float rs = ((const float*)(ws + OFF_RSTD0))[row]; pg8::f32x4 v = acc[0] * rs;
        const int c = 16 * grp + 4 * fq, sec = c < 4096 ? (c >> 10) : (c < 6144 ? 4 : 5);
        if (sec >= 4) { v[0] = sigmoidf_(v[0]); v[1] = sigmoidf_(v[1]); v[2] = sigmoidf_(v[2]); v[3] = sigmoidf_(v[3]); }
        const v2u w = {pk2(v[0], v[1]), pk2(v[2], v[3])};
        if (sec == 0) *(v2u*)((bf16_t*)(ws + OFF_Q) + (size_t)row * 1024 + c) = w;
        else if (sec == 4) *(v2u*)((bf16_t*)(ws + OFF_SGA) + (size_t)row * 2048 + (c - 4096)) = w;
        else if (sec == 5) *(v2u*)((bf16_t*)(ws + OFF_SGB) + (size_t)row * 2048 + (c - 6144)) = w;
        else { bf16_t* base = (bf16_t*)(ws + (sec == 1 ? OFF_K : (sec == 2 ? OFF_V : OFF_UB))); const int cc = c & 1023;
            *(v2u*)(base + (size_t)(48 + fr) * 1024 + cc) = w; *(v2u*)(base + (size_t)(PPOS + 48 + fr) * 1024 + cc) = w; } }
}
__device__ __forceinline__ void thin_o(const Args& a, LAS unsigned char* lds, int bx, int G, int wid, int lane) {
    unsigned char* ws = a.ws; const int fr = lane & 15, fq = lane >> 4, row = MREAL + fr;
    for (int grp = bx; grp < 128; grp += G) { const int n0[1] = {16 * grp}; pg8::f32x4 acc[1];
        thin_tile<1, DATT>((const bf16_t*)(ws + OFF_OB), (const bf16_t*)(ws + OFF_WT_O), n0, acc, lds, wid, lane);
        if (wid != 0) continue;
        const size_t off = (size_t)row * 2048 + 16 * grp + 4 * fq; float sg[4]; unpack4(*(const v2u*)((const bf16_t*)(ws + OFF_SGB) + off), sg);
        *(v2u*)((bf16_t*)(ws + OFF_M1) + off) = (v2u){pk2(acc[0][0] * sg[0], acc[0][1] * sg[1]), pk2(acc[0][2] * sg[2], acc[0][3] * sg[3])}; }
}
__device__ __forceinline__ void thin_glu(const Args& a, LAS unsigned char* lds, int bx, int G, int wid, int lane) {
    unsigned char* ws = a.ws; const int fr = lane & 15, fq = lane >> 4, row = MREAL + fr;
    for (int grp = bx; grp < 128; grp += G) { const int oc = 16 * grp, t = oc >> 7, w = oc & 127; const int n0[2] = {256 * t + w, 256 * t + 128 + w}; pg8::f32x4 acc[2];
        thin_tile<2, DSSM>((const bf16_t*)(ws + OFF_YG), (const bf16_t*)(ws + OFF_WT_GLU), n0, acc, lds, wid, lane);
        if (wid != 0) continue;
        const size_t off = (size_t)row * 2048 + oc + 4 * fq; float ga[4], m1[4], o[4]; unpack4(*(const v2u*)((const bf16_t*)(ws + OFF_SGA) + off), ga); unpack4(*(const v2u*)((const bf16_t*)(ws + OFF_M1) + off), m1);
#pragma unroll
        for (int e = 0; e < 4; ++e) o[e] = m1[e] + ga[e] * acc[0][e] * sigmoidf_(acc[1][e]);
        *(v2u*)((bf16_t*)(ws + OFF_MERGED) + off) = (v2u){pk2(o[0], o[1]), pk2(o[2], o[3])}; }
}
__device__ __forceinline__ void thin_out(const Args& a, LAS unsigned char* lds, int bx, int G, int wid, int lane) {
    unsigned char* ws = a.ws; const int fr = lane & 15, fq = lane >> 4, row = MREAL + fr;
    for (int grp = bx; grp < 128; grp += G) { const int n0[1] = {16 * grp}; pg8::f32x4 acc[1];
        thin_tile<1, DM>((const bf16_t*)(ws + OFF_MERGED), (const bf16_t*)(ws + OFF_WT_OUT), n0, acc, lds, wid, lane);
        if (wid != 0) continue;
        const int c = 16 * grp + 4 * fq; const pg8::f32x4 v = acc[0] + *(const pg8::f32x4*)(a.in[I_META] + (size_t)fr * DM + c);
        *(v2u*)((bf16_t*)(ws + OFF_H1B) + (size_t)row * DM + c) = (v2u){pk2(v[0], v[1]), pk2(v[2], v[3])};
        float ss = (v[0] * v[0] + v[1] * v[1]) + (v[2] * v[2] + v[3] * v[3]); ss += __shfl_xor(ss, 16); ss += __shfl_xor(ss, 32);
        if (fq == 0) atomicAdd((float*)(ws + OFF_SUMSQ1) + row, ss); }
}
__device__ __forceinline__ void thin_up(const Args& a, LAS unsigned char* lds, int bx, int G, int wid, int lane) {
    unsigned char* ws = a.ws; const int fr = lane & 15, fq = lane >> 4, row = MREAL + fr;
    for (int grp = bx; grp < DFF / 16; grp += G) { const int oc = 16 * grp, t = oc >> 7, w = oc & 127; const int n0[2] = {256 * t + w, 256 * t + 128 + w}; pg8::f32x4 acc[2];
        thin_tile<2, DM>((const bf16_t*)(ws + OFF_H1B), (const bf16_t*)(ws + OFF_WT_UP), n0, acc, lds, wid, lane);
        if (wid != 0) continue;
        const float rs = 1.0f / sqrtf(((const float*)(ws + OFF_SUMSQ1))[row] * (1.f / DM) + EPS); const size_t off = (size_t)row * DFF + oc + 4 * fq;
        *(v2u*)((bf16_t*)(ws + OFF_G) + off) = (v2u){pk2(acc[0][0] * rs, acc[0][1] * rs), pk2(acc[0][2] * rs, acc[0][3] * rs)};
        *(v2u*)((bf16_t*)(ws + OFF_U) + off) = (v2u){pk2(acc[1][0] * rs, acc[1][1] * rs), pk2(acc[1][2] * rs, acc[1][3] * rs)}; }
}

__device__ __forceinline__ void conv_phase(const Args& a, int gt, int NT) {
    const bf16_t* G = (const bf16_t*)(a.ws + OFF_G); bf16_t* U = (bf16_t*)(a.ws + OFF_U);
    const float* cw = a.in[I_CONVW]; const float* cb = a.in[I_CONVB];
    constexpr int NCG = DFF / 8, NITEM = (MREAL / 64) * NCG;
    for (int it = gt; it < NITEM; it += NT) { const int j = it / NCG, cgp = it - j * NCG, r0 = 64 * j, c0 = 8 * cgp;
        float w0[8], w1[8], w2[8], bb[8];
#pragma unroll
        for (int h = 0; h < 2; ++h) { const v4f x0 = *(const v4f*)(cw + c0 + 4 * h), x1 = *(const v4f*)(cw + DFF + c0 + 4 * h), x2 = *(const v4f*)(cw + 2 * DFF + c0 + 4 * h), x3 = *(const v4f*)(cb + c0 + 4 * h);
#pragma unroll
            for (int e = 0; e < 4; ++e) { w0[4 * h + e] = x0[e]; w1[4 * h + e] = x1[e]; w2[4 * h + e] = x2[e]; bb[4 * h + e] = x3[e]; } }
        const bool first = (r0 & 8191) == 0;
        float p2[8], p1[8], g0[8], g1[8], u0[8], u1[8], o0[8], o1[8];
        unpack8(*(const v4u*)(G + (size_t)(first ? MREAL + 14 : r0 - 2) * DFF + c0), p2);
        unpack8(*(const v4u*)(G + (size_t)(first ? MREAL + 15 : r0 - 1) * DFF + c0), p1);
        unpack8(*(const v4u*)(G + (size_t)r0 * DFF + c0), g0); unpack8(*(const v4u*)(G + (size_t)(r0 + 1) * DFF + c0), g1);
        unpack8(*(const v4u*)(U + (size_t)r0 * DFF + c0), u0); unpack8(*(const v4u*)(U + (size_t)(r0 + 1) * DFF + c0), u1);
#pragma unroll
        for (int e = 0; e < 8; ++e) { const float ga = bb[e] + w0[e] * p2[e] + w1[e] * p1[e] + w2[e] * g0[e], gb = bb[e] + w0[e] * p1[e] + w1[e] * g0[e] + w2[e] * g1[e];
            o0[e] = ga * sigmoidf_(ga) * u0[e]; o1[e] = gb * sigmoidf_(gb) * u1[e]; }
        *(v4u*)(U + (size_t)r0 * DFF + c0) = (v4u){pk2(o0[0], o0[1]), pk2(o0[2], o0[3]), pk2(o0[4], o0[5]), pk2(o0[6], o0[7])};
        *(v4u*)(U + (size_t)(r0 + 1) * DFF + c0) = (v4u){pk2(o1[0], o1[1]), pk2(o1[2], o1[3]), pk2(o1[4], o1[5]), pk2(o1[6], o1[7])};
    }
}

#define RLX_AGENT __ATOMIC_RELAXED, __HIP_MEMORY_SCOPE_AGENT
#define XB_TMO      128
#define XB_XCNT(j)  (256  + 64 * (j))
#define XB_XSUB(j)  (1280 + 64 * (j))
#define XB_XGEN(j)  (2304 + 64 * (j))
#define XB_TOP      3328
#define XB_TOPGEN   3392
#define XCD_BAR_WORDS 3456
#define XB_SPIN_CAP (1u << 18)

__device__ __forceinline__ unsigned xb_ld(unsigned* p)              { return __hip_atomic_load(p, __ATOMIC_RELAXED, __HIP_MEMORY_SCOPE_AGENT); }
__device__ __forceinline__ unsigned xb_add(unsigned* p, unsigned v) { return __hip_atomic_fetch_add(p, v, __ATOMIC_RELAXED, __HIP_MEMORY_SCOPE_AGENT); }
__device__ __forceinline__ unsigned xb_xcc_id() { return (unsigned)__builtin_amdgcn_s_getreg((3 << 11) | 20) & 0xFu; }
#define XB_SPIN(cond, bar) do { unsigned _sp = 0; while (cond) { __builtin_amdgcn_s_sleep(1); \
    if ((++_sp & 255u) == 0u) { if (xb_ld(&(bar)[XB_TMO])) break; if (_sp > XB_SPIN_CAP) { atomicAdd(&(bar)[XB_TMO], 1u); break; } } } } while (0)

struct XcdBarrier {
    unsigned* bar; unsigned x;
    volatile LAS unsigned* st;
};

__device__ __forceinline__ XcdBarrier xcd_barrier_post(unsigned* bar, volatile LAS unsigned* st) {
    XcdBarrier b; b.bar = bar; b.x = xb_xcc_id(); b.st = st;
    if (threadIdx.x == 0) (void)xb_add(&bar[XB_XCNT(b.x)], 1u);
    return b;
}
__device__ __forceinline__ void xcd_barrier_complete(unsigned* bar, unsigned x, unsigned& nloc, unsigned& nx) {
    const unsigned G = gridDim.x * gridDim.y * gridDim.z;
    unsigned sum, cnt, mine, sp = 0u;
    for (;;) {
        sum = 0u; cnt = 0u; mine = 0u;
#pragma unroll
        for (unsigned j = 0; j < 16; ++j) { const unsigned c = xb_ld(&bar[XB_XCNT(j)]); sum += c; cnt += (c > 0u) ? 1u : 0u; mine = (j == x) ? c : mine; }
        if (sum == G) break;
        __builtin_amdgcn_s_sleep(1);
        if ((++sp & 255u) == 0u) { if (xb_ld(&bar[XB_TMO])) break; if (sp > XB_SPIN_CAP) { atomicAdd(&bar[XB_TMO], 1u); break; } }
    }
    nloc = mine > 0u ? mine : 1u; nx = cnt > 0u ? cnt : 1u;
}

__device__ __forceinline__ void xcd_barrier(const XcdBarrier& b) {
    asm volatile("s_waitcnt vmcnt(0)" ::: "memory");
    __syncthreads();
    if (threadIdx.x == 0) {
        unsigned* bar = b.bar;
        __builtin_amdgcn_s_waitcnt(0);
        unsigned nloc = b.st[0], nx = b.st[1];
        if (nloc == 0u) { xcd_barrier_complete(bar, b.x, nloc, nx); b.st[0] = nloc; b.st[1] = nx; }
        const unsigned old = xb_add(&bar[XB_XSUB(b.x)], 1u);
        const unsigned gen = old / nloc;
        if (old + 1u == (gen + 1u) * nloc) {
            __builtin_amdgcn_fence(__ATOMIC_RELEASE, "agent");
            asm volatile("s_waitcnt vmcnt(0)" ::: "memory");
            const unsigned og = xb_add(&bar[XB_TOP], 1u);
            const unsigned tg = og / nx;
            if (og + 1u == (tg + 1u) * nx) xb_add(&bar[XB_TOPGEN], 1u);
            else XB_SPIN(xb_ld(&bar[XB_TOPGEN]) == tg, bar);
            __builtin_amdgcn_fence(__ATOMIC_ACQUIRE, "agent");
            xb_add(&bar[XB_XGEN(b.x)], 1u);
            asm volatile("s_waitcnt vmcnt(0)" ::: "memory");
        } else {
            XB_SPIN(xb_ld(&bar[XB_XGEN(b.x)]) == gen, bar);
            __builtin_amdgcn_fence(__ATOMIC_ACQUIRE, "agent");
            asm volatile("s_waitcnt vmcnt(0)" ::: "memory");
        }
    }
    __syncthreads();
}

__global__ void __launch_bounds__(512, 2) mk_fwd(Args a0) {
    extern __shared__ __attribute__((aligned(16))) unsigned char lds_raw[];
    LAS unsigned char* lds = (LAS unsigned char*)lds_raw;
    const int tid = threadIdx.x, lane = tid & 63, wid = __builtin_amdgcn_readfirstlane(tid >> 6);
    const int G = gridDim.x, bx = blockIdx.x;
    volatile LAS unsigned* xb_st = (volatile LAS unsigned*)(lds + (LDS_BYTES - 64));
    if (tid < 2) xb_st[tid] = 0u;
    __syncthreads();
    XcdBarrier xbar; { LOAD_ARGS(ab); (void)ab; xbar = xcd_barrier_post((unsigned*)(ws + OFF_BAR), xb_st); }
#define VCU() ((G % 8 == 0) ? (bx % 8) * (G / 8) + bx / 8 : bx)
    const int gw = bx * 8 + wid, NGW = G * 8;
#ifndef PH_MASK
#define PH_MASK 0x3ff
#endif
#define IN(k) (((PH_MASK >> (k)) & 1) && ph_in(k))
#ifndef PROBE_PH
#define PROBE_PH -1
#endif
#ifndef PROBE_MUL
#define PROBE_MUL 8
#endif
    unsigned long long pr_t0 = 0, pr_dt = 0;
#define SEAM(k) do { if (IN(k) && IN((k) + 1)) { if (ph_in(-7)) cg::this_grid().sync();   xcd_barrier(xbar); } if (PROBE_PH == (k)) pr_dt = __builtin_amdgcn_s_memrealtime() - pr_t0; if (PROBE_PH == (k) + 1) pr_t0 = __builtin_amdgcn_s_memrealtime(); } while (0)
    if (PROBE_PH == 0) pr_t0 = __builtin_amdgcn_s_memrealtime();

    if (IN(0)) { LOAD_ARGS(a);
        { LAS float* wf = (LAS float*)(lds + WF_OFF); const float* win = a.in[I_WIN]; const float* gm = a.in[I_GMIX];
#pragma unroll
          for (int k = tid; k < DM; k += 512) { const float g = gm[k]; const v4f w0 = *(const v4f*)(win + (size_t)k * NIN + 3072), w1 = *(const v4f*)(win + (size_t)k * NIN + 3076);
              wf[0 * 2048 + k] = w0.x * g; wf[1 * 2048 + k] = w0.y * g; wf[2 * 2048 + k] = w0.z * g; wf[3 * 2048 + k] = w0.w * g;
              wf[4 * 2048 + k] = w1.x * g; wf[5 * 2048 + k] = w1.y * g; wf[6 * 2048 + k] = w1.z * g; wf[7 * 2048 + k] = w1.w * g; } }
        { const int gt = bx * 512 + tid, NT = G * 512;
          float* s1 = (float*)(ws + OFF_SUMSQ1); float* s2 = (float*)(ws + OFF_SUMSQ2);
          for (int i = gt; i < RPAD; i += NT) { s1[i] = 0.f; s2[i] = 0.f; }
          constexpr int NZ = 48 * 1024 * 2 / 16;
          for (int i = gt; i < 6 * NZ; i += NT) { const int w = i / NZ, j = i - w * NZ; const size_t base = (w >> 1) == 0 ? OFF_K : ((w >> 1) == 1 ? OFF_V : OFF_UB);
              *(v4u*)(ws + base + (size_t)(w & 1) * PPOS * 1024 * 2 + (size_t)j * 16) = (v4u){0u, 0u, 0u, 0u}; } }
        __syncthreads();
#define SUBSTAMP(id) do { if (PROBE_PH == 100 + (id)) pr_t0 = __builtin_amdgcn_s_memrealtime(); if (PROBE_PH == 99 + (id)) pr_dt = __builtin_amdgcn_s_memrealtime() - pr_t0; } while (0)
        SUBSTAMP(0);
        p0_rows(a, lds, gw, NGW, lane);
        __syncthreads();
        SUBSTAMP(1);
        { LOAD_ARGS(a2); (void)ws; p0_transposes(a2, lds, gw, NGW, wid, lane); }
        __syncthreads();
        SUBSTAMP(2);
        for (int jb = bx; jb < 4 * NG; jb += G) ssm_gen(lds, jb >> 2, jb & 3, tid);
        SUBSTAMP(3);
    }
    SEAM(0);
    if (IN(1)) { LOAD_ARGS(a);
        if (bx >= G - 16) cumsum_seq(a, lds, bx - (G - 16), tid);
        thin_z(a, lds, bx, G, wid, lane);
        pg8::Gemm g{(const bf16_t*)(ws + OFF_H0B), (const bf16_t*)(ws + OFF_WT_IN), MREAL, 8192, DM}; pg8::StaticOrder S; S.init(MREAL, 8192, G, bx);
        EpiZ E{(const float*)(ws + OFF_RSTD0), (bf16_t*)(ws + OFF_Q), (bf16_t*)(ws + OFF_K), (bf16_t*)(ws + OFF_V), (bf16_t*)(ws + OFF_UB), (bf16_t*)(ws + OFF_SGA), (bf16_t*)(ws + OFF_SGB)};
        pg8::gemm_phase<EpiZ, pg8::StaticOrder, true, true>(lds, g, S, E);
    }
    SEAM(1);
    if (IN(2)) { LOAD_ARGS(a);
#ifndef P2_PARTS
#define P2_PARTS 7
#endif
        const int vcu = VCU();
        SUBSTAMP(10);
        if ((P2_PARTS & 1) && vcu < 128) ssm_unit(a, lds, vcu >> 6, vcu & 63, tid);
        if ((P2_PARTS & 2) && vcu == 0) meta_attn(a, tid);
        __syncthreads();
        SUBSTAMP(11);
        if (P2_PARTS & 4) attn_phase(a, (char*)lds_raw, vcu, G);
        SUBSTAMP(12);
    }
    SEAM(2);
    if (IN(3)) { LOAD_ARGS(a);
        thin_o(a, lds, bx, G, wid, lane);
        thin_glu(a, lds, bx, G, wid, lane);
        pg8::Gemm g{(const bf16_t*)(ws + OFF_OB), (const bf16_t*)(ws + OFF_WT_O), MREAL, DM, DATT}; ChainOrder S; S.init(MREAL, G, bx);
        S.A0 = (const char*)(ws + OFF_OB); S.B0 = (const char*)(ws + OFF_WT_O); S.A1 = (const char*)(ws + OFF_YG); S.B1 = (const char*)(ws + OFF_WT_GLU);
        EpiOG E{EpiO{(const bf16_t*)(ws + OFF_SGB), (bf16_t*)(ws + OFF_M1)}, EpiGlu{(const bf16_t*)(ws + OFF_SGA), (const bf16_t*)(ws + OFF_M1), (bf16_t*)(ws + OFF_MERGED)}};
        pg8::gemm_phase<EpiOG, ChainOrder, true, true>(lds, g, S, E);
    }
    SEAM(4);
    if (IN(5)) { LOAD_ARGS(a);
        thin_out(a, lds, bx, G, wid, lane);
        pg8::Gemm g{(const bf16_t*)(ws + OFF_MERGED), (const bf16_t*)(ws + OFF_WT_OUT), MREAL, DM, DM}; pg8::StaticOrder S; S.init(MREAL, DM, G, bx);
        EpiOut E{a.in[I_X], a.out, (bf16_t*)(ws + OFF_H1B), (float*)(ws + OFF_SUMSQ1)};
        pg8::gemm_phase<EpiOut, pg8::StaticOrder, true, true>(lds, g, S, E);
    }
    SEAM(5);
    if (IN(6)) { LOAD_ARGS(a);
        thin_up(a, lds, bx, G, wid, lane);
        pg8::Gemm g{(const bf16_t*)(ws + OFF_H1B), (const bf16_t*)(ws + OFF_WT_UP), MREAL, 2 * DFF, DM}; pg8::StaticOrder S; S.init(MREAL, 2 * DFF, G, bx);
        EpiUp E{(const float*)(ws + OFF_SUMSQ1), (bf16_t*)(ws + OFF_G), (bf16_t*)(ws + OFF_U), a.in[I_CONVW], a.in[I_CONVB]};
        pg8::gemm_phase<EpiUp, pg8::StaticOrder, true, true>(lds, g, S, E);
    }
    SEAM(6);
    if (IN(7)) { LOAD_ARGS(a); (void)ws; conv_phase(a, bx * 512 + tid, G * 512); }
    SEAM(7);
    if (IN(8)) { LOAD_ARGS(a);
        pg8::Gemm g{(const bf16_t*)(ws + OFF_U), (const bf16_t*)(ws + OFF_WT_DOWN), MREAL, DM, DFF}; pg8::StaticOrder S; S.init(MREAL, DM, G, bx);
        EpiDown E{a.out, (float*)(ws + OFF_SUMSQ2)};
        pg8::gemm_phase<EpiDown, pg8::StaticOrder, true, true>(lds, g, S, E);
    }
    SEAM(8);
    if (IN(9)) { LOAD_ARGS(a);
        const float* ss = (const float*)(ws + OFF_SUMSQ2); const float* gf = a.in[I_GFINAL];
        v4f gv[8];
#pragma unroll
        for (int j = 0; j < 8; ++j) gv[j] = *((const v4f*)gf + lane + 64 * j);
        for (int r = gw; r < MREAL; r += 2 * NGW) {
            const int r1 = r + NGW; const bool two = r1 < MREAL; const int r1c = two ? r1 : r;
            const float rs0 = 1.0f / sqrtf(ss[r] * (1.f / DM) + EPS), rs1 = 1.0f / sqrtf(ss[r1c] * (1.f / DM) + EPS);
            v4f* p0 = (v4f*)(a.out + (size_t)r * DM) + lane; v4f* p1 = (v4f*)(a.out + (size_t)r1c * DM) + lane; v4f x0[8], x1[8];
#pragma unroll
            for (int j = 0; j < 8; ++j) { x0[j] = p0[64 * j]; x1[j] = p1[64 * j]; }
#pragma unroll
            for (int j = 0; j < 8; ++j) p0[64 * j] = x0[j] * rs0 * gv[j];
            if (two) {
#pragma unroll
                for (int j = 0; j < 8; ++j) p1[64 * j] = x1[j] * rs1 * gv[j]; } }
    }
    if (PROBE_PH >= 0 && bx == 0) { const unsigned long long t1 = __builtin_amdgcn_s_memrealtime(); while (__builtin_amdgcn_s_memrealtime() - t1 < (unsigned long long)PROBE_MUL * pr_dt) __builtin_amdgcn_s_sleep(8); }
#undef IN
#undef SEAM
}

extern "C" void kernel_launch(void* const* d_in, const int* in_sizes, int n_in, void* d_out, int out_size, void* d_ws, size_t ws_size, hipStream_t stream) {
    static int grid = 0;
    if (grid == 0) {
        if (n_in != 22 || out_size != MREAL * DM || ws_size < WS_NEED) { fprintf(stderr, "kernel_launch: unexpected shapes (n_in %d out %d ws %zu need %zu)\n", n_in, out_size, ws_size, (size_t)WS_NEED); grid = -1; return; }
        int dev = 0, cus = 0, per_cu = 0;
        (void)hipGetDevice(&dev); (void)hipDeviceGetAttribute(&cus, hipDeviceAttributeMultiprocessorCount, dev);
        if (hipFuncSetAttribute((const void*)mk_fwd, hipFuncAttributeMaxDynamicSharedMemorySize, LDS_BYTES) != hipSuccess) { fprintf(stderr, "kernel_launch: hipFuncSetAttribute failed\n"); grid = -1; return; }
        if (hipOccupancyMaxActiveBlocksPerMultiprocessor(&per_cu, (const void*)mk_fwd, 512, LDS_BYTES) != hipSuccess || per_cu < 1) { fprintf(stderr, "kernel_launch: occupancy query says %d\n", per_cu); per_cu = 1; }
        (void)hipGetLastError();
        grid = cus > 0 ? cus : 256;
    }
    if (grid < 0) return;
    (void)hipMemsetAsync((unsigned char*)d_ws + OFF_BAR, 0, 16384, stream);
    Args a{};
    for (int i = 0; i < 22; ++i) a.in[i] = (const float*)d_in[i];
    a.out = (float*)d_out; a.ws = (unsigned char*)d_ws;
#if MK_SPLIT
    for (int p = 0; p < 10; ++p) { a.ph_lo = p; a.ph_hi = p + 1; hipLaunchKernelGGL(mk_fwd, dim3(grid), dim3(512), LDS_BYTES, stream, a); }
#else
    a.ph_lo = 0; a.ph_hi = 10;
    void* args[] = {&a};
    const hipError_t e = hipLaunchCooperativeKernel((const void*)mk_fwd, dim3(grid), dim3(512), args, LDS_BYTES, stream);
    if (e != hipSuccess) fprintf(stderr, "kernel_launch: cooperative launch failed: %s (grid %d)\n", hipGetErrorString(e), grid);
#endif
}
```

```cpp
#include <hip/hip_runtime.h>
#include <hip/hip_bf16.h>
#include <hip/hip_cooperative_groups.h>
#include <cstdio>
#include <cstdint>
namespace cg = cooperative_groups;
namespace pg8 {
#define PG8_LAS __attribute__((address_space(3)))
typedef unsigned short bf16_t;
typedef short bf16x8 __attribute__((ext_vector_type(8)));
typedef float f32x4 __attribute__((ext_vector_type(4)));
typedef unsigned u32x4 __attribute__((ext_vector_type(4)));
constexpr int BM = 256, BK = 64, HALF = 128, HTB = HALF * BK * 2  , STAGE_BYTES = 8 * HTB, NXCD = 8, WGM = 8;

__host__ __device__ __forceinline__ int lds_byte(int r, int c) { const int st = (r >> 4) * 2 + (c >> 5), rr = r & 15, cc = c & 31, ob = rr * 64 + cc * 2; return st * 1024 + (ob ^ (((ob >> 9) & 1) << 5)); }
__host__ __device__ __forceinline__ void stage_rc(int b, int& R, int& C) { const int st = b / 1024, sb = b % 1024, swz = sb ^ (((sb >> 9) & 1) << 5); R = (st >> 1) * 16 + swz / 64; C = (st & 1) * 32 + (swz % 64) / 2; }
__host__ __device__ __forceinline__ int perm32(int rho) { const int n = rho >> 4, i = rho & 15; return 8 * (i >> 2) + 4 * n + (i & 3); }

struct Unit { int pm, pn, kind; };
struct Gemm { const bf16_t* A; const bf16_t* Bt; int M, N, K; };

struct StaticOrder {
    int nM, nN, nwg, G, c;
    __host__ __device__ void init(int M, int N, int G_, int c_) { nM = M / BM; nN = N / BM; nwg = nM * nN; G = G_; c = c_; }
    __host__ __device__ bool next(int i, Unit& u) const {
        const long L = (long)i * G + c; if (L >= nwg) return false;
        int wgid = (int)L; { const int q = nwg / NXCD, r = nwg % NXCD, xcd = wgid % NXCD, off = wgid / NXCD; wgid = (xcd < r ? xcd * (q + 1) : r * (q + 1) + (xcd - r) * q) + off; }
        const int nig = WGM * nN, gid = wgid / nig, fm = gid * WGM, gsz = (nM - fm) < WGM ? (nM - fm) : WGM;
        u.pm = fm + ((wgid % nig) % gsz); u.pn = (wgid % nig) / gsz; return true;
    }
    template <class G_> __device__ __forceinline__ const char* abase(const G_& g, const Unit&) const { return (const char*)g.A; }
    template <class G_> __device__ __forceinline__ const char* bbase(const G_& g, const Unit&) const { return (const char*)g.Bt; }
    __device__ __forceinline__ void a_ready(const Unit&) const {}
    __device__ __forceinline__ void done(const Unit&) const {}
};

__device__ __forceinline__ unsigned cvt_pk_bf16(float lo, float hi) { unsigned r; asm volatile("v_cvt_pk_bf16_f32 %0, %1, %2" : "=v"(r) : "v"(lo), "v"(hi)); return r; }
typedef float f32x2 __attribute__((ext_vector_type(2)));
template <class Epi, class Sched, bool ALIGN_EPI = false, bool SP2 = false>
__device__ __forceinline__ void gemm_phase(PG8_LAS unsigned char* lds, const Gemm g, const Sched& S, const Epi& E) {
    const int tid = threadIdx.x, wid = __builtin_amdgcn_readfirstlane(tid >> 6), lane = tid & 63, wr = wid >> 2, wc = wid & 3, fr = lane & 15, fq = lane >> 4;
    const int K = g.K, nt = K / BK;
    unsigned voffA[2], voffB[2];
#pragma unroll
    for (int i = 0; i < 2; ++i) { int R, C; stage_rc(tid * 16 + i * 8192, R, C); const int Rb = Epi::PERM ? ((R & ~31) + perm32(R & 31)) : R;
        voffA[i] = (unsigned)(R * K + C) * 2u; voffB[i] = (unsigned)(Rb * K + C) * 2u; }
    const size_t kstep = (size_t)(BK * 2);
    const size_t hstep = (size_t)HALF * K * 2;
    const size_t tstep = 2 * hstep;
    const unsigned ldsw = (unsigned)wid * 1024u;
    const int aoff = lds_byte(wr * 64 + fr, fq * 8), boff = lds_byte(wc * 32 + fr, fq * 8);
#define PG8_SA(b, h) (((b) * 2 + (h)) * HTB)
#define PG8_SB(b, h) ((4 + (b) * 2 + (h)) * HTB)
#define PG8_STAGE(bufoff, gbase, voff) do { _Pragma("unroll") for (int _i = 0; _i < 2; ++_i) \
        __builtin_amdgcn_global_load_lds((const unsigned*)((const char*)(gbase) + (voff)[_i]), (PG8_LAS unsigned*)(lds + (bufoff) + ldsw + _i * 8192), 16, 0, 0); } while (0)
#define PG8_LDA(dst, b, h) do { _Pragma("unroll") for (int m = 0; m < 4; ++m) _Pragma("unroll") for (int k = 0; k < 2; ++k) dst[m][k] = *(const PG8_LAS bf16x8*)(lds + PG8_SA(b, h) + aoff + m * 2048 + k * 1024); } while (0)
#define PG8_LDB(dst, b, h) do { _Pragma("unroll") for (int n = 0; n < 2; ++n) _Pragma("unroll") for (int k = 0; k < 2; ++k) dst[n][k] = *(const PG8_LAS bf16x8*)(lds + PG8_SB(b, h) + boff + n * 2048 + k * 1024); } while (0)
#define PG8_MMA(ai, bj, At, Bt) do { __builtin_amdgcn_s_setprio(1); _Pragma("unroll") for (int m = 0; m < 4; ++m) _Pragma("unroll") for (int n = 0; n < 2; ++n) _Pragma("unroll") for (int k = 0; k < 2; ++k) \
        acc[ai][bj][m][n] = __builtin_amdgcn_mfma_f32_16x16x32_bf16(Bt[n][k], At[m][k], acc[ai][bj][m][n], 0, 0, 0); __builtin_amdgcn_s_setprio(0); } while (0)
#define PG8_WAIT_V(n) asm volatile("s_waitcnt vmcnt(" #n ")" ::: "memory")
#define PG8_WAIT_L(n) asm volatile("s_waitcnt lgkmcnt(" #n ")" ::: "memory")
#define PG8_BAR __builtin_amdgcn_s_barrier()
#define PG8_SCHED __builtin_amdgcn_sched_barrier(0)
    Unit cur, nxt; int ui = 0;
    if (!S.next(0, cur)) return;
    f32x4 acc[2][2][4][2];
#pragma unroll
    for (int a = 0; a < 2; ++a)
#pragma unroll
        for (int b = 0; b < 2; ++b)
#pragma unroll
            for (int m = 0; m < 4; ++m)
#pragma unroll
                for (int n = 0; n < 2; ++n) acc[a][b][m][n] = (f32x4){0.f, 0.f, 0.f, 0.f};
    bf16x8 At[4][2], B0[2][2], B1[2][2];
    const char* cA = S.abase(g, cur) + (size_t)cur.pm * tstep; const char* cB = S.bbase(g, cur) + (size_t)cur.pn * tstep;
    S.a_ready(cur);
    if constexpr (SP2) {
        PG8_STAGE(PG8_SB(0, 0), cB, voffB); PG8_STAGE(PG8_SB(0, 1), cB + hstep, voffB); PG8_STAGE(PG8_SA(0, 0), cA, voffA); PG8_STAGE(PG8_SA(0, 1), cA + hstep, voffA);
        if (wr == 1) PG8_BAR;
        PG8_WAIT_V(2); PG8_BAR;
        PG8_STAGE(PG8_SB(1, 0), cB + kstep, voffB); PG8_STAGE(PG8_SA(1, 0), cA + kstep, voffA); PG8_STAGE(PG8_SB(1, 1), cB + hstep + kstep, voffB);
        PG8_WAIT_V(6); PG8_BAR;
    } else {
        PG8_STAGE(PG8_SB(0, 0), cB, voffB); PG8_STAGE(PG8_SA(0, 0), cA, voffA); PG8_STAGE(PG8_SB(0, 1), cB + hstep, voffB); PG8_STAGE(PG8_SA(0, 1), cA + hstep, voffA);
        if (wr == 1) PG8_BAR;
        PG8_WAIT_V(4); PG8_BAR;
        PG8_STAGE(PG8_SB(1, 0), cB + kstep, voffB); PG8_STAGE(PG8_SA(1, 0), cA + kstep, voffA); PG8_STAGE(PG8_SB(1, 1), cB + hstep + kstep, voffB);
        PG8_WAIT_V(6); PG8_BAR;
    }
    for (;;) {
        const bool has_next = S.next(ui + 1, nxt);
        const char* nA = has_next ? S.abase(g, nxt) + (size_t)nxt.pm * tstep : cA; const char* nB = has_next ? S.bbase(g, nxt) + (size_t)nxt.pn * tstep : cB;
        for (int t = 0; t < nt; t += 2) {
            const bool last = (t == nt - 2);
            const char* a1 = cA + (size_t)(t + 1) * kstep;
            const char* a2 = last ? nA : cA + (size_t)(t + 2) * kstep; const char* b2 = last ? nB : cB + (size_t)(t + 2) * kstep;
            const char* a3 = a2 + kstep; const char* b3 = b2 + kstep;
            if (last && has_next) S.a_ready(nxt);
            if constexpr (SP2) {
            PG8_LDB(B0, 0, 0); PG8_LDB(B1, 0, 1); PG8_SCHED; PG8_LDA(At, 0, 0); PG8_STAGE(PG8_SA(1, 1), a1 + hstep, voffA);
            PG8_WAIT_V(8); PG8_WAIT_L(0); PG8_BAR; PG8_MMA(0, 0, At, B0); PG8_MMA(0, 1, At, B1); PG8_BAR; PG8_SCHED;
            PG8_LDA(At, 0, 1); PG8_STAGE(PG8_SB(0, 0), b2, voffB); PG8_STAGE(PG8_SB(0, 1), b2 + hstep, voffB); PG8_STAGE(PG8_SA(0, 0), a2, voffA);
            PG8_WAIT_V(8); PG8_WAIT_L(0); PG8_BAR; PG8_MMA(1, 0, At, B0); PG8_MMA(1, 1, At, B1); PG8_BAR; PG8_SCHED;
            PG8_LDB(B0, 1, 0); PG8_LDB(B1, 1, 1); PG8_SCHED; PG8_LDA(At, 1, 0); PG8_STAGE(PG8_SA(0, 1), a2 + hstep, voffA);
            PG8_WAIT_V(8); PG8_WAIT_L(0); PG8_BAR; PG8_MMA(0, 0, At, B0); PG8_MMA(0, 1, At, B1); PG8_BAR; PG8_SCHED;
            PG8_LDA(At, 1, 1); PG8_STAGE(PG8_SB(1, 0), b3, voffB); PG8_STAGE(PG8_SB(1, 1), b3 + hstep, voffB); PG8_STAGE(PG8_SA(1, 0), a3, voffA);
            PG8_WAIT_V(8); PG8_WAIT_L(0); PG8_BAR; PG8_MMA(1, 0, At, B0); PG8_MMA(1, 1, At, B1); PG8_BAR; PG8_SCHED;
            } else {
            PG8_LDB(B0, 0, 0); PG8_SCHED; PG8_LDA(At, 0, 0); PG8_STAGE(PG8_SA(1, 1), a1 + hstep, voffA);
            PG8_WAIT_L(8); PG8_BAR; PG8_WAIT_L(0); PG8_MMA(0, 0, At, B0); PG8_BAR; PG8_SCHED;
            PG8_LDB(B1, 0, 1); PG8_STAGE(PG8_SB(0, 0), b2, voffB);
            PG8_BAR; PG8_WAIT_L(0); PG8_MMA(0, 1, At, B1); PG8_BAR;
            PG8_LDA(At, 0, 1); PG8_STAGE(PG8_SA(0, 0), a2, voffA);
            PG8_BAR; PG8_WAIT_L(0); PG8_MMA(1, 0, At, B0); PG8_BAR; PG8_SCHED;
            PG8_STAGE(PG8_SB(0, 1), b2 + hstep, voffB);
            PG8_WAIT_V(6); PG8_BAR; PG8_MMA(1, 1, At, B1); PG8_BAR;
            PG8_LDB(B0, 1, 0); PG8_SCHED; PG8_LDA(At, 1, 0); PG8_STAGE(PG8_SA(0, 1), a2 + hstep, voffA);
            PG8_WAIT_L(8); PG8_BAR; PG8_WAIT_L(0); PG8_MMA(0, 0, At, B0); PG8_BAR; PG8_SCHED;
            PG8_LDB(B1, 1, 1); PG8_STAGE(PG8_SB(1, 0), b3, voffB);
            PG8_BAR; PG8_WAIT_L(0); PG8_MMA(0, 1, At, B1); PG8_BAR;
            PG8_LDA(At, 1, 1); PG8_STAGE(PG8_SA(1, 0), a3, voffA);
            PG8_BAR; PG8_WAIT_L(0); PG8_MMA(1, 0, At, B0); PG8_BAR; PG8_SCHED;
            PG8_STAGE(PG8_SB(1, 1), b3 + hstep, voffB);
            PG8_WAIT_V(6); PG8_BAR; PG8_MMA(1, 1, At, B1); PG8_BAR;
            }
        }
        if constexpr (ALIGN_EPI) { if (wr == 0) PG8_BAR; }
        if constexpr (!Epi::AFTER_DRAIN) { E(acc, cur, wr, wc, fr, fq); S.done(cur); }
        if (!has_next) break;
#pragma unroll
        for (int a = 0; a < 2; ++a)
#pragma unroll
            for (int b = 0; b < 2; ++b)
#pragma unroll
                for (int m = 0; m < 4; ++m)
#pragma unroll
                    for (int n = 0; n < 2; ++n) acc[a][b][m][n] = (f32x4){0.f, 0.f, 0.f, 0.f};
        cur = nxt; cA = nA; cB = nB; ++ui;
        if constexpr (ALIGN_EPI) { if (wr == 1) PG8_BAR; }
    }
    PG8_WAIT_V(0);
    if constexpr (!ALIGN_EPI) { if (wr == 0) PG8_BAR; }
    PG8_BAR;
    if constexpr (Epi::AFTER_DRAIN) { E.fused(acc, cur, wr, wc, fr, fq, lds, wid, lane); S.done(cur); }
#undef PG8_SA
#undef PG8_SB
#undef PG8_STAGE
#undef PG8_LDA
#undef PG8_LDB
#undef PG8_MMA
#undef PG8_WAIT_V
#undef PG8_WAIT_L
#undef PG8_BAR
#undef PG8_SCHED
}
}
namespace att {
constexpr int D = 128, RS = 1024;
constexpr float THR = 8.f; constexpr bool WSKIP = false;
constexpr float SCALE = 0.08838834764831845f;
constexpr int NW = 8, QBLK = 32, KVBLK = 64, QB = NW * QBLK;
constexpr int SHM_V = KVBLK * D * 2, SHM_K = KVBLK * D * 2;
constexpr int LDS_BYTES = 2 * SHM_V + 2 * SHM_K + NW * 64 * 4;

using bf16 = __hip_bfloat16;
typedef short bf16x8 __attribute__((ext_vector_type(8)));
typedef short s16x4 __attribute__((ext_vector_type(4)));
typedef float f32x16 __attribute__((ext_vector_type(16)));
typedef float f32x4 __attribute__((ext_vector_type(4)));
typedef unsigned u32x4 __attribute__((ext_vector_type(4)));
template <class A, class Bt> struct same_t { static constexpr bool v = false; };
template <class A> struct same_t<A, A> { static constexpr bool v = true; };

#define KSWZ(row, colB) ((row) * 256 + ((colB) ^ (((row) & 7) << 4)))
#define SBAR() __builtin_amdgcn_sched_barrier(0)
__device__ __forceinline__ int att_tid() { int t = threadIdx.x; asm volatile("" : "+v"(t)); return t; }
__device__ __forceinline__ int v_st(int k, int c) { const int kk = (k & ~0xC) | ((k & 4) << 1) | ((k & 8) >> 1); return ((kk >> 3) * 4 + (c >> 5)) * 512 + ((kk & 7) * 32 + (c & 31)) * 2; }
__device__ __forceinline__ int v_rd_base(int lane) { return ((lane & 3) << 3) | (((lane >> 2) & 3) << 6) | (((lane >> 4) & 1) << 5) | (((lane >> 5) & 1) << 8); }
constexpr int v_rd_off(int d0, int ks, int half) { return d0 * 512 + ks * 4096 + half * 2048; }
__device__ __forceinline__ int crow(int r, int hi) { return (r & 3) + 8 * (r >> 2) + 4 * hi; }
__device__ __forceinline__ unsigned cvtpk(float lo, float hi) {
    unsigned r; asm volatile("v_cvt_pk_bf16_f32 %0, %1, %2" : "=v"(r) : "v"(lo), "v"(hi)); return r;
}
__device__ __forceinline__ bf16x8 pack8(f32x4 a, f32x4 b) {
    u32x4 w = {cvtpk(a[0], a[1]), cvtpk(a[2], a[3]), cvtpk(b[0], b[1]), cvtpk(b[2], b[3])};
    return *reinterpret_cast<bf16x8*>(&w);
}
template <class T> __device__ __forceinline__ bf16x8 load8(const T* p) {
    if constexpr (same_t<T, float>::v) { return pack8(*(const f32x4*)p, *(const f32x4*)(p + 4)); }
    else { return *reinterpret_cast<const bf16x8*>(p); }
}
__device__ __forceinline__ void mask_tile(f32x16& p0, f32x16& p1, int dq, unsigned W) {
    const float NEG = -__builtin_inff();
#pragma unroll
    for (int r = 0; r < 16; ++r) {
        const int c = (r & 3) + 8 * (r >> 2);
        if ((unsigned)(dq - c) >= W) p0[r] = NEG;
        if ((unsigned)(dq - c - 32) >= W) p1[r] = NEG;
    }
}
__device__ __forceinline__ void partialSM(f32x16& p0, f32x16& p1, float& m_reg, float& mn, float& alpha) {
    float pmax = p0[0]; for (int r = 1; r < 16; ++r) pmax = fmaxf(pmax, p0[r]); for (int r = 0; r < 16; ++r) pmax = fmaxf(pmax, p1[r]);
    { auto rr = __builtin_amdgcn_permlane32_swap(__float_as_uint(pmax), __float_as_uint(pmax), false, false);
      pmax = fmaxf(__uint_as_float(rr[0]), __uint_as_float(rr[1])); }
    constexpr float C2 = 1.4426950408889634f * SCALE;
    if (__builtin_expect(__all((pmax - m_reg) * SCALE <= THR), 1)) { mn = m_reg; alpha = 1.f; }
    else { mn = fmaxf(m_reg, pmax); alpha = __builtin_amdgcn_exp2f((m_reg - mn) * C2); m_reg = mn; }
    const float mnL = -mn * C2;
    for (int r = 0; r < 16; ++r) p0[r] = fmaf(p0[r], C2, mnL); for (int r = 0; r < 16; ++r) p1[r] = fmaf(p1[r], C2, mnL);
    for (int r = 0; r < 16; ++r) p0[r] = __builtin_amdgcn_exp2f(p0[r]);
}
__device__ __forceinline__ void finishSM(f32x16& p0, f32x16& p1, float alpha, float& l_reg, bf16x8& pa0, bf16x8& pa1, bf16x8& pa2, bf16x8& pa3) {
    for (int r = 0; r < 16; ++r) p1[r] = __builtin_amdgcn_exp2f(p1[r]);
    float ps = 0; for (int r = 0; r < 16; ++r) ps += p0[r]; for (int r = 0; r < 16; ++r) ps += p1[r];
    { auto rr = __builtin_amdgcn_permlane32_swap(__float_as_uint(ps), __float_as_uint(ps), false, false);
      ps = __uint_as_float(rr[0]) + __uint_as_float(rr[1]); }
    l_reg = l_reg * alpha + ps;
#define PK4(P, B_, OUT) do { unsigned a0 = cvtpk(P[B_+0], P[B_+1]), a1 = cvtpk(P[B_+2], P[B_+3]);                          \
        unsigned b0 = cvtpk(P[B_+4], P[B_+5]), b1 = cvtpk(P[B_+6], P[B_+7]);                                             \
        auto r0 = __builtin_amdgcn_permlane32_swap(a0, b0, false, false); auto r1 = __builtin_amdgcn_permlane32_swap(a1, b1, false, false); \
        u32x4 w = {r0[0], r1[0], r0[1], r1[1]}; OUT = *reinterpret_cast<bf16x8*>(&w); } while (0)
    PK4(p0, 0, pa0); PK4(p0, 8, pa1); PK4(p1, 0, pa2); PK4(p1, 8, pa3);
#undef PK4
}
template <int KB, bool SK>
__device__ __forceinline__ void qkt(f32x16& p0, f32x16& p1, const char* K_lds, int r32, int hi, const bf16x8* qr, bool act, int bia) {
    if (SK && !act) { const float NEG = -__builtin_inff();
#pragma unroll
        for (int r = 0; r < 16; ++r) { p0[r] = NEG; p1[r] = NEG; } return; }
    {
#pragma unroll
        for (int g = 0; g < 4; ++g) { typedef const __attribute__((address_space(3))) f32x4* lp4; const f32x4 a = *(lp4)(uintptr_t)(unsigned)(bia + 32 * g), b = *(lp4)(uintptr_t)(unsigned)(bia + 128 + 32 * g);
            p0[4 * g] = a[0]; p0[4 * g + 1] = a[1]; p0[4 * g + 2] = a[2]; p0[4 * g + 3] = a[3];
            p1[4 * g] = b[0]; p1[4 * g + 1] = b[1]; p1[4 * g + 2] = b[2]; p1[4 * g + 3] = b[3]; } }
    const char* kb[4];
#pragma unroll
    for (int dd = 0; dd < 4; ++dd) kb[dd] = K_lds + KB * SHM_K + KSWZ(r32, (dd * 16 + hi * 8) * 2);
#pragma unroll
    for (int d0 = 0; d0 < 8; ++d0) { const char* a = kb[d0 & 3] + (d0 >> 2) * 128;
        bf16x8 b0 = *reinterpret_cast<const bf16x8*>(a);
        bf16x8 b1 = *reinterpret_cast<const bf16x8*>(a + 32 * 256);
        p0 = __builtin_amdgcn_mfma_f32_32x32x16_bf16(b0, qr[d0], p0, 0, 0, 0);
        p1 = __builtin_amdgcn_mfma_f32_32x32x16_bf16(b1, qr[d0], p1, 0, 0, 0); }
}
template <int VB, bool SK>
__device__ __forceinline__ void pv_tile(f32x16* o, int vb0, bf16x8 pa0, bf16x8 pa1, bf16x8 pa2, bf16x8 pa3, bool act) {
    if (SK && !act) return;
#define TRRD(dst, off) asm volatile("ds_read_b64_tr_b16 %0, %1 offset:%2" : "=&v"(dst) : "v"(vb0), "i"(off) : "memory")
#define PV_D0(d0) do { s16x4 l0, l1, l2, l3, h0, h1, h2, h3; constexpr int b_ = VB * SHM_V + v_rd_off(d0, 0, 0);     \
        TRRD(l0, b_); TRRD(h0, b_ + 2048); TRRD(l1, b_ + 4096); TRRD(h1, b_ + 6144); TRRD(l2, b_ + 8192); TRRD(h2, b_ + 10240); TRRD(l3, b_ + 12288); TRRD(h3, b_ + 14336); \
        asm volatile("s_waitcnt lgkmcnt(0)" ::: "memory"); SBAR();                 \
        o[d0] = __builtin_amdgcn_mfma_f32_32x32x16_bf16(pa0, (bf16x8){l0[0], l0[1], l0[2], l0[3], h0[0], h0[1], h0[2], h0[3]}, o[d0], 0, 0, 0);   \
        o[d0] = __builtin_amdgcn_mfma_f32_32x32x16_bf16(pa1, (bf16x8){l1[0], l1[1], l1[2], l1[3], h1[0], h1[1], h1[2], h1[3]}, o[d0], 0, 0, 0);   \
        o[d0] = __builtin_amdgcn_mfma_f32_32x32x16_bf16(pa2, (bf16x8){l2[0], l2[1], l2[2], l2[3], h2[0], h2[1], h2[2], h2[3]}, o[d0], 0, 0, 0);   \
        o[d0] = __builtin_amdgcn_mfma_f32_32x32x16_bf16(pa3, (bf16x8){l3[0], l3[1], l3[2], l3[3], h3[0], h3[1], h3[2], h3[3]}, o[d0], 0, 0, 0); } while (0)
    PV_D0(0); PV_D0(1); PV_D0(2); PV_D0(3);
#undef PV_D0
#undef TRRD
}

template <class TIn, class TOut> struct BlockRef { const TIn* Q; const TIn* K; const TIn* V; TOut* O; int P0; };
template <class TIn> struct Seam {
    bf16x8 qr[8];
    bf16x8 st_v0, st_v1, st_k0, st_k1; f32x4 sf0, sf1, sf2, sf3;
    f32x4 tq[16];
};
__device__ __forceinline__ int swa_jlo(int P0, int W) { const int lowk = P0 - W + 1; return lowk > 0 ? lowk / KVBLK : 0; }
#define ROW(p, k0, rr) ((p) + (size_t)((k0) + (rr)) * RS + sc)
#define VMW() asm volatile("s_waitcnt vmcnt(0)" ::: "memory")
#define VMWN(n) asm volatile("s_waitcnt vmcnt(%0)" :: "i"(n) : "memory")
#define SLOAD_H(Kp, Vp, k0) do { S.st_v0 = load8<TIn>(ROW(Vp, k0, sr)); S.st_v1 = load8<TIn>(ROW(Vp, k0, 32 + sr));              \
                         S.st_k0 = load8<TIn>(ROW(Kp, k0, sr)); S.st_k1 = load8<TIn>(ROW(Kp, k0, 32 + sr)); } while (0)
#define SWRITE_HK(bf) do { *(bf16x8*)(K_lds + (bf) * SHM_K + kws) = S.st_k0; *(bf16x8*)(K_lds + (bf) * SHM_K + kws + 32 * 256) = S.st_k1; } while (0)
#define SWRITE_HV(bf) do { *(bf16x8*)(V_lds + (bf) * SHM_V + vst0) = S.st_v0; *(bf16x8*)(V_lds + (bf) * SHM_V + vst1) = S.st_v1; } while (0)
#define SWRITE_H(bf) do { SWRITE_HV(bf); SWRITE_HK(bf); } while (0)
#define SLOAD_F(p, k0) do { S.sf0 = *(const f32x4*)ROW(p, k0, sr); S.sf1 = *(const f32x4*)(ROW(p, k0, sr) + 4);                \
                            S.sf2 = *(const f32x4*)ROW(p, k0, 32 + sr); S.sf3 = *(const f32x4*)(ROW(p, k0, 32 + sr) + 4); } while (0)
#define SWRITE_KF(bf) do { *(bf16x8*)(K_lds + (bf) * SHM_K + kws) = pack8(S.sf0, S.sf1); *(bf16x8*)(K_lds + (bf) * SHM_K + kws + 32 * 256) = pack8(S.sf2, S.sf3); } while (0)
#define SWRITE_VF(bf) do { *(bf16x8*)(V_lds + (bf) * SHM_V + vst0) = pack8(S.sf0, S.sf1); *(bf16x8*)(V_lds + (bf) * SHM_V + vst1) = pack8(S.sf2, S.sf3); } while (0)
template <class TIn, class TOut>
__device__ __forceinline__ void causal_swa_prime(const BlockRef<TIn, TOut>& cur, int W, char* lds, Seam<TIn>& S) {
    constexpr bool F32 = same_t<TIn, float>::v;
    const int tid = att_tid(), wid = __builtin_amdgcn_readfirstlane(tid >> 6), lane = tid & 63, r32 = lane & 31, hi = lane >> 5;
    const int sr = tid >> 4, sc = (tid & 15) * 8, kws = KSWZ(sr, sc * 2); char* K_lds = lds + 2 * SHM_V;
    const int kb0 = swa_jlo(cur.P0, W) * KVBLK;
    for (int d0 = 0; d0 < 8; ++d0) S.qr[d0] = load8<TIn>(cur.Q + (size_t)(wid * QBLK + r32) * RS + d0 * 16 + hi * 8);
    if constexpr (F32) { SLOAD_F((const float*)cur.K, kb0); VMW(); SWRITE_KF(0); SBAR(); SLOAD_F((const float*)cur.V, kb0); }
    else { SLOAD_H(cur.K, cur.V, kb0); VMW(); SWRITE_HK(0); }
    __syncthreads();
}
template <class TIn, class TOut>
__device__ __forceinline__ void causal_swa_block(const BlockRef<TIn, TOut>& cur, const BlockRef<TIn, TOut>& nxt, int skv, int W, char* lds, Seam<TIn>& S, const float* __restrict__ biasG) {
    constexpr bool F32 = same_t<TIn, float>::v;
    const int tid = att_tid(), wid = __builtin_amdgcn_readfirstlane(tid >> 6), lane = tid & 63, r32 = lane & 31, hi = lane >> 5;
    const int j_lo = swa_jlo(cur.P0, W);
    int j_hi = (cur.P0 + QB - 1) / KVBLK + 1; if (j_hi > skv / KVBLK) j_hi = skv / KVBLK;
    const int NT = j_hi - j_lo;
    {
        float* bl = (float*)(lds + LDS_BYTES);
        unsigned t0 = (unsigned)tid; asm volatile("" : "+v"(t0));
        for (unsigned i4 = t0; i4 < (unsigned)(j_hi * 16); i4 += 512u) *(f32x4*)(bl + 4u * i4) = *(const f32x4*)((const char*)biasG + 16u * i4);
        __syncthreads(); }
    const int biaL = (int)(uintptr_t)(lds + LDS_BYTES) + 16 * hi;
    const int kbn = swa_jlo(nxt.P0, W) * KVBLK;
    const int qlo = cur.P0 + wid * QBLK, qm = qlo + r32 - 4 * hi;
    char* V_lds = lds; char* K_lds = lds + 2 * SHM_V;
    float* ws = (float*)(lds + 2 * SHM_V + 2 * SHM_K) + wid * 64; float* li_l = ws, * al_l = ws + 32;
    float m_reg = -1e30f, l_reg = 0; f32x16 o[4] = {};
    const int sr = tid >> 4, sc = (tid & 15) * 8, vst0 = v_st(sr, sc), vst1 = v_st(32 + sr, sc), kws = KSWZ(sr, sc * 2);
    const int vb0 = (int)(uintptr_t)V_lds + v_rd_base(lane);
    const TIn* Kh = cur.K; const TIn* Vh = cur.V;
#define RESC(a) do { if (__any((a) < 1.f)) { if (hi == 0) al_l[r32] = (a); asm volatile("s_waitcnt lgkmcnt(0)" ::: "memory");              \
                     for (int d_ = 0; d_ < 4; ++d_) for (int r = 0; r < 16; ++r) o[d_][r] *= al_l[crow(r, hi)]; } } while (0)
#define KBASE(t) ((j_lo + (t)) * KVBLK)
#define ACT(t) (KBASE(t) <= qlo + QBLK - 1 && KBASE(t) + KVBLK - 1 >= qlo - W + 1)
#define MASKT(P0_, P1_, t) do { const int kb_ = KBASE(t); if ((!SK || ACT(t)) && (kb_ + KVBLK - 1 > qlo || kb_ <= qlo + QBLK - 1 - W)) mask_tile(P0_, P1_, qm - kb_, (unsigned)W); } while (0)
    constexpr int NQL = F32 ? 16 : 8;
    constexpr bool SK = WSKIP && !F32;
#define SEAM_K0() do { VMWN(NQL); if constexpr (F32) { SWRITE_KF(0); SBAR(); SLOAD_F((const float*)nxt.V, kbn); } else { SWRITE_HK(0); } SBAR(); } while (0)
    f32x16 pA0, pA1, pB0, pB1; float mnA, mnB, alA, alB; bf16x8 pa0, pa1, pa2, pa3;
    if constexpr (F32) { VMW(); SWRITE_VF(0); SBAR(); } else { SWRITE_HV(0); SBAR(); }
    if (NT > 1) { if constexpr (F32) SLOAD_F((const float*)Kh, KBASE(1)); else SLOAD_H(Kh, Vh, KBASE(1)); }
    SBAR(); qkt<0, SK>(pA0, pA1, K_lds, r32, hi, S.qr, ACT(0), biaL + 4 * KBASE(0));
    if constexpr (F32) { if (NT > 1) { VMW(); SWRITE_KF(1); SBAR(); SLOAD_F((const float*)Vh, KBASE(1)); } }
    MASKT(pA0, pA1, 0); partialSM(pA0, pA1, m_reg, mnA, alA);
    if (NT > 1) { VMW(); if constexpr (F32) { SWRITE_VF(1); SBAR(); if (NT > 2) SLOAD_F((const float*)Kh, KBASE(2)); } else SWRITE_H(1); }
    __syncthreads();
#define HALF_STEP(PX0, PX1, mnX, alX, PY0, PY1, alY, t, KB, VB, SB) do {                                                      \
        SBAR(); qkt<KB, SK>(PX0, PX1, K_lds, r32, hi, S.qr, ACT(t), biaL + 4 * KBASE(t));                                             \
        finishSM(PY0, PY1, alY, l_reg, pa0, pa1, pa2, pa3); SBAR();                                                           \
        if ((t) + 1 < NT) { if constexpr (F32) { VMW(); SWRITE_KF(SB); SBAR(); SLOAD_F((const float*)Vh, KBASE((t) + 1)); }  \
                            else { SLOAD_H(Kh, Vh, KBASE((t) + 1)); } SBAR(); }                                               \
        pv_tile<VB, SK>(o, vb0, pa0, pa1, pa2, pa3, ACT((t) - 1)); MASKT(PX0, PX1, (t)); partialSM(PX0, PX1, m_reg, mnX, alX);                                        \
        __syncthreads();                                                                                                      \
        if ((t) + 1 < NT) { VMW(); if constexpr (F32) { SWRITE_VF(SB); SBAR(); if ((t) + 2 < NT) SLOAD_F((const float*)Kh, KBASE((t) + 2)); } \
                            else { SWRITE_H(SB); } }                                                                          \
        RESC(alX); __syncthreads(); } while (0)
    for (int t = 1; t + 1 < NT; t += 2) {
        HALF_STEP(pB0, pB1, mnB, alB, pA0, pA1, alA, t, 1, 0, 0);
        HALF_STEP(pA0, pA1, mnA, alA, pB0, pB1, alB, t + 1, 0, 1, 1);
    }
    const bool even = (NT & 1) == 0;
    if (even) { SBAR(); qkt<1, SK>(pB0, pB1, K_lds, r32, hi, S.qr, ACT(NT - 1), biaL + 4 * KBASE(NT - 1)); SBAR(); }
#define QROW(e) (nxt.Q + (size_t)(wid * QBLK + r32) * RS + ((e) >> 1) * 16 + hi * 8 + ((e) & 1) * 4)
    if constexpr (F32) { SLOAD_F((const float*)nxt.K, kbn); SBAR();
#pragma unroll
        for (int e = 0; e < 8; ++e) S.tq[e] = *(const f32x4*)QROW(e); }
    else { SLOAD_H(nxt.K, nxt.V, kbn); SBAR();
#pragma unroll
        for (int d0 = 0; d0 < 8; ++d0) S.qr[d0] = load8<TIn>(nxt.Q + (size_t)(wid * QBLK + r32) * RS + d0 * 16 + hi * 8); }
    SBAR();
    finishSM(pA0, pA1, alA, l_reg, pa0, pa1, pa2, pa3); SBAR();
    if constexpr (F32) {
#pragma unroll
        for (int e = 8; e < 16; ++e) S.tq[e] = *(const f32x4*)QROW(e); SBAR(); }
#undef QROW
    pv_tile<0, SK>(o, vb0, pa0, pa1, pa2, pa3, ACT(even ? NT - 2 : NT - 1));
    if (even) { MASKT(pB0, pB1, NT - 1); partialSM(pB0, pB1, m_reg, mnB, alB); __syncthreads(); RESC(alB);
        finishSM(pB0, pB1, alB, l_reg, pa0, pa1, pa2, pa3); SBAR(); pv_tile<1, SK>(o, vb0, pa0, pa1, pa2, pa3, ACT(NT - 1)); }
    SBAR(); SEAM_K0();
    if (hi == 0) li_l[r32] = l_reg; asm volatile("s_waitcnt lgkmcnt(0)" ::: "memory");
    float rli[16];
#pragma unroll
    for (int r = 0; r < 16; ++r) rli[r] = __builtin_amdgcn_rcpf(li_l[crow(r, hi)]);
    TOut* Ow = cur.O + (size_t)(wid * QBLK) * RS;
#pragma unroll
    for (int r = 0; r < 16; ++r) { const int orow = crow(r, hi);
#pragma unroll
        for (int d0 = 0; d0 < 4; ++d0) { const float v = o[d0][r] * rli[r];
            if constexpr (same_t<TOut, float>::v) { Ow[(size_t)orow * RS + d0 * 32 + r32] = v; }
            else { const float vn = __shfl_xor(v, 1);
                   if ((r32 & 1) == 0) *(unsigned*)(Ow + (size_t)orow * RS + d0 * 32 + r32) = cvtpk(v, vn); } } }
    if constexpr (F32) {
#pragma unroll
        for (int d0 = 0; d0 < 8; ++d0) S.qr[d0] = pack8(S.tq[2 * d0], S.tq[2 * d0 + 1]); }
    __syncthreads();
#undef RESC
#undef KBASE
#undef ACT
#undef MASKT
#undef SEAM_K0
#undef HALF_STEP
}
#undef ROW
#undef VMW
#undef VMWN
#undef SLOAD_H
#undef SWRITE_HK
#undef SWRITE_HV
#undef SWRITE_H
#undef SLOAD_F
#undef SWRITE_KF
#undef SWRITE_VF
}
#ifndef MK_SPLIT
#define MK_SPLIT 0
#endif
#define LAS __attribute__((address_space(3)))
typedef unsigned short bf16_t;
typedef float v4f __attribute__((ext_vector_type(4)));
typedef float v2f __attribute__((ext_vector_type(2)));
typedef unsigned v4u __attribute__((ext_vector_type(4)));
typedef unsigned v2u __attribute__((ext_vector_type(2)));
typedef short h8 __attribute__((ext_vector_type(8)));

constexpr int DM = 2048, SEQ = 8192, NMETA = 16, NH = 8, HD = 128, DATT = 1024, DSSM = 1024, NG = 64, NP = 64, DFF = 5632, NIN = 8200;
constexpr int MREAL = 2 * SEQ;
constexpr int MROWS = MREAL + NMETA;
constexpr int RPAD = 16640;
constexpr int PPOS = 8256;
constexpr float EPS = 1e-6f;
constexpr float INV_SCALE = 11.313708498984761f;
constexpr int LDS_BYTES = 147456;

constexpr size_t MiB = 1u << 20;
constexpr size_t OFF_WT_UP = 0, OFF_WT_DOWN = 44 * MiB, OFF_WT_OUT = 66 * MiB, OFF_WT_IN = 74 * MiB, OFF_WT_O = 106 * MiB, OFF_WT_GLU = 110 * MiB;
constexpr size_t OFF_KT = 118 * MiB, OFF_WTS = 120 * MiB, OFF_VTS = 136 * MiB, OFF_MISC = 152 * MiB;
constexpr size_t OFF_GP = OFF_MISC, OFF_RSTD0 = OFF_MISC + 640 * 1024, OFF_SUMSQ1 = OFF_MISC + 768 * 1024, OFF_SUMSQ2 = OFF_MISC + 896 * 1024,
                 OFF_LF = OFF_MISC + 1024 * 1024, OFF_BIAS = OFF_MISC + 1664 * 1024, OFF_GP2 = OFF_MISC + 2560 * 1024, OFF_BAR = OFF_MISC + 3072 * 1024;
constexpr size_t OFF_H0B = 156 * MiB, OFF_OB = 156 * MiB, OFF_YG = OFF_OB + (size_t)RPAD * 1024 * 2;
constexpr size_t OFF_Q = 221 * MiB, OFF_K = 254 * MiB, OFF_V = 287 * MiB, OFF_UB = 320 * MiB, OFF_SGA = 353 * MiB, OFF_SGB = 418 * MiB;
constexpr size_t OFF_M1 = 221 * MiB, OFF_MERGED = 286 * MiB, OFF_H1B = 74 * MiB, OFF_G = 156 * MiB, OFF_U = 333 * MiB;
constexpr size_t WS_NEED = OFF_U + (size_t)MROWS * DFF * 2;
static_assert(WS_NEED <= 512 * MiB, "ws map");
static_assert(OFF_YG + (size_t)RPAD * 1024 * 2 <= OFF_Q && OFF_G + (size_t)MROWS * DFF * 2 <= OFF_U, "ws map 2");

struct Args { const float* in[22]; float* out; unsigned char* ws; int ph_lo, ph_hi; };
static_assert(sizeof(Args) == 22 * 8 + 8 + 8 + 8, "no padding");
enum { I_X = 0, I_META, I_GMIX, I_WIN, I_BF, I_LRE, I_LIM, I_LOGDT, I_BRE, I_BIM, I_CRE, I_CIM, I_DSKIP, I_WGLU, I_WATTO, I_WOUT, I_GFFN, I_WUP, I_CONVW, I_CONVB, I_WDOWN, I_GFINAL };

__device__ __forceinline__ float bf2f(unsigned short h) { return __uint_as_float((unsigned)h << 16); }
__device__ __forceinline__ float bflo(unsigned w) { return __uint_as_float(w << 16); }
__device__ __forceinline__ float bfhi(unsigned w) { return __uint_as_float(w & 0xffff0000u); }
__device__ __forceinline__ unsigned pk2(float lo, float hi) { return pg8::cvt_pk_bf16(lo, hi); }
__device__ __forceinline__ unsigned pk2n(float lo, float hi) { unsigned r; asm("v_cvt_pk_bf16_f32 %0, %1, %2" : "=v"(r) : "v"(lo), "v"(hi)); return r; }
__device__ __forceinline__ float sigmoidf_(float x) { return __builtin_amdgcn_rcpf(1.f + __expf(-x)); }
__device__ __forceinline__ float gelu_tanh(float x) { const float u = 0.7978845608028654f * (x + 0.044715f * x * x * x); return x * sigmoidf_(2.f * u); }
__device__ __forceinline__ float wave_sum(float v) {
#pragma unroll
    for (int o = 1; o < 64; o <<= 1) v += __shfl_xor(v, o);
    return v;
}
#define LDS_WAIT() asm volatile("s_waitcnt lgkmcnt(0)" ::: "memory")
#if defined(__HIP_DEVICE_COMPILE__)
#define KARG_PTR(p_) unsigned long long p_ = (unsigned long long)__builtin_amdgcn_kernarg_segment_ptr(); asm volatile("" : "+s"(p_))
#define LOAD_ARGS(name) Args name; { KARG_PTR(p_); name = *(const __attribute__((address_space(4))) Args*)p_; } unsigned char* ws = name.ws
__device__ __forceinline__ bool ph_in(int k) { KARG_PTR(p_); const __attribute__((address_space(4))) Args* q = (const __attribute__((address_space(4))) Args*)p_; return q->ph_lo <= k && k < q->ph_hi; }
#else
#define LOAD_ARGS(name) Args name{}; unsigned char* ws = name.ws
__device__ __forceinline__ bool ph_in(int k) { return false; }
#endif

__device__ __forceinline__ void tr_item(const float* __restrict__ W, int K, int Nsrc, int nsrc0, bf16_t* __restrict__ WT, int ndst0, int k0, const float* __restrict__ ksc, LAS float* scr, int lane) {
    const float* src = W + (size_t)k0 * Nsrc + nsrc0 + lane;
    float v[64];
#pragma unroll
    for (int i = 0; i < 64; ++i) v[i] = __builtin_nontemporal_load(src + (size_t)i * Nsrc);
    if (ksc) { const float sc = ksc[k0 + lane];
#pragma unroll
        for (int i = 0; i < 64; ++i) v[i] *= __uint_as_float(__builtin_amdgcn_readlane(__float_as_uint(sc), i)); }
#pragma unroll
    for (int i = 0; i < 64; ++i) scr[i * 65 + lane] = v[i];
    LDS_WAIT(); asm volatile("" ::: "memory");
    const int c = lane & 7;
#pragma unroll
    for (int j = 0; j < 8; ++j) { const int n = (lane >> 3) + 8 * j; const LAS float* q = scr + (8 * c) * 65 + n;
        v4u o; o.x = pk2(q[0 * 65], q[1 * 65]); o.y = pk2(q[2 * 65], q[3 * 65]); o.z = pk2(q[4 * 65], q[5 * 65]); o.w = pk2(q[6 * 65], q[7 * 65]);
        *(v4u*)(WT + (size_t)(ndst0 + n) * K + k0 + 8 * c) = o; }
    LDS_WAIT(); asm volatile("" ::: "memory");
}
__device__ __forceinline__ int ilv_src(int n, int half) { const int t = n >> 8, w = n & 255; return w < 128 ? 128 * t + w : half + 128 * t + (w - 128); }

__device__ __forceinline__ void p0_transposes(const Args& a, LAS unsigned char* lds, int gw, int NGW, int wid, int lane) {
    LAS float* scr = (LAS float*)(lds + wid * 16640);
    unsigned char* ws = a.ws;
    constexpr int I_IN = (DM / 64) * (8192 / 64), I_O = (DATT / 64) * (DM / 64), I_GLU = (DSSM / 64) * (4096 / 64), I_OUT = (DM / 64) * (DM / 64), I_UP = (DM / 64) * (2 * DFF / 64), I_DN = (DFF / 64) * (DM / 64);
    constexpr int NIT = I_IN + I_O + I_GLU + I_OUT + I_UP + I_DN;
    for (int it = gw; it < NIT; it += NGW) {
        int r = it;
        if (r < I_UP) { const int nb = r % (2 * DFF / 64), kb = r / (2 * DFF / 64), nd = 64 * nb; tr_item(a.in[I_WUP], DM, 2 * DFF, ilv_src(nd, DFF), (bf16_t*)(ws + OFF_WT_UP), nd, 64 * kb, a.in[I_GFFN], scr, lane); continue; } r -= I_UP;
        if (r < I_IN) { const int nb = r % 128, kb = r / 128, nd = 64 * nb; tr_item(a.in[I_WIN], DM, NIN, nd < 3072 ? nd : nd + 8, (bf16_t*)(ws + OFF_WT_IN), nd, 64 * kb, a.in[I_GMIX], scr, lane); continue; } r -= I_IN;
        if (r < I_DN) { const int nb = r % 32, kb = r / 32; tr_item(a.in[I_WDOWN], DFF, DM, 64 * nb, (bf16_t*)(ws + OFF_WT_DOWN), 64 * nb, 64 * kb, nullptr, scr, lane); continue; } r -= I_DN;
        if (r < I_GLU) { const int nb = r % 64, kb = r / 64, nd = 64 * nb; tr_item(a.in[I_WGLU], DSSM, 4096, ilv_src(nd, 2048), (bf16_t*)(ws + OFF_WT_GLU), nd, 64 * kb, nullptr, scr, lane); continue; } r -= I_GLU;
        if (r < I_OUT) { const int nb = r % 32, kb = r / 32; tr_item(a.in[I_WOUT], DM, DM, 64 * nb, (bf16_t*)(ws + OFF_WT_OUT), 64 * nb, 64 * kb, nullptr, scr, lane); continue; } r -= I_OUT;
        { const int nb = r % 32, kb = r / 32; tr_item(a.in[I_WATTO], DATT, DM, 64 * nb, (bf16_t*)(ws + OFF_WT_O), 64 * nb, 64 * kb, nullptr, scr, lane); }
    }
}

constexpr int WF_OFF = 69632;
__device__ __forceinline__ void p0_rows(const Args& a, LAS unsigned char* lds, int gw, int NGW, int lane) {
    unsigned char* ws = a.ws;
    LAS float* wf = (LAS float*)(lds + WF_OFF);
    bf16_t* H0B = (bf16_t*)(ws + OFF_H0B); float* RSTD0 = (float*)(ws + OFF_RSTD0); float* LF = (float*)(ws + OFF_LF);
    const float* bfp = a.in[I_BF];
    for (int r = gw; r < RPAD; r += NGW) {
        v2u* o8 = (v2u*)(H0B + (size_t)r * DM) + lane;
        if (r >= MROWS) {
#pragma unroll
            for (int j = 0; j < 8; ++j) o8[64 * j] = (v2u){0u, 0u};
            if (lane == 0) RSTD0[r] = 0.f;
            continue;
        }
        const float* src = r < MREAL ? a.in[I_X] + (size_t)r * DM : a.in[I_META] + (size_t)(r - MREAL) * DM;
        const v4f* xr = (const v4f*)src + lane;
        v4f v[8]; float s2 = 0.f;
#pragma unroll
        for (int j = 0; j < 8; ++j) { v[j] = __builtin_nontemporal_load(xr + 64 * j); s2 += (v[j].x * v[j].x + v[j].y * v[j].y) + (v[j].z * v[j].z + v[j].w * v[j].w); }
        float f[8];
#pragma unroll
        for (int h = 0; h < 8; ++h) { float acc = 0.f;
#pragma unroll
            for (int j = 0; j < 8; ++j) { const v4f w = *(const LAS v4f*)(wf + h * 2048 + 256 * j + 4 * lane); acc += (v[j].x * w.x + v[j].y * w.y) + (v[j].z * w.z + v[j].w * w.w); }
            f[h] = acc; }
        s2 = wave_sum(s2);
        const float rstd = 1.0f / sqrtf(s2 * (1.f / DM) + EPS);
#pragma unroll
        for (int h = 0; h < 8; ++h) f[h] = wave_sum(f[h]);
#pragma unroll
        for (int j = 0; j < 8; ++j) o8[64 * j] = (v2u){pk2(v[j].x, v[j].y), pk2(v[j].z, v[j].w)};
        if (lane == 0) RSTD0[r] = rstd;
        if (lane < 8) {
            float fv = f[0];
#pragma unroll
            for (int h = 1; h < 8; ++h) fv = (lane == h) ? f[h] : fv;
            const float y = fv * rstd + bfp[lane];
            const float lf = fminf(y, 0.f) - log1pf(__expf(-fabsf(y)));
            if (r < MREAL) { const int b = r >> 13, i = r & 8191; LF[(size_t)(b * 8 + lane) * PPOS + 64 + i] = lf; }
            else { const int j = r - MREAL; LF[(size_t)lane * PPOS + 48 + j] = lf; LF[(size_t)(8 + lane) * PPOS + 48 + j] = lf; }
        }
    }
}

__device__ __forceinline__ void ssm_gen(LAS unsigned char* lds, int g, int part, int tid) {
    LAS float* TBr = (LAS float*)lds; LAS float* TBi = TBr + 65 * 64; LAS float* BBr = TBi + 65 * 64; LAS float* BBi = BBr + 1024; LAS float* CTr = BBi + 1024; LAS float* CTi = CTr + 1024;
    LAS double* AZ = (LAS double*)(CTi + 1024);
    if (tid < 64) { LOAD_ARGS(a); (void)ws; const int p = tid;
        const double dt = exp((double)a.in[I_LOGDT][g]);
        const double lr = (double)a.in[I_LRE][g * 64 + p], li = (double)a.in[I_LIM][g * 64 + p];
        const double mag = exp(lr * dt); double sn, cs; sincos(li * dt, &sn, &cs);
        const double are = mag * cs, aim = mag * sn, den = lr * lr + li * li, nr = are - 1.0;
        AZ[4 * p] = are; AZ[4 * p + 1] = aim; AZ[4 * p + 2] = (nr * lr + aim * li) / den; AZ[4 * p + 3] = (aim * lr - nr * li) / den; }
    __syncthreads();
    { LOAD_ARGS(a); float* GP = (float*)(ws + OFF_GP) + (size_t)g * 2304;
#pragma unroll 1
      for (int e = tid; e < 65 * 64; e += 512) { const int j = e >> 6, p = e & 63;
        double br = AZ[4 * p], bi = AZ[4 * p + 1], rr = 1.0, ri = 0.0;
#pragma unroll
        for (int bit = 0; bit < 7; ++bit) { if ((j >> bit) & 1) { const double t = rr * br - ri * bi; ri = rr * bi + ri * br; rr = t; } const double t2 = br * br - bi * bi; bi = 2.0 * br * bi; br = t2; }
        TBr[e] = (float)rr; TBi[e] = (float)ri;
        if (part == 0 && j == 1) { GP[p] = (float)rr; GP[64 + p] = (float)ri; }
        if (part == 0 && j == 64) { GP[128 + p] = (float)rr; GP[192 + p] = (float)ri; }
        if (part == 0 && (j == 16 || j == 32 || j == 48)) { float* G2 = (float*)(ws + OFF_GP2) + (size_t)g * 384 + ((j >> 4) - 1) * 128 + 2 * p; G2[0] = (float)rr; G2[1] = (float)ri; } }
#pragma unroll 1
      for (int e = tid; e < 1024; e += 512) { const int p = e >> 4; const double zr = AZ[4 * p + 2], zi = AZ[4 * p + 3];
        const double br = (double)a.in[I_BRE][(size_t)g * 1024 + e], bi = (double)a.in[I_BIM][(size_t)g * 1024 + e];
        const float bbr = (float)(zr * br - zi * bi), bbi = (float)(zr * bi + zi * br);
        BBr[e] = bbr; BBi[e] = bbi; if (part == 0) { GP[256 + e] = bbr; GP[1280 + e] = bbi; } }
#pragma unroll 1
      for (int e = tid; e < 1024; e += 512) { const int co = e >> 6, p = e & 63;
        CTr[p * 16 + co] = a.in[I_CRE][(size_t)g * 1024 + e]; CTi[p * 16 + co] = a.in[I_CIM][(size_t)g * 1024 + e]; } }
    __syncthreads();
    { LOAD_ARGS(a); (void)a; bf16_t* KT = (bf16_t*)(ws + OFF_KT) + (size_t)g * 16384;
      const int pair = tid & 255, co = pair >> 4, ci = pair & 15, j0 = 16 * part + 8 * (tid >> 8); float acc[8];
#pragma unroll
      for (int jj = 0; jj < 8; ++jj) acc[jj] = 0.f;
#pragma unroll 4
      for (int p = 0; p < 64; ++p) { const float cr = CTr[p * 16 + co], cim = CTi[p * 16 + co], br = BBr[p * 16 + ci], bi = BBi[p * 16 + ci], wr = cr * br - cim * bi, wi = cr * bi + cim * br;
#pragma unroll
          for (int jj = 0; jj < 8; ++jj) acc[jj] += wr * TBr[(j0 + jj) * 64 + p] - wi * TBi[(j0 + jj) * 64 + p]; }
#pragma unroll
      for (int jj = 0; jj < 8; ++jj) KT[(j0 + jj) * 256 + pair] = (bf16_t)(pk2(acc[jj], 0.f) & 0xffffu); }
    { LOAD_ARGS(a); (void)a; bf16_t* WTS = (bf16_t*)(ws + OFF_WTS) + (size_t)g * 131072;
#pragma unroll 1
      for (int it = 1024 * part + tid; it < 1024 * (part + 1); it += 512) { const int n = it >> 5, k8 = 96 + (it & 31), p = n >> 1, ri = n & 1, sx = k8 >> 1, c0 = (k8 & 1) * 8;
        const float tr = TBr[(63 - sx) * 64 + p], ti = TBi[(63 - sx) * 64 + p]; float v[8];
#pragma unroll
        for (int e = 0; e < 8; ++e) { const float br = BBr[p * 16 + c0 + e], bi = BBi[p * 16 + c0 + e]; v[e] = ri ? (tr * bi + ti * br) : (tr * br - ti * bi); }
        *(v4u*)(WTS + (size_t)n * 1024 + 8 * k8) = (v4u){pk2(v[0], v[1]), pk2(v[2], v[3]), pk2(v[4], v[5]), pk2(v[6], v[7])}; } }
    { LOAD_ARGS(a); (void)a; bf16_t* VTS = (bf16_t*)(ws + OFF_VTS) + (size_t)g * 131072;
#pragma unroll 1
      for (int it = 1024 * part + tid; it < 1024 * (part + 1); it += 512) { const int n = it >> 4, k8 = it & 15, t = n >> 4, co = n & 15; float v[8];
#pragma unroll
        for (int e = 0; e < 4; ++e) { const int p = 4 * k8 + e; const float tr = TBr[(t + 1) * 64 + p], ti = TBi[(t + 1) * 64 + p], cr = CTr[p * 16 + co], ci = CTi[p * 16 + co];
            v[2 * e] = cr * tr - ci * ti; v[2 * e + 1] = -(cr * ti + ci * tr); }
        *(v4u*)(VTS + (size_t)n * 128 + 8 * k8) = (v4u){pk2(v[0], v[1]), pk2(v[2], v[3]), pk2(v[4], v[5]), pk2(v[6], v[7])}; } }
    __syncthreads();
}

__device__ __forceinline__ void cumsum_seq(const Args& a, LAS unsigned char* lds, int seq, int tid) {
    const float* LF = (const float*)(a.ws + OFF_LF) + (size_t)seq * PPOS; float* BI = (float*)(a.ws + OFF_BIAS) + (size_t)seq * PPOS;
    LAS float* wsum = (LAS float*)lds;
    const int base = 48 + 17 * tid; float s = 0.f; float v[17];
#pragma unroll
    for (int i = 0; i < 17; ++i) v[i] = (base + i < PPOS) ? LF[base + i] : 0.f;
#pragma unroll
    for (int i = 0; i < 17; ++i) s += v[i];
    float inc = s;
#pragma unroll
    for (int o = 1; o < 64; o <<= 1) { const float t = __shfl_up(inc, o); if ((tid & 63) >= o) inc += t; }
    if ((tid & 63) == 63) wsum[tid >> 6] = inc;
    __syncthreads();
    float off = 0.f;
    for (int w = 0; w < (tid >> 6); ++w) off += wsum[w];
    float run = off + inc - s;
#pragma unroll
    for (int i = 0; i < 17; ++i) { run += v[i]; if (base + i < PPOS) BI[base + i] = -run * INV_SCALE; }
    if (tid < 48) BI[tid] = -__builtin_inff();
    __syncthreads();
}

struct EpiZ {
    static constexpr bool PERM = true, AFTER_DRAIN = false;
    const float* rstd; bf16_t *Q, *K, *V, *U, *SGA, *SGB;
    __device__ __forceinline__ void operator()(const pg8::f32x4 (&acc)[2][2][4][2], const pg8::Unit& u, int wr, int wc, int fr, int fq) const {
        const int pn = u.pn, sec = pn < 16 ? (pn >> 2) : (pn < 24 ? 4 : 5), colt = (pn < 16 ? (pn & 3) : (pn & 7)) * 256 + wc * 32 + 8 * fq;
        bf16_t* base = sec == 0 ? Q : (sec == 1 ? K : (sec == 2 ? V : (sec == 3 ? U : (sec == 4 ? SGA : SGB))));
        const int ld = sec >= 4 ? 2048 : 1024; const bool pos = sec >= 1 && sec <= 3, sg = sec >= 4;
#pragma unroll
        for (int ai = 0; ai < 2; ++ai)
#pragma unroll
            for (int m = 0; m < 4; ++m) { const int row = u.pm * 256 + ai * 128 + wr * 64 + m * 16 + fr; const float rs = rstd[row];
                int d1 = row, d2 = -1;
                if (pos) { const int j = row - MREAL; d1 = j < 0 ? (row >> 13) * PPOS + 64 + (row & 8191) : (j < NMETA ? 48 + j : -1); d2 = (j >= 0 && j < NMETA) ? PPOS + 48 + j : -1; }
#pragma unroll
                for (int bj = 0; bj < 2; ++bj) { const int col = colt + bj * 128; pg8::f32x4 v0 = acc[ai][bj][m][0] * rs, v1 = acc[ai][bj][m][1] * rs;
                    if (sg) { v0[0] = sigmoidf_(v0[0]); v0[1] = sigmoidf_(v0[1]); v0[2] = sigmoidf_(v0[2]); v0[3] = sigmoidf_(v0[3]); v1[0] = sigmoidf_(v1[0]); v1[1] = sigmoidf_(v1[1]); v1[2] = sigmoidf_(v1[2]); v1[3] = sigmoidf_(v1[3]); }
                    const v4u w = {pk2n(v0[0], v0[1]), pk2n(v0[2], v0[3]), pk2n(v1[0], v1[1]), pk2n(v1[2], v1[3])};
                    if (d1 >= 0) *(v4u*)(base + (size_t)d1 * ld + col) = w;
                    if (d2 >= 0) *(v4u*)(base + (size_t)d2 * ld + col) = w; } }
    }
};
__device__ __forceinline__ void unpack8(const v4u w, float (&f)[8]) { f[0] = bflo(w.x); f[1] = bfhi(w.x); f[2] = bflo(w.y); f[3] = bfhi(w.y); f[4] = bflo(w.z); f[5] = bfhi(w.z); f[6] = bflo(w.w); f[7] = bfhi(w.w); }
struct EpiO {
    static constexpr bool PERM = true, AFTER_DRAIN = false;
    const bf16_t* SGB; bf16_t* M1;
    __device__ __forceinline__ void operator()(const pg8::f32x4 (&acc)[2][2][4][2], const pg8::Unit& u, int wr, int wc, int fr, int fq) const {
        const size_t off0 = (size_t)(u.pm * 256 + wr * 64 + fr) * 2048 + u.pn * 256 + wc * 32 + 8 * fq;
        v4u sg[2][4][2];
#pragma unroll
        for (int ai = 0; ai < 2; ++ai)
#pragma unroll
            for (int m = 0; m < 4; ++m)
#pragma unroll
                for (int bj = 0; bj < 2; ++bj) sg[ai][m][bj] = *(const v4u*)(SGB + off0 + (size_t)(ai * 128 + m * 16) * 2048 + bj * 128);
#pragma unroll
        for (int ai = 0; ai < 2; ++ai)
#pragma unroll
            for (int m = 0; m < 4; ++m)
#pragma unroll
                for (int bj = 0; bj < 2; ++bj) { float sf[8]; unpack8(sg[ai][m][bj], sf); const pg8::f32x4 v0 = acc[ai][bj][m][0], v1 = acc[ai][bj][m][1];
                    *(v4u*)(M1 + off0 + (size_t)(ai * 128 + m * 16) * 2048 + bj * 128) = (v4u){pk2n(v0[0] * sf[0], v0[1] * sf[1]), pk2n(v0[2] * sf[2], v0[3] * sf[3]), pk2n(v1[0] * sf[4], v1[1] * sf[5]), pk2n(v1[2] * sf[6], v1[3] * sf[7])}; }
    }
};
struct EpiGlu {
    static constexpr bool PERM = true, AFTER_DRAIN = false;
    const bf16_t* SGA; const bf16_t* M1; bf16_t* MG;
    __device__ __forceinline__ void operator()(const pg8::f32x4 (&acc)[2][2][4][2], const pg8::Unit& u, int wr, int wc, int fr, int fq) const {
        const size_t off0 = (size_t)(u.pm * 256 + wr * 64 + fr) * 2048 + u.pn * 128 + wc * 32 + 8 * fq;
        v4u gav[2][4], m1v[2][4];
#pragma unroll
        for (int ai = 0; ai < 2; ++ai)
#pragma unroll
            for (int m = 0; m < 4; ++m) { const size_t off = off0 + (size_t)(ai * 128 + m * 16) * 2048; gav[ai][m] = *(const v4u*)(SGA + off); m1v[ai][m] = *(const v4u*)(M1 + off); }
#pragma unroll
        for (int ai = 0; ai < 2; ++ai)
#pragma unroll
            for (int m = 0; m < 4; ++m) { float ga[8], m1[8], o[8]; unpack8(gav[ai][m], ga); unpack8(m1v[ai][m], m1);
#pragma unroll
                for (int e = 0; e < 8; ++e) { const float ya = acc[ai][0][m][e >> 2][e & 3], yb = acc[ai][1][m][e >> 2][e & 3]; o[e] = m1[e] + ga[e] * ya * sigmoidf_(yb); }
                *(v4u*)(MG + off0 + (size_t)(ai * 128 + m * 16) * 2048) = (v4u){pk2n(o[0], o[1]), pk2n(o[2], o[3]), pk2n(o[4], o[5]), pk2n(o[6], o[7])}; }
    }
};
struct EpiOut {
    static constexpr bool PERM = true, AFTER_DRAIN = false;
    const float* X; float* OUT; bf16_t* H1B; float* SS;
    __device__ __forceinline__ void operator()(const pg8::f32x4 (&acc)[2][2][4][2], const pg8::Unit& u, int wr, int wc, int fr, int fq) const {
#pragma unroll
        for (int ai = 0; ai < 2; ++ai) { const size_t off0 = (size_t)(u.pm * 256 + ai * 128 + wr * 64 + fr) * DM + u.pn * 256 + wc * 32 + 8 * fq;
            pg8::f32x4 h0[4][2][2];
#pragma unroll
            for (int m = 0; m < 4; ++m)
#pragma unroll
                for (int bj = 0; bj < 2; ++bj) { const float* p = X + off0 + (size_t)(m * 16) * DM + bj * 128; h0[m][bj][0] = *(const pg8::f32x4*)p; h0[m][bj][1] = *(const pg8::f32x4*)(p + 4); }
#pragma unroll
            for (int m = 0; m < 4; ++m) { float ss = 0.f;
#pragma unroll
                for (int bj = 0; bj < 2; ++bj) { const size_t off = off0 + (size_t)(m * 16) * DM + bj * 128; const pg8::f32x4 v0 = acc[ai][bj][m][0] + h0[m][bj][0], v1 = acc[ai][bj][m][1] + h0[m][bj][1];
                    *(v4u*)(H1B + off) = (v4u){pk2n(v0[0], v0[1]), pk2n(v0[2], v0[3]), pk2n(v1[0], v1[1]), pk2n(v1[2], v1[3])};
                    ss += (v0[0] * v0[0] + v0[1] * v0[1]) + (v0[2] * v0[2] + v0[3] * v0[3]) + (v1[0] * v1[0] + v1[1] * v1[1]) + (v1[2] * v1[2] + v1[3] * v1[3]); }
                ss += __shfl_xor(ss, 16); ss += __shfl_xor(ss, 32);
                if (fq == 0) atomicAdd(SS + u.pm * 256 + ai * 128 + wr * 64 + m * 16 + fr, ss); } }
    }
};
struct EpiUp {
    static constexpr bool PERM = true, AFTER_DRAIN = false;
    const float* SS; bf16_t* G; bf16_t* U; const float* CW; const float* CB;
    __device__ __forceinline__ void operator()(const pg8::f32x4 (&acc)[2][2][4][2], const pg8::Unit& u, int wr, int wc, int fr, int fq) const {
        const int oc = u.pn * 128 + wc * 32 + 8 * fq, lm1 = (fq << 4) | ((fr - 1) & 15), lm2 = (fq << 4) | ((fr - 2) & 15);
        float w0[8], w1[8], w2[8], cb[8];
#pragma unroll
        for (int h = 0; h < 2; ++h) { const v4f x0 = *(const v4f*)(CW + oc + 4 * h), x1 = *(const v4f*)(CW + DFF + oc + 4 * h), x2 = *(const v4f*)(CW + 2 * DFF + oc + 4 * h), x3 = *(const v4f*)(CB + oc + 4 * h);
#pragma unroll
            for (int e = 0; e < 4; ++e) { w0[4 * h + e] = x0[e]; w1[4 * h + e] = x1[e]; w2[4 * h + e] = x2[e]; cb[4 * h + e] = x3[e]; } }
#pragma unroll
        for (int ai = 0; ai < 2; ++ai) { const int rbase = u.pm * 256 + ai * 128 + wr * 64; float gs[4][8], rs[4];
#pragma unroll
            for (int m = 0; m < 4; ++m) { rs[m] = 1.0f / sqrtf(SS[rbase + 16 * m + fr] * (1.f / DM) + EPS);
#pragma unroll
                for (int e = 0; e < 8; ++e) gs[m][e] = acc[ai][0][m][e >> 2][e & 3] * rs[m]; }
#pragma unroll
            for (int m = 0; m < 4; ++m) { const size_t off = (size_t)(rbase + 16 * m + fr) * DFF + oc; float o[8];
#pragma unroll
                for (int e = 0; e < 8; ++e) { const float a1 = __shfl(gs[m][e], lm1), a2 = __shfl(gs[m][e], lm2); float b1 = 0.f, b2 = 0.f;
                    if (m > 0) { b1 = __shfl(gs[m - 1][e], lm1); b2 = __shfl(gs[m - 1][e], lm2); }
                    const float p1 = fr >= 1 ? a1 : b1, p2 = fr >= 2 ? a2 : b2, gc = cb[e] + w0[e] * p2 + w1[e] * p1 + w2[e] * gs[m][e];
                    o[e] = gc * sigmoidf_(gc) * (acc[ai][1][m][e >> 2][e & 3] * rs[m]); }
                const v4u gw = {pk2n(gs[m][0], gs[m][1]), pk2n(gs[m][2], gs[m][3]), pk2n(gs[m][4], gs[m][5]), pk2n(gs[m][6], gs[m][7])};
                if (m == 0 && fr < 2) {
                    const pg8::f32x4 u0 = acc[ai][1][m][0] * rs[m], u1 = acc[ai][1][m][1] * rs[m];
                    *(v4u*)(G + off) = gw; *(v4u*)(U + off) = (v4u){pk2n(u0[0], u0[1]), pk2n(u0[2], u0[3]), pk2n(u1[0], u1[1]), pk2n(u1[2], u1[3])}; }
                else { *(v4u*)(U + off) = (v4u){pk2n(o[0], o[1]), pk2n(o[2], o[3]), pk2n(o[4], o[5]), pk2n(o[6], o[7])}; if (m == 3 && fr >= 14) *(v4u*)(G + off) = gw; } } }
    }
};
struct EpiDown {
    static constexpr bool PERM = true, AFTER_DRAIN = false;
    float* OUT; const bf16_t* H1B; float* SS;
    __device__ __forceinline__ void operator()(const pg8::f32x4 (&acc)[2][2][4][2], const pg8::Unit& u, int wr, int wc, int fr, int fq) const {
#pragma unroll
        for (int ai = 0; ai < 2; ++ai) { const size_t off0 = (size_t)(u.pm * 256 + ai * 128 + wr * 64 + fr) * DM + u.pn * 256 + wc * 32 + 8 * fq;
            v4u h1[4][2];
#pragma unroll
            for (int m = 0; m < 4; ++m)
#pragma unroll
                for (int bj = 0; bj < 2; ++bj) h1[m][bj] = *(const v4u*)(H1B + off0 + (size_t)(m * 16) * DM + bj * 128);
#pragma unroll
            for (int m = 0; m < 4; ++m) { float ss = 0.f;
#pragma unroll
                for (int bj = 0; bj < 2; ++bj) { float* p = OUT + off0 + (size_t)(m * 16) * DM + bj * 128; float hf[8]; unpack8(h1[m][bj], hf);
                    const pg8::f32x4 v0 = acc[ai][bj][m][0] + (pg8::f32x4){hf[0], hf[1], hf[2], hf[3]}, v1 = acc[ai][bj][m][1] + (pg8::f32x4){hf[4], hf[5], hf[6], hf[7]};
                    *(pg8::f32x4*)p = v0; *(pg8::f32x4*)(p + 4) = v1;
                    ss += (v0[0] * v0[0] + v0[1] * v0[1]) + (v0[2] * v0[2] + v0[3] * v0[3]) + (v1[0] * v1[0] + v1[1] * v1[1]) + (v1[2] * v1[2] + v1[3] * v1[3]); }
                ss += __shfl_xor(ss, 16); ss += __shfl_xor(ss, 32);
                if (fq == 0) atomicAdd(SS + u.pm * 256 + ai * 128 + wr * 64 + m * 16 + fr, ss); } }
    }
};

struct ChainOrder {
    pg8::StaticOrder base; const char *A0, *B0, *A1, *B1;
    __device__ void init(int M, int G_, int c_) { base.init(M, DM, G_, c_); }
    __device__ bool next(int i, pg8::Unit& u) const { pg8::Unit t; const int ti = i / 3, k = i - 3 * ti; if (!base.next(ti, t)) return false; u.pm = t.pm; u.kind = k ? 1 : 0; u.pn = k ? 2 * t.pn + (k - 1) : t.pn; return true; }
    template <class G_> __device__ __forceinline__ const char* abase(const G_&, const pg8::Unit& u) const { return u.kind ? A1 : A0; }
    template <class G_> __device__ __forceinline__ const char* bbase(const G_&, const pg8::Unit& u) const { return u.kind ? B1 : B0; }
    __device__ __forceinline__ void a_ready(const pg8::Unit&) const {}
    __device__ __forceinline__ void done(const pg8::Unit&) const {}
};
struct EpiOG {
    static constexpr bool PERM = true, AFTER_DRAIN = false;
    EpiO o; EpiGlu g;
    __device__ __forceinline__ void operator()(const pg8::f32x4 (&acc)[2][2][4][2], const pg8::Unit& u, int wr, int wc, int fr, int fq) const { if (u.kind == 0) o(acc, u, wr, wc, fr, fq); else g(acc, u, wr, wc, fr, fq); }
};

#define MFMA16(a, b, c) __builtin_amdgcn_mfma_f32_16x16x32_bf16(a, b, c, 0, 0, 0)
constexpr int SX_KT = 0, SX_W16 = 0, SX_HB = 32768, SX_Y = 69632, SX_TAB = 139264, SX_HSC = SX_TAB + 2048;
constexpr int W16ROW = 264, V16ROW = 136, SS_SROW = 132, SS_HROW = 136;
static_assert(SX_HB + 128 * SS_HROW * 2 <= SX_Y && 128 * W16ROW * 2 <= SX_Y && SX_Y + 256 * V16ROW * 2 <= SX_TAB && SX_Y + 128 * SS_SROW * 4 <= SX_TAB && SX_HSC + 512 <= LDS_BYTES, "ssm lds");
__device__ __forceinline__ void ssm_unit(const Args& a, LAS unsigned char* lds, int b, int g, int tid) {
    const int wid = __builtin_amdgcn_readfirstlane(tid >> 6), lane = tid & 63, fr = lane & 15, fq = lane >> 4;
    unsigned char* ws = a.ws;
    const bf16_t* UB = (const bf16_t*)(ws + OFF_UB) + (size_t)b * PPOS * 1024 + 16 * g;
    const float* GP = (const float*)(ws + OFF_GP) + (size_t)g * 2304;
    bf16_t* YG = (bf16_t*)(ws + OFF_YG);
    LAS float* Sst = (LAS float*)(lds + SX_Y); LAS bf16_t* Hb = (LAS bf16_t*)(lds + SX_HB); LAS float* hsc = (LAS float*)(lds + SX_HSC);
    LAS bf16_t* W16 = (LAS bf16_t*)(lds + SX_W16); LAS bf16_t* V16 = (LAS bf16_t*)(lds + SX_Y); LAS v2f* TAB = (LAS v2f*)(lds + SX_TAB);
    const bf16_t* ubw = UB + (size_t)(64 + 64 * (16 * wid + fr)) * 1024 + 8 * (fq & 1);
    h8 A[32];
#pragma unroll
    for (int ks = 0; ks < 32; ++ks) A[ks] = *(const h8*)(ubw + (size_t)(2 * ks + (fq >> 1)) * 1024);
    { const bf16_t* wsrc = (const bf16_t*)(ws + OFF_WTS) + (size_t)g * 131072 + 768;
#pragma unroll
      for (int i = 0; i < 8; ++i) { const int it = tid + 512 * i, n = it >> 5, c = it & 31; *(LAS v4u*)(W16 + n * W16ROW + 8 * c) = *(const v4u*)(wsrc + (size_t)n * 1024 + 8 * c); }
      if (tid < 192) TAB[64 + tid] = *(const v2f*)((const float*)(ws + OFF_GP2) + (size_t)g * 384 + 2 * tid); }
    float hr = 0.f, hi_ = 0.f;
    if (wid == 0) {
        const float are = GP[lane], aim = GP[64 + lane]; float bbr[16], bbi[16];
#pragma unroll
        for (int q = 0; q < 4; ++q) { const v4f r4 = *(const v4f*)(GP + 256 + lane * 16 + 4 * q), i4 = *(const v4f*)(GP + 1280 + lane * 16 + 4 * q);
            bbr[4 * q] = r4.x; bbr[4 * q + 1] = r4.y; bbr[4 * q + 2] = r4.z; bbr[4 * q + 3] = r4.w; bbi[4 * q] = i4.x; bbi[4 * q + 1] = i4.y; bbi[4 * q + 2] = i4.z; bbi[4 * q + 3] = i4.w; }
        const v2u uw_ = *(const v2u*)(UB + (size_t)(48 + (lane >> 2)) * 1024 + 4 * (lane & 3));
#pragma unroll 1
        for (int t = 0; t < 16; ++t) {
            float br = 0.f, bi = 0.f;
#pragma unroll
            for (int c4 = 0; c4 < 4; ++c4) { const unsigned sx = __builtin_amdgcn_readlane(uw_.x, 4 * t + c4), sy = __builtin_amdgcn_readlane(uw_.y, 4 * t + c4);
                const float u0 = bflo(sx), u1 = bfhi(sx), u2 = bflo(sy), u3 = bfhi(sy);
                br += bbr[4 * c4] * u0 + bbr[4 * c4 + 1] * u1 + bbr[4 * c4 + 2] * u2 + bbr[4 * c4 + 3] * u3;
                bi += bbi[4 * c4] * u0 + bbi[4 * c4 + 1] * u1 + bbi[4 * c4 + 2] * u2 + bbi[4 * c4 + 3] * u3; }
            const float nr = are * hr - aim * hi_ + br, ni = are * hi_ + aim * hr + bi; hr = nr; hi_ = ni;
            if (b == 0 && t >= 14) {
                hsc[2 * lane] = hr; hsc[2 * lane + 1] = hi_; LDS_WAIT(); asm volatile("" ::: "memory");
                if (lane < 16) { const float* cr = a.in[I_CRE] + ((size_t)g * 16 + lane) * 64; const float* ci = a.in[I_CIM] + ((size_t)g * 16 + lane) * 64; float y = 0.f;
#pragma unroll 16
                    for (int p = 0; p < 64; ++p) y += cr[p] * hsc[2 * p] - ci[p] * hsc[2 * p + 1];
                    y += a.in[I_DSKIP][16 * g + lane] * bf2f(UB[(size_t)(48 + t) * 1024 + lane]);
                    YG[(size_t)(MREAL + t) * 1024 + 16 * g + lane] = (bf16_t)(pk2(gelu_tanh(y), 0.f) & 0xffffu); }
                LDS_WAIT(); asm volatile("" ::: "memory");
            }
        }
    }
    __syncthreads();
#pragma unroll
    for (int nt = 0; nt < 8; ++nt) { pg8::f32x4 srun = {0.f, 0.f, 0.f, 0.f};
#pragma unroll
        for (int sub = 0; sub < 4; ++sub) { pg8::f32x4 ac = {0.f, 0.f, 0.f, 0.f};
#pragma unroll
            for (int kk = 0; kk < 8; ++kk) { const h8 B = *(const LAS h8*)(W16 + (16 * nt + fr) * W16ROW + 32 * kk + 8 * fq); ac = MFMA16(B, A[8 * sub + kk], ac); }
            if (sub == 0) srun = ac;
            else { const v2f f0 = TAB[64 + 8 * nt + 2 * fq], f1 = TAB[64 + 8 * nt + 2 * fq + 1]; const pg8::f32x4 o = srun;
                srun = (pg8::f32x4){f0.x * o[0] - f0.y * o[1] + ac[0], f0.x * o[1] + f0.y * o[0] + ac[1], f1.x * o[2] - f1.y * o[3] + ac[2], f1.x * o[3] + f1.y * o[2] + ac[3]}; } }
        *(LAS pg8::f32x4*)(Sst + (16 * wid + fr) * SS_SROW + 16 * nt + 4 * fq) = srun; }
    __syncthreads();
    { const v4u* src = (const v4u*)((const bf16_t*)(ws + OFF_KT) + (size_t)g * 16384); LAS v4u* dst = (LAS v4u*)(lds + SX_KT);
#pragma unroll
      for (int i = 0; i < 4; ++i) dst[tid + 512 * i] = src[tid + 512 * i]; }
    if (wid == 0) { const float a64r = GP[128 + lane], a64i = GP[192 + lane];
        for (int c = 0; c < 128; ++c) { *(LAS unsigned*)(Hb + c * SS_HROW + 2 * lane) = pk2(hr, hi_); const v2f sv = *(const LAS v2f*)(Sst + c * SS_SROW + 2 * lane);
            const float nr = a64r * hr - a64i * hi_ + sv.x, ni = a64r * hi_ + a64i * hr + sv.y; hr = nr; hi_ = ni; } }
    __syncthreads();
    { const bf16_t* vsrc = (const bf16_t*)(ws + OFF_VTS) + (size_t)g * 131072;
#pragma unroll
      for (int i = 0; i < 8; ++i) { const int it = tid + 512 * i, n = it >> 4, c = it & 15; *(LAS v4u*)(V16 + n * V16ROW + 8 * c) = *(const v4u*)(vsrc + (size_t)n * 128 + 8 * c); } }
    __syncthreads();
    const LAS bf16_t* KTl = (const LAS bf16_t*)(lds + SX_KT) + fr * 16 + 8 * (fq & 1);
    const v4f dv = *(const v4f*)(a.in[I_DSKIP] + 16 * g + 4 * fq);
#pragma unroll
    for (int q8 = 0; q8 < 8; ++q8) {
        pg8::f32x4 acc[8];
#pragma unroll
        for (int i = 0; i < 8; ++i) acc[i] = (pg8::f32x4){0.f, 0.f, 0.f, 0.f};
#pragma unroll
        for (int ks = 0; ks < 4 * q8 + 4; ++ks) {
#pragma unroll
            for (int i = 0; i < 8; ++i) { const int t = 8 * q8 + i, s0 = 2 * ks;
                if (t > s0) { const h8 B = *(const LAS h8*)(KTl + (t - s0 - (fq >> 1)) * 256); acc[i] = MFMA16(B, A[ks], acc[i]); }
                else if (t == s0) { h8 B = *(const LAS h8*)KTl; if (fq >> 1) B = (h8){0, 0, 0, 0, 0, 0, 0, 0}; acc[i] = MFMA16(B, A[ks], acc[i]); } } }
#pragma unroll
        for (int k2 = 0; k2 < 4; ++k2) { v4u hw = *(const LAS v4u*)(Hb + (16 * wid + fr) * SS_HROW + 32 * k2 + 8 * fq);
            if (q8 >= 2) { const LAS v2f* tb = TAB + 64 * (q8 >> 1) + 16 * k2 + 4 * fq; const v2f f0 = tb[0], f1 = tb[1], f2 = tb[2], f3 = tb[3];
                hw.x = pk2(f0.x * bflo(hw.x) - f0.y * bfhi(hw.x), f0.x * bfhi(hw.x) + f0.y * bflo(hw.x)); hw.y = pk2(f1.x * bflo(hw.y) - f1.y * bfhi(hw.y), f1.x * bfhi(hw.y) + f1.y * bflo(hw.y));
                hw.z = pk2(f2.x * bflo(hw.z) - f2.y * bfhi(hw.z), f2.x * bfhi(hw.z) + f2.y * bflo(hw.z)); hw.w = pk2(f3.x * bflo(hw.w) - f3.y * bfhi(hw.w), f3.x * bfhi(hw.w) + f3.y * bflo(hw.w)); }
            const h8 Ah = __builtin_bit_cast(h8, hw);
#pragma unroll
            for (int i = 0; i < 8; ++i) { const h8 B = *(const LAS h8*)(V16 + (16 * (8 * (q8 & 1) + i) + fr) * V16ROW + 32 * k2 + 8 * fq); acc[i] = MFMA16(B, Ah, acc[i]); } }
#pragma unroll
        for (int i = 0; i < 8; ++i) { const int tok = 64 * (16 * wid + fr) + 8 * q8 + i;
            const v2u uw = *(const v2u*)(UB + (size_t)(64 + tok) * 1024 + 4 * fq);
            const float y0 = acc[i][0] + dv.x * bflo(uw.x), y1 = acc[i][1] + dv.y * bfhi(uw.x), y2 = acc[i][2] + dv.z * bflo(uw.y), y3 = acc[i][3] + dv.w * bfhi(uw.y);
            *(v2u*)(YG + (size_t)(b * SEQ + tok) * 1024 + 16 * g + 4 * fq) = (v2u){pk2(gelu_tanh(y0), gelu_tanh(y1)), pk2(gelu_tanh(y2), gelu_tanh(y3))}; }
    }
    __syncthreads();
}

__device__ __forceinline__ void meta_attn(const Args& a, int tid) {
    const int h = tid >> 6, lane = tid & 63, qi = lane >> 2, part = lane & 3;
    unsigned char* ws = a.ws;
    const bf16_t* Qm = (const bf16_t*)(ws + OFF_Q) + (size_t)(MREAL + qi) * 1024 + h * 128 + 32 * part;
    const bf16_t* Km = (const bf16_t*)(ws + OFF_K) + (size_t)48 * 1024 + h * 128 + 32 * part;
    const bf16_t* Vm = (const bf16_t*)(ws + OFF_V) + (size_t)48 * 1024 + h * 128 + 32 * part;
    const float* BI = (const float*)(ws + OFF_BIAS) + (size_t)h * PPOS + 48;
    float q[32];
#pragma unroll
    for (int c = 0; c < 4; ++c) { float t8[8]; unpack8(*(const v4u*)(Qm + 8 * c), t8);
#pragma unroll
        for (int e = 0; e < 8; ++e) q[8 * c + e] = t8[e]; }
    float sc[16]; float mx = -1e30f;
#pragma unroll
    for (int kj = 0; kj < 16; ++kj) { float d = 0.f;
#pragma unroll
        for (int c = 0; c < 4; ++c) { float t8[8]; unpack8(*(const v4u*)(Km + (size_t)kj * 1024 + 8 * c), t8);
#pragma unroll
            for (int e = 0; e < 8; ++e) d += q[8 * c + e] * t8[e]; }
        d += __shfl_xor(d, 1); d += __shfl_xor(d, 2);
        sc[kj] = (kj <= qi) ? (d + BI[kj]) * att::SCALE : -__builtin_inff(); mx = fmaxf(mx, sc[kj]); }
    float l = 0.f;
#pragma unroll
    for (int kj = 0; kj < 16; ++kj) { sc[kj] = __expf(sc[kj] - mx); l += sc[kj]; }
    const float rl = 1.f / l;
    float o[32];
#pragma unroll
    for (int e = 0; e < 32; ++e) o[e] = 0.f;
#pragma unroll
    for (int kj = 0; kj < 16; ++kj) {
#pragma unroll
        for (int c = 0; c < 4; ++c) { float t8[8]; unpack8(*(const v4u*)(Vm + (size_t)kj * 1024 + 8 * c), t8);
#pragma unroll
            for (int e = 0; e < 8; ++e) o[8 * c + e] += sc[kj] * t8[e]; } }
    bf16_t* Om = (bf16_t*)(ws + OFF_OB) + (size_t)(MREAL + qi) * 1024 + h * 128 + 32 * part;
#pragma unroll
    for (int c = 0; c < 4; ++c) *(v4u*)(Om + 8 * c) = (v4u){pk2(o[8 * c] * rl, o[8 * c + 1] * rl), pk2(o[8 * c + 2] * rl, o[8 * c + 3] * rl), pk2(o[8 * c + 4] * rl, o[8 * c + 5] * rl), pk2(o[8 * c + 6] * rl, o[8 * c + 7] * rl)};
}

__device__ __forceinline__ att::BlockRef<att::bf16, att::bf16> att_ref(const Args& a, int bh, int qb) {
    att::BlockRef<att::bf16, att::bf16> r; const int b = bh >> 3, h = bh & 7;
    r.Q = (const att::bf16*)(a.ws + OFF_Q) + (size_t)(b * SEQ + qb * 256) * 1024 + h * 128;
    r.O = (att::bf16*)(a.ws + OFF_OB) + (size_t)(b * SEQ + qb * 256) * 1024 + h * 128;
    r.K = (const att::bf16*)(a.ws + OFF_K) + (size_t)b * PPOS * 1024 + h * 128;
    r.V = (const att::bf16*)(a.ws + OFF_V) + (size_t)b * PPOS * 1024 + h * 128;
    r.P0 = 64 + qb * 256;
    return r;
}
__device__ const signed char ATT_BINS[16][4] = {{4, 19, -1, -1}, {5, 21, -1, -1}, {11, 14, -1, -1}, {1, 25, -1, -1}, {10, 16, -1, -1}, {26, -1, -1, -1}, {7, 18, -1, -1}, {27, -1, -1, -1},
                                                {2, 3, 30, -1}, {17, 20, -1, -1}, {13, 24, -1, -1}, {15, 22, -1, -1}, {8, 29, -1, -1}, {6, 31, -1, -1}, {0, 12, 23, -1}, {9, 28, -1, -1}};
__device__ __forceinline__ void attn_phase(const Args& a, char* lds, int vcu, int G) {
    typedef att::BlockRef<att::bf16, att::bf16> Ref;
    constexpr int W = 1 << 20;
    const float* BIAS = (const float*)(a.ws + OFF_BIAS);
    att::Seam<att::bf16> S;
    if (G == 256) {
        const int bh = (vcu & 127) >> 3, bin = (vcu & 7) + (vcu >= 128 ? 8 : 0);
        int idx = 0;
        Ref cur = att_ref(a, bh, ATT_BINS[bin][0]);
        att::causal_swa_prime<att::bf16, att::bf16>(cur, W, lds, S);
        for (;;) {
            const int nq = idx < 3 ? (int)ATT_BINS[bin][idx + 1] : -1; const bool last = nq < 0;
            const Ref nxt = last ? cur : att_ref(a, bh, nq);
            att::causal_swa_block<att::bf16, att::bf16>(cur, nxt, PPOS, W, lds, S, BIAS + (size_t)bh * PPOS);
            if (last) break;
            cur = nxt; ++idx;
        }
        return;
    }
    constexpr int TOTAL = 256;
    int L = vcu; if (L >= TOTAL) return;
    int bh = L >> 4, x = L & 15, pass = 0;
    Ref cur = att_ref(a, bh, x);
    att::causal_swa_prime<att::bf16, att::bf16>(cur, W, lds, S);
    for (;;) {
        const bool more_pass = pass == 0, more_item = L + G < TOTAL, last = !more_pass && !more_item;
        int bhn = bh, xn = x, passn = pass + 1, Ln = L;
        if (!more_pass) { passn = 0; Ln = more_item ? L + G : L; bhn = Ln >> 4; xn = Ln & 15; }
        const Ref nxt = last ? cur : att_ref(a, bhn, passn ? 31 - xn : xn);
        att::causal_swa_block<att::bf16, att::bf16>(cur, nxt, PPOS, W, lds, S, BIAS + (size_t)bh * PPOS);
        if (last) break;
        cur = nxt; bh = bhn; x = xn; pass = passn; L = Ln;
    }
}

template <int NACC, int K>
__device__ __forceinline__ void thin_tile(const bf16_t* __restrict__ A, const bf16_t* __restrict__ Bt, const int (&n0)[NACC], pg8::f32x4 (&acc)[NACC], LAS unsigned char* lds, int wid, int lane) {
    constexpr int KS = K / 32 / 8; const int fr = lane & 15, fq = lane >> 4;
    const bf16_t* ap = A + (size_t)(MREAL + fr) * K + 8 * fq + 32 * KS * wid; h8 av[KS], bv[NACC][KS];
#pragma unroll
    for (int ks = 0; ks < KS; ++ks) { av[ks] = *(const h8*)(ap + 32 * ks);
#pragma unroll
        for (int j = 0; j < NACC; ++j) bv[j][ks] = *(const h8*)(Bt + (size_t)(n0[j] + fr) * K + 8 * fq + 32 * KS * wid + 32 * ks); }
#pragma unroll
    for (int j = 0; j < NACC; ++j) { acc[j] = (pg8::f32x4){0.f, 0.f, 0.f, 0.f};
#pragma unroll
        for (int ks = 0; ks < KS; ++ks) acc[j] = MFMA16(bv[j][ks], av[ks], acc[j]); }
    LAS pg8::f32x4* red = (LAS pg8::f32x4*)lds;
#pragma unroll
    for (int j = 0; j < NACC; ++j) red[(wid * NACC + j) * 64 + lane] = acc[j];
    __syncthreads();
    if (wid == 0) {
#pragma unroll
        for (int j = 0; j < NACC; ++j) { pg8::f32x4 t = red[j * 64 + lane];
#pragma unroll
            for (int w = 1; w < 8; ++w) t += red[(w * NACC + j) * 64 + lane];
            acc[j] = t; } }
    __syncthreads();
}
__device__ __forceinline__ void unpack4(const v2u w, float (&f)[4]) { f[0] = bflo(w.x); f[1] = bfhi(w.x); f[2] = bflo(w.y); f[3] = bfhi(w.y); }
__device__ __forceinline__ void thin_z(const Args& a, LAS unsigned char* lds, int bx, int G, int wid, int lane) {
    unsigned char* ws = a.ws; const int fr = lane & 15, fq = lane >> 4, row = MREAL + fr;
    for (int grp = bx; grp < 512; grp += G) { const int n0[1] = {16 * grp}; pg8::f32x4 acc[1];
        thin_tile<1, DM>((const bf16_t*)(ws + OFF_H0B), (const bf16_t*)(ws + OFF_WT_IN), n0, acc, lds, wid, lane);
        if (wid != 0) continue;
        const float rs = ((const float*)(ws + OFF_RSTD0))[row]; pg8::f32x4 v = acc[0] * rs;
        const int c = 16 * grp + 4 * fq, sec = c < 4096 ? (c >> 10) : (c < 6144 ? 4 : 5);
        if (sec >= 4) { v[0] = sigmoidf_(v[0]); v[1] = sigmoidf_(v[1]); v[2] = sigmoidf_(v[2]); v[3] = sigmoidf_(v[3]); }
        const v2u w = {pk2(v[0], v[1]), pk2(v[2], v[3])};
        if (sec == 0) *(v2u*)((bf16_t*)(ws + OFF_Q) + (size_t)row * 1024 + c) = w;
        else if (sec == 4) *(v2u*)((bf16_t*)(ws + OFF_SGA) + (size_t)row * 2048 + (c - 4096)) = w;
        else if (sec == 5) *(v2u*)((bf16_t*)(ws + OFF_SGB) + (size_t)row * 2048 + (c - 6144)) = w;
        else { bf16_t* base = (bf16_t*)(ws + (sec == 1 ? OFF_K : (sec == 2 ? OFF_V : OFF_UB))); const int cc = c & 1023;
            *(v2u*)(base + (size_t)(48 + fr) * 1024 + cc) = w; *(v2u*)(base + (size_t)(PPOS + 48 + fr) * 1024 + cc) = w; } }
}
__device__ __forceinline__ void thin_o(const Args& a, LAS unsigned char* lds, int bx, int G, int wid, int lane) {
    unsigned char* ws = a.ws; const int fr = lane & 15, fq = lane >> 4, row = MREAL + fr;
    for (int grp = bx; grp < 128; grp += G) { const int n0[1] = {16 * grp}; pg8::f32x4 acc[1];
        thin_tile<1, DATT>((const bf16_t*)(ws + OFF_OB), (const bf16_t*)(ws + OFF_WT_O), n0, acc, lds, wid, lane);
        if (wid != 0) continue;
        const size_t off = (size_t)row * 2048 + 16 * grp + 4 * fq; float sg[4]; unpack4(*(const v2u*)((const bf16_t*)(ws + OFF_SGB) + off), sg);
        *(v2u*)((bf16_t*)(ws + OFF_M1) + off) = (v2u){pk2(acc[0][0] * sg[0], acc[0][1] * sg[1]), pk2(acc[0][2] * sg[2], acc[0][3] * sg[3])}; }
}
__device__ __forceinline__ void thin_glu(const Args& a, LAS unsigned char* lds, int bx, int G, int wid, int lane) {
    unsigned char* ws = a.ws; const int fr = lane & 15, fq = lane >> 4, row = MREAL + fr;
    for (int grp = bx; grp < 128; grp += G) { const int oc = 16 * grp, t = oc >> 7, w = oc & 127; const int n0[2] = {256 * t + w, 256 * t + 128 + w}; pg8::f32x4 acc[2];
        thin_tile<2, DSSM>((const bf16_t*)(ws + OFF_YG), (const bf16_t*)(ws + OFF_WT_GLU), n0, acc, lds, wid, lane);
        if (wid != 0) continue;
        const size_t off = (size_t)row * 2048 + oc + 4 * fq; float ga[4], m1[4], o[4]; unpack4(*(const v2u*)((const bf16_t*)(ws + OFF_SGA) + off), ga); unpack4(*(const v2u*)((const bf16_t*)(ws + OFF_M1) + off), m1);
#pragma unroll
        for (int e = 0; e < 4; ++e) o[e] = m1[e] + ga[e] * acc[0][e] * sigmoidf_(acc[1][e]);
        *(v2u*)((bf16_t*)(ws + OFF_MERGED) + off) = (v2u){pk2(o[0], o[1]), pk2(o[2], o[3])}; }
}
__device__ __forceinline__ void thin_out(const Args& a, LAS unsigned char* lds, int bx, int G, int wid, int lane) {
    unsigned char* ws = a.ws; const int fr = lane & 15, fq = lane >> 4, row = MREAL + fr;
    for (int grp = bx; grp < 128; grp += G) { const int n0[1] = {16 * grp}; pg8::f32x4 acc[1];
        thin_tile<1, DM>((const bf16_t*)(ws + OFF_MERGED), (const bf16_t*)(ws + OFF_WT_OUT), n0, acc, lds, wid, lane);
        if (wid != 0) continue;
        const int c = 16 * grp + 4 * fq; const pg8::f32x4 v = acc[0] + *(const pg8::f32x4*)(a.in[I_META] + (size_t)fr * DM + c);
        *(v2u*)((bf16_t*)(ws + OFF_H1B) + (size_t)row * DM + c) = (v2u){pk2(v[0], v[1]), pk2(v[2], v[3])};
        float ss = (v[0] * v[0] + v[1] * v[1]) + (v[2] * v[2] + v[3] * v[3]); ss += __shfl_xor(ss, 16); ss += __shfl_xor(ss, 32);
        if (fq == 0) atomicAdd((float*)(ws + OFF_SUMSQ1) + row, ss); }
}
__device__ __forceinline__ void thin_up(const Args& a, LAS unsigned char* lds, int bx, int G, int wid, int lane) {
    unsigned char* ws = a.ws; const int fr = lane & 15, fq = lane >> 4, row = MREAL + fr;
    for (int grp = bx; grp < DFF / 16; grp += G) { const int oc = 16 * grp, t = oc >> 7, w = oc & 127; const int n0[2] = {256 * t + w, 256 * t + 128 + w}; pg8::f32x4 acc[2];
        thin_tile<2, DM>((const bf16_t*)(ws + OFF_H1B), (const bf16_t*)(ws + OFF_WT_UP), n0, acc, lds, wid, lane);
        if (wid != 0) continue;
        const float rs = 1.0f / sqrtf(((const float*)(ws + OFF_SUMSQ1))[row] * (1.f / DM) + EPS); const size_t off = (size_t)row * DFF + oc + 4 * fq;
        *(v2u*)((bf16_t*)(ws + OFF_G) + off) = (v2u){pk2(acc[0][0] * rs, acc[0][1] * rs), pk2(acc[0][2] * rs, acc[0][3] * rs)};
        *(v2u*)((bf16_t*)(ws + OFF_U) + off) = (v2u){pk2(acc[1][0] * rs, acc[1][1] * rs), pk2(acc[1][2] * rs, acc[1][3] * rs)}; }
}

__device__ __forceinline__ void conv_phase(const Args& a, int gt, int NT) {
    const bf16_t* G = (const bf16_t*)(a.ws + OFF_G); bf16_t* U = (bf16_t*)(a.ws + OFF_U);
    const float* cw = a.in[I_CONVW]; const float* cb = a.in[I_CONVB];
    constexpr int NCG = DFF / 8, NITEM = (MREAL / 64) * NCG;
    for (int it = gt; it < NITEM; it += NT) { const int j = it / NCG, cgp = it - j * NCG, r0 = 64 * j, c0 = 8 * cgp;
        float w0[8], w1[8], w2[8], bb[8];
#pragma unroll
        for (int h = 0; h < 2; ++h) { const v4f x0 = *(const v4f*)(cw + c0 + 4 * h), x1 = *(const v4f*)(cw + DFF + c0 + 4 * h), x2 = *(const v4f*)(cw + 2 * DFF + c0 + 4 * h), x3 = *(const v4f*)(cb + c0 + 4 * h);
#pragma unroll
            for (int e = 0; e < 4; ++e) { w0[4 * h + e] = x0[e]; w1[4 * h + e] = x1[e]; w2[4 * h + e] = x2[e]; bb[4 * h + e] = x3[e]; } }
        const bool first = (r0 & 8191) == 0;
        float p2[8], p1[8], g0[8], g1[8], u0[8], u1[8], o0[8], o1[8];
        unpack8(*(const v4u*)(G + (size_t)(first ? MREAL + 14 : r0 - 2) * DFF + c0), p2);
        unpack8(*(const v4u*)(G + (size_t)(first ? MREAL + 15 : r0 - 1) * DFF + c0), p1);
        unpack8(*(const v4u*)(G + (size_t)r0 * DFF + c0), g0); unpack8(*(const v4u*)(G + (size_t)(r0 + 1) * DFF + c0), g1);
        unpack8(*(const v4u*)(U + (size_t)r0 * DFF + c0), u0); unpack8(*(const v4u*)(U + (size_t)(r0 + 1) * DFF + c0), u1);
#pragma unroll
        for (int e = 0; e < 8; ++e) { const float ga = bb[e] + w0[e] * p2[e] + w1[e] * p1[e] + w2[e] * g0[e], gb = bb[e] + w0[e] * p1[e] + w1[e] * g0[e] + w2[e] * g1[e];
            o0[e] = ga * sigmoidf_(ga) * u0[e]; o1[e] = gb * sigmoidf_(gb) * u1[e]; }
        *(v4u*)(U + (size_t)r0 * DFF + c0) = (v4u){pk2(o0[0], o0[1]), pk2(o0[2], o0[3]), pk2(o0[4], o0[5]), pk2(o0[6], o0[7])};
        *(v4u*)(U + (size_t)(r0 + 1) * DFF + c0) = (v4u){pk2(o1[0], o1[1]), pk2(o1[2], o1[3]), pk2(o1[4], o1[5]), pk2(o1[6], o1[7])};
    }
}

#define RLX_AGENT __ATOMIC_RELAXED, __HIP_MEMORY_SCOPE_AGENT
#define XB_TMO      128
#define XB_XCNT(j)  (256  + 64 * (j))
#define XB_XSUB(j)  (1280 + 64 * (j))
#define XB_XGEN(j)  (2304 + 64 * (j))
#define XB_TOP      3328
#define XB_TOPGEN   3392
#define XCD_BAR_WORDS 3456
#define XB_SPIN_CAP (1u << 18)

__device__ __forceinline__ unsigned xb_ld(unsigned* p)              { return __hip_atomic_load(p, __ATOMIC_RELAXED, __HIP_MEMORY_SCOPE_AGENT); }
__device__ __forceinline__ unsigned xb_add(unsigned* p, unsigned v) { return __hip_atomic_fetch_add(p, v, __ATOMIC_RELAXED, __HIP_MEMORY_SCOPE_AGENT); }
__device__ __forceinline__ unsigned xb_xcc_id() { return (unsigned)__builtin_amdgcn_s_getreg((3 << 11) | 20) & 0xFu; }
#define XB_SPIN(cond, bar) do { unsigned _sp = 0; while (cond) { __builtin_amdgcn_s_sleep(1); \
    if ((++_sp & 255u) == 0u) { if (xb_ld(&(bar)[XB_TMO])) break; if (_sp > XB_SPIN_CAP) { atomicAdd(&(bar)[XB_TMO], 1u); break; } } } } while (0)

struct XcdBarrier {
    unsigned* bar; unsigned x;
    volatile LAS unsigned* st;
};

__device__ __forceinline__ XcdBarrier xcd_barrier_post(unsigned* bar, volatile LAS unsigned* st) {
    XcdBarrier b; b.bar = bar; b.x = xb_xcc_id(); b.st = st;
    if (threadIdx.x == 0) (void)xb_add(&bar[XB_XCNT(b.x)], 1u);
    return b;
}
__device__ __forceinline__ void xcd_barrier_complete(unsigned* bar, unsigned x, unsigned& nloc, unsigned& nx) {
    const unsigned G = gridDim.x * gridDim.y * gridDim.z;
    unsigned sum, cnt, mine, sp = 0u;
    for (;;) {
        sum = 0u; cnt = 0u; mine = 0u;
#pragma unroll
        for (unsigned j = 0; j < 16; ++j) { const unsigned c = xb_ld(&bar[XB_XCNT(j)]); sum += c; cnt += (c > 0u) ? 1u : 0u; mine = (j == x) ? c : mine; }
        if (sum == G) break;
        __builtin_amdgcn_s_sleep(1);
        if ((++sp & 255u) == 0u) { if (xb_ld(&bar[XB_TMO])) break; if (sp > XB_SPIN_CAP) { atomicAdd(&bar[XB_TMO], 1u); break; } }
    }
    nloc = mine > 0u ? mine : 1u; nx = cnt > 0u ? cnt : 1u;
}

__device__ __forceinline__ void xcd_barrier(const XcdBarrier& b) {
    asm volatile("s_waitcnt vmcnt(0)" ::: "memory");
    __syncthreads();
    if (threadIdx.x == 0) {
        unsigned* bar = b.bar;
        __builtin_amdgcn_s_waitcnt(0);
        unsigned nloc = b.st[0], nx = b.st[1];
        if (nloc == 0u) { xcd_barrier_complete(bar, b.x, nloc, nx); b.st[0] = nloc; b.st[1] = nx; }
        const unsigned old = xb_add(&bar[XB_XSUB(b.x)], 1u);
        const unsigned gen = old / nloc;
        if (old + 1u == (gen + 1u) * nloc) {
            __builtin_amdgcn_fence(__ATOMIC_RELEASE, "agent");
            asm volatile("s_waitcnt vmcnt(0)" ::: "memory");
            const unsigned og = xb_add(&bar[XB_TOP], 1u);
            const unsigned tg = og / nx;
            if (og + 1u == (tg + 1u) * nx) xb_add(&bar[XB_TOPGEN], 1u);
            else XB_SPIN(xb_ld(&bar[XB_TOPGEN]) == tg, bar);
            __builtin_amdgcn_fence(__ATOMIC_ACQUIRE, "agent");
            xb_add(&bar[XB_XGEN(b.x)], 1u);
            asm volatile("s_waitcnt vmcnt(0)" ::: "memory");
        } else {
            XB_SPIN(xb_ld(&bar[XB_XGEN(b.x)]) == gen, bar);
            __builtin_amdgcn_fence(__ATOMIC_ACQUIRE, "agent");
            asm volatile("s_waitcnt vmcnt(0)" ::: "memory");
        }
    }
    __syncthreads();
}

__global__ void __launch_bounds__(512, 2) mk_fwd(Args a0) {
    extern __shared__ __attribute__((aligned(16))) unsigned char lds_raw[];
    LAS unsigned char* lds = (LAS unsigned char*)lds_raw;
    const int tid = threadIdx.x, lane = tid & 63, wid = __builtin_amdgcn_readfirstlane(tid >> 6);
    const int G = gridDim.x, bx = blockIdx.x;
    volatile LAS unsigned* xb_st = (volatile LAS unsigned*)(lds + (LDS_BYTES - 64));
    if (tid < 2) xb_st[tid] = 0u;
    __syncthreads();
    XcdBarrier xbar; { LOAD_ARGS(ab); (void)ab; xbar = xcd_barrier_post((unsigned*)(ws + OFF_BAR), xb_st); }
#define VCU() ((G % 8 == 0) ? (bx % 8) * (G / 8) + bx / 8 : bx)
    const int gw = bx * 8 + wid, NGW = G * 8;
#ifndef PH_MASK
#define PH_MASK 0x3ff
#endif
#define IN(k) (((PH_MASK >> (k)) & 1) && ph_in(k))
#ifndef PROBE_PH
#define PROBE_PH -1
#endif
#ifndef PROBE_MUL
#define PROBE_MUL 8
#endif
    unsigned long long pr_t0 = 0, pr_dt = 0;
#define SEAM(k) do { if (IN(k) && IN((k) + 1)) { if (ph_in(-7)) cg::this_grid().sync();   xcd_barrier(xbar); } if (PROBE_PH == (k)) pr_dt = __builtin_amdgcn_s_memrealtime() - pr_t0; if (PROBE_PH == (k) + 1) pr_t0 = __builtin_amdgcn_s_memrealtime(); } while (0)
    if (PROBE_PH == 0) pr_t0 = __builtin_amdgcn_s_memrealtime();

    if (IN(0)) { LOAD_ARGS(a);
        { LAS float* wf = (LAS float*)(lds + WF_OFF); const float* win = a.in[I_WIN]; const float* gm = a.in[I_GMIX];
#pragma unroll
          for (int k = tid; k < DM; k += 512) { const float g = gm[k]; const v4f w0 = *(const v4f*)(win + (size_t)k * NIN + 3072), w1 = *(const v4f*)(win + (size_t)k * NIN + 3076);
              wf[0 * 2048 + k] = w0.x * g; wf[1 * 2048 + k] = w0.y * g; wf[2 * 2048 + k] = w0.z * g; wf[3 * 2048 + k] = w0.w * g;
              wf[4 * 2048 + k] = w1.x * g; wf[5 * 2048 + k] = w1.y * g; wf[6 * 2048 + k] = w1.z * g; wf[7 * 2048 + k] = w1.w * g; } }
        { const int gt = bx * 512 + tid, NT = G * 512;
          float* s1 = (float*)(ws + OFF_SUMSQ1); float* s2 = (float*)(ws + OFF_SUMSQ2);
          for (int i = gt; i < RPAD; i += NT) { s1[i] = 0.f; s2[i] = 0.f; }
          constexpr int NZ = 48 * 1024 * 2 / 16;
          for (int i = gt; i < 6 * NZ; i += NT) { const int w = i / NZ, j = i - w * NZ; const size_t base = (w >> 1) == 0 ? OFF_K : ((w >> 1) == 1 ? OFF_V : OFF_UB);
              *(v4u*)(ws + base + (size_t)(w & 1) * PPOS * 1024 * 2 + (size_t)j * 16) = (v4u){0u, 0u, 0u, 0u}; } }
        __syncthreads();
#define SUBSTAMP(id) do { if (PROBE_PH == 100 + (id)) pr_t0 = __builtin_amdgcn_s_memrealtime(); if (PROBE_PH == 99 + (id)) pr_dt = __builtin_amdgcn_s_memrealtime() - pr_t0; } while (0)
        SUBSTAMP(0);
        p0_rows(a, lds, gw, NGW, lane);
        __syncthreads();
        SUBSTAMP(1);
        { LOAD_ARGS(a2); (void)ws; p0_transposes(a2, lds, gw, NGW, wid, lane); }
        __syncthreads();
        SUBSTAMP(2);
        for (int jb = bx; jb < 4 * NG; jb += G) ssm_gen(lds, jb >> 2, jb & 3, tid);
        SUBSTAMP(3);
    }
    SEAM(0);
    if (IN(1)) { LOAD_ARGS(a);
        if (bx >= G - 16) cumsum_seq(a, lds, bx - (G - 16), tid);
        thin_z(a, lds, bx, G, wid, lane);
        pg8::Gemm g{(const bf16_t*)(ws + OFF_H0B), (const bf16_t*)(ws + OFF_WT_IN), MREAL, 8192, DM}; pg8::StaticOrder S; S.init(MREAL, 8192, G, bx);
        EpiZ E{(const float*)(ws + OFF_RSTD0), (bf16_t*)(ws + OFF_Q), (bf16_t*)(ws + OFF_K), (bf16_t*)(ws + OFF_V), (bf16_t*)(ws + OFF_UB), (bf16_t*)(ws + OFF_SGA), (bf16_t*)(ws + OFF_SGB)};
        pg8::gemm_phase<EpiZ, pg8::StaticOrder, true, true>(lds, g, S, E);
    }
    SEAM(1);
    if (IN(2)) { LOAD_ARGS(a);
#ifndef P2_PARTS
#define P2_PARTS 7
#endif
        const int vcu = VCU();
        SUBSTAMP(10);
        if ((P2_PARTS & 1) && vcu < 128) ssm_unit(a, lds, vcu >> 6, vcu & 63, tid);
        if ((P2_PARTS & 2) && vcu == 0) meta_attn(a, tid);
        __syncthreads();
        SUBSTAMP(11);
        if (P2_PARTS & 4) attn_phase(a, (char*)lds_raw, vcu, G);
        SUBSTAMP(12);
    }
    SEAM(2);
    if (IN(3)) { LOAD_ARGS(a);
        thin_o(a, lds, bx, G, wid, lane);
        thin_glu(a, lds, bx, G, wid, lane);
        pg8::Gemm g{(const bf16_t*)(ws + OFF_OB), (const bf16_t*)(ws + OFF_WT_O), MREAL, DM, DATT}; ChainOrder S; S.init(MREAL, G, bx);
        S.A0 = (const char*)(ws + OFF_OB); S.B0 = (const char*)(ws + OFF_WT_O); S.A1 = (const char*)(ws + OFF_YG); S.B1 = (const char*)(ws + OFF_WT_GLU);
        EpiOG E{EpiO{(const bf16_t*)(ws + OFF_SGB), (bf16_t*)(ws + OFF_M1)}, EpiGlu{(const bf16_t*)(ws + OFF_SGA), (const bf16_t*)(ws + OFF_M1), (bf16_t*)(ws + OFF_MERGED)}};
        pg8::gemm_phase<EpiOG, ChainOrder, true, true>(lds, g, S, E);
    }
    SEAM(4);
    if (IN(5)) { LOAD_ARGS(a);
        thin_out(a, lds, bx, G, wid, lane);
        pg8::Gemm g{(const bf16_t*)(ws + OFF_MERGED), (const bf16_t*)(ws + OFF_WT_OUT), MREAL, DM, DM}; pg8::StaticOrder S; S.init(MREAL, DM, G, bx);
        EpiOut E{a.in[I_X], a.out, (bf16_t*)(ws + OFF_H1B), (float*)(ws + OFF_SUMSQ1)};
        pg8::gemm_phase<EpiOut, pg8::StaticOrder, true, true>(lds, g, S, E);
    }
    SEAM(5);
    if (IN(6)) { LOAD_ARGS(a);
        thin_up(a, lds, bx, G, wid, lane);
        pg8::Gemm g{(const bf16_t*)(ws + OFF_H1B), (const bf16_t*)(ws + OFF_WT_UP), MREAL, 2 * DFF, DM}; pg8::StaticOrder S; S.init(MREAL, 2 * DFF, G, bx);
        EpiUp E{(const float*)(ws + OFF_SUMSQ1), (bf16_t*)(ws + OFF_G), (bf16_t*)(ws + OFF_U), a.in[I_CONVW], a.in[I_CONVB]};
        pg8::gemm_phase<EpiUp, pg8::StaticOrder, true, true>(lds, g, S, E);
    }
    SEAM(6);
    if (IN(7)) { LOAD_ARGS(a); (void)ws; conv_phase(a, bx * 512 + tid, G * 512); }
    SEAM(7);
    if (IN(8)) { LOAD_ARGS(a);
        pg8::Gemm g{(const bf16_t*)(ws + OFF_U), (const bf16_t*)(ws + OFF_WT_DOWN), MREAL, DM, DFF}; pg8::StaticOrder S; S.init(MREAL, DM, G, bx);
        EpiDown E{a.out, (const bf16_t*)(ws + OFF_H1B), (float*)(ws + OFF_SUMSQ2)};
        pg8::gemm_phase<EpiDown, pg8::StaticOrder, true, true>(lds, g, S, E);
    }
    SEAM(8);
    if (IN(9)) { LOAD_ARGS(a);
        const float* ss = (const float*)(ws + OFF_SUMSQ2); const float* gf = a.in[I_GFINAL];
        v4f gv[8];
#pragma unroll
        for (int j = 0; j < 8; ++j) gv[j] = *((const v4f*)gf + lane + 64 * j);
        for (int r = gw; r < MREAL; r += 2 * NGW) {
            const int r1 = r + NGW; const bool two = r1 < MREAL; const int r1c = two ? r1 : r;
            const float rs0 = 1.0f / sqrtf(ss[r] * (1.f / DM) + EPS), rs1 = 1.0f / sqrtf(ss[r1c] * (1.f / DM) + EPS);
            v4f* p0 = (v4f*)(a.out + (size_t)r * DM) + lane; v4f* p1 = (v4f*)(a.out + (size_t)r1c * DM) + lane; v4f x0[8], x1[8];
#pragma unroll
            for (int j = 0; j < 8; ++j) { x0[j] = p0[64 * j]; x1[j] = p1[64 * j]; }
#pragma unroll
            for (int j = 0; j < 8; ++j) p0[64 * j] = x0[j] * rs0 * gv[j];
            if (two) {
#pragma unroll
                for (int j = 0; j < 8; ++j) p1[64 * j] = x1[j] * rs1 * gv[j]; } }
    }
    if (PROBE_PH >= 0 && bx == 0) { const unsigned long long t1 = __builtin_amdgcn_s_memrealtime(); while (__builtin_amdgcn_s_memrealtime() - t1 < (unsigned long long)PROBE_MUL * pr_dt) __builtin_amdgcn_s_sleep(8); }
#undef IN
#undef SEAM
}

extern "C" void kernel_launch(void* const* d_in, const int* in_sizes, int n_in, void* d_out, int out_size, void* d_ws, size_t ws_size, hipStream_t stream) {
    static int grid = 0;
    if (grid == 0) {
        if (n_in != 22 || out_size != MREAL * DM || ws_size < WS_NEED) { fprintf(stderr, "kernel_launch: unexpected shapes (n_in %d out %d ws %zu need %zu)\n", n_in, out_size, ws_size, (size_t)WS_NEED); grid = -1; return; }
        int dev = 0, cus = 0, per_cu = 0;
        (void)hipGetDevice(&dev); (void)hipDeviceGetAttribute(&cus, hipDeviceAttributeMultiprocessorCount, dev);
        if (hipFuncSetAttribute((const void*)mk_fwd, hipFuncAttributeMaxDynamicSharedMemorySize, LDS_BYTES) != hipSuccess) { fprintf(stderr, "kernel_launch: hipFuncSetAttribute failed\n"); grid = -1; return; }
        if (hipOccupancyMaxActiveBlocksPerMultiprocessor(&per_cu, (const void*)mk_fwd, 512, LDS_BYTES) != hipSuccess || per_cu < 1) { fprintf(stderr, "kernel_launch: occupancy query says %d\n", per_cu); per_cu = 1; }
        (void)hipGetLastError();
        grid = cus > 0 ? cus : 256;
    }
    if (grid < 0) return;
    (void)hipMemsetAsync((unsigned char*)d_ws + OFF_BAR, 0, 16384, stream);
    Args a{};
    for (int i = 0; i < 22; ++i) a.in[i] = (const float*)d_in[i];
    a.out = (float*)d_out; a.ws = (unsigned char*)d_ws;
#if MK_SPLIT
    for (int p = 0; p < 10; ++p) { a.ph_lo = p; a.ph_hi = p + 1; hipLaunchKernelGGL(mk_fwd, dim3(grid), dim3(512), LDS_BYTES, stream, a); }
#else
    a.ph_lo = 0; a.ph_hi = 10;
    void* args[] = {&a};
    const hipError_t e = hipLaunchCooperativeKernel((const void*)mk_fwd, dim3(grid), dim3(512), args, LDS_BYTES, stream);
    if (e != hipSuccess) fprintf(stderr, "kernel_launch: cooperative launch failed: %s (grid %d)\n", hipGetErrorString(e), grid);
#endif
}
```

```cpp
#include <hip/hip_runtime.h>
#include <hip/hip_bf16.h>
#include <hip/hip_cooperative_groups.h>
#include <cstdio>
#include <cstdint>
namespace cg = cooperative_groups;
namespace pg8 {
#define PG8_LAS __attribute__((address_space(3)))
typedef unsigned short bf16_t;
typedef short bf16x8 __attribute__((ext_vector_type(8)));
typedef float f32x4 __attribute__((ext_vector_type(4)));
typedef unsigned u32x4 __attribute__((ext_vector_type(4)));
constexpr int BM = 256, BK = 64, HALF = 128, HTB = HALF * BK * 2  , STAGE_BYTES = 8 * HTB, NXCD = 8, WGM = 8;

__host__ __device__ __forceinline__ int lds_byte(int r, int c) { const int st = (r >> 4) * 2 + (c >> 5), rr = r & 15, cc = c & 31, ob = rr * 64 + cc * 2; return st * 1024 + (ob ^ (((ob >> 9) & 1) << 5)); }
__host__ __device__ __forceinline__ void stage_rc(int b, int& R, int& C) { const int st = b / 1024, sb = b % 1024, swz = sb ^ (((sb >> 9) & 1) << 5); R = (st >> 1) * 16 + swz / 64; C = (st & 1) * 32 + (swz % 64) / 2; }
__host__ __device__ __forceinline__ int perm32(int rho) { const int n = rho >> 4, i = rho & 15; return 8 * (i >> 2) + 4 * n + (i & 3); }

struct Unit { int pm, pn, kind; };
struct Gemm { const bf16_t* A; const bf16_t* Bt; int M, N, K; };

struct StaticOrder {
    int nM, nN, nwg, G, c;
    __host__ __device__ void init(int M, int N, int G_, int c_) { nM = M / BM; nN = N / BM; nwg = nM * nN; G = G_; c = c_; }
    __host__ __device__ bool next(int i, Unit& u) const {
        const long L = (long)i * G + c; if (L >= nwg) return false;
        int wgid = (int)L; { const int q = nwg / NXCD, r = nwg % NXCD, xcd = wgid % NXCD, off = wgid / NXCD; wgid = (xcd < r ? xcd * (q + 1) : r * (q + 1) + (xcd - r) * q) + off; }
        const int nig = WGM * nN, gid = wgid / nig, fm = gid * WGM, gsz = (nM - fm) < WGM ? (nM - fm) : WGM;
        u.pm = fm + ((wgid % nig) % gsz); u.pn = (wgid % nig) / gsz; return true;
    }
    template <class G_> __device__ __forceinline__ const char* abase(const G_& g, const Unit&) const { return (const char*)g.A; }
    template <class G_> __device__ __forceinline__ const char* bbase(const G_& g, const Unit&) const { return (const char*)g.Bt; }
    __device__ __forceinline__ void a_ready(const Unit&) const {}
    __device__ __forceinline__ void done(const Unit&) const {}
};

__device__ __forceinline__ unsigned cvt_pk_bf16(float lo, float hi) { unsigned r; asm volatile("v_cvt_pk_bf16_f32 %0, %1, %2" : "=v"(r) : "v"(lo), "v"(hi)); return r; }
typedef float f32x2 __attribute__((ext_vector_type(2)));
template <class Epi, class Sched, bool ALIGN_EPI = false, bool SP2 = false>
__device__ __forceinline__ void gemm_phase(PG8_LAS unsigned char* lds, const Gemm g, const Sched& S, const Epi& E) {
    const int tid = threadIdx.x, wid = __builtin_amdgcn_readfirstlane(tid >> 6), lane = tid & 63, wr = wid >> 2, wc = wid & 3, fr = lane & 15, fq = lane >> 4;
    const int K = g.K, nt = K / BK;
    unsigned voffA[2], voffB[2];
#pragma unroll
    for (int i = 0; i < 2; ++i) { int R, C; stage_rc(tid * 16 + i * 8192, R, C); const int Rb = Epi::PERM ? ((R & ~31) + perm32(R & 31)) : R;
        voffA[i] = (unsigned)(R * K + C) * 2u; voffB[i] = (unsigned)(Rb * K + C) * 2u; }
    const size_t kstep = (size_t)(BK * 2);
    const size_t hstep = (size_t)HALF * K * 2;
    const size_t tstep = 2 * hstep;
    const unsigned ldsw = (unsigned)wid * 1024u;
    const int aoff = lds_byte(wr * 64 + fr, fq * 8), boff = lds_byte(wc * 32 + fr, fq * 8);
#define PG8_SA(b, h) (((b) * 2 + (h)) * HTB)
#define PG8_SB(b, h) ((4 + (b) * 2 + (h)) * HTB)
#define PG8_STAGE(bufoff, gbase, voff) do { _Pragma("unroll") for (int _i = 0; _i < 2; ++_i) \
        __builtin_amdgcn_global_load_lds((const unsigned*)((const char*)(gbase) + (voff)[_i]), (PG8_LAS unsigned*)(lds + (bufoff) + ldsw + _i * 8192), 16, 0, 0); } while (0)
#define PG8_LDA(dst, b, h) do { _Pragma("unroll") for (int m = 0; m < 4; ++m) _Pragma("unroll") for (int k = 0; k < 2; ++k) dst[m][k] = *(const PG8_LAS bf16x8*)(lds + PG8_SA(b, h) + aoff + m * 2048 + k * 1024); } while (0)
#define PG8_LDB(dst, b, h) do { _Pragma("unroll") for (int n = 0; n < 2; ++n) _Pragma("unroll") for (int k = 0; k < 2; ++k) dst[n][k] = *(const PG8_LAS bf16x8*)(lds + PG8_SB(b, h) + boff + n * 2048 + k * 1024); } while (0)
#define PG8_MMA(ai, bj, At, Bt) do { __builtin_amdgcn_s_setprio(1); _Pragma("unroll") for (int m = 0; m < 4; ++m) _Pragma("unroll") for (int n = 0; n < 2; ++n) _Pragma("unroll") for (int k = 0; k < 2; ++k) \
        acc[ai][bj][m][n] = __builtin_amdgcn_mfma_f32_16x16x32_bf16(Bt[n][k], At[m][k], acc[ai][bj][m][n], 0, 0, 0); __builtin_amdgcn_s_setprio(0); } while (0)
#define PG8_WAIT_V(n) asm volatile("s_waitcnt vmcnt(" #n ")" ::: "memory")
#define PG8_WAIT_L(n) asm volatile("s_waitcnt lgkmcnt(" #n ")" ::: "memory")
#define PG8_BAR __builtin_amdgcn_s_barrier()
#define PG8_SCHED __builtin_amdgcn_sched_barrier(0)
    Unit cur, nxt; int ui = 0;
    if (!S.next(0, cur)) return;
    f32x4 acc[2][2][4][2];
#pragma unroll
    for (int a = 0; a < 2; ++a)
#pragma unroll
        for (int b = 0; b < 2; ++b)
#pragma unroll
            for (int m = 0; m < 4; ++m)
#pragma unroll
                for (int n = 0; n < 2; ++n) acc[a][b][m][n] = (f32x4){0.f, 0.f, 0.f, 0.f};
    bf16x8 At[4][2], B0[2][2], B1[2][2];
    const char* cA = S.abase(g, cur) + (size_t)cur.pm * tstep; const char* cB = S.bbase(g, cur) + (size_t)cur.pn * tstep;
    S.a_ready(cur);
    if constexpr (SP2) {
        PG8_STAGE(PG8_SB(0, 0), cB, voffB); PG8_STAGE(PG8_SB(0, 1), cB + hstep, voffB); PG8_STAGE(PG8_SA(0, 0), cA, voffA); PG8_STAGE(PG8_SA(0, 1), cA + hstep, voffA);
        if (wr == 1) PG8_BAR;
        PG8_WAIT_V(2); PG8_BAR;
        PG8_STAGE(PG8_SB(1, 0), cB + kstep, voffB); PG8_STAGE(PG8_SA(1, 0), cA + kstep, voffA); PG8_STAGE(PG8_SB(1, 1), cB + hstep + kstep, voffB);
        PG8_WAIT_V(6); PG8_BAR;
    } else {
        PG8_STAGE(PG8_SB(0, 0), cB, voffB); PG8_STAGE(PG8_SA(0, 0), cA, voffA); PG8_STAGE(PG8_SB(0, 1), cB + hstep, voffB); PG8_STAGE(PG8_SA(0, 1), cA + hstep, voffA);
        if (wr == 1) PG8_BAR;
        PG8_WAIT_V(4); PG8_BAR;
        PG8_STAGE(PG8_SB(1, 0), cB + kstep, voffB); PG8_STAGE(PG8_SA(1, 0), cA + kstep, voffA); PG8_STAGE(PG8_SB(1, 1), cB + hstep + kstep, voffB);
        PG8_WAIT_V(6); PG8_BAR;
    }
    for (;;) {
        const bool has_next = S.next(ui + 1, nxt);
        const char* nA = has_next ? S.abase(g, nxt) + (size_t)nxt.pm * tstep : cA; const char* nB = has_next ? S.bbase(g, nxt) + (size_t)nxt.pn * tstep : cB;
        for (int t = 0; t < nt; t += 2) {
            const bool last = (t == nt - 2);
            const char* a1 = cA + (size_t)(t + 1) * kstep;
            const char* a2 = last ? nA : cA + (size_t)(t + 2) * kstep; const char* b2 = last ? nB : cB + (size_t)(t + 2) * kstep;
            const char* a3 = a2 + kstep; const char* b3 = b2 + kstep;
            if (last && has_next) S.a_ready(nxt);
            if constexpr (SP2) {
            PG8_LDB(B0, 0, 0); PG8_LDB(B1, 0, 1); PG8_SCHED; PG8_LDA(At, 0, 0); PG8_STAGE(PG8_SA(1, 1), a1 + hstep, voffA);
            PG8_WAIT_V(8); PG8_WAIT_L(0); PG8_BAR; PG8_MMA(0, 0, At, B0); PG8_MMA(0, 1, At, B1); PG8_BAR; PG8_SCHED;
            PG8_LDA(At, 0, 1); PG8_STAGE(PG8_SB(0, 0), b2, voffB); PG8_STAGE(PG8_SB(0, 1), b2 + hstep, voffB); PG8_STAGE(PG8_SA(0, 0), a2, voffA);
            PG8_WAIT_V(8); PG8_WAIT_L(0); PG8_BAR; PG8_MMA(1, 0, At, B0); PG8_MMA(1, 1, At, B1); PG8_BAR; PG8_SCHED;
            PG8_LDB(B0, 1, 0); PG8_LDB(B1, 1, 1); PG8_SCHED; PG8_LDA(At, 1, 0); PG8_STAGE(PG8_SA(0, 1), a2 + hstep, voffA);
            PG8_WAIT_V(8); PG8_WAIT_L(0); PG8_BAR; PG8_MMA(0, 0, At, B0); PG8_MMA(0, 1, At, B1); PG8_BAR; PG8_SCHED;
            PG8_LDA(At, 1, 1); PG8_STAGE(PG8_SB(1, 0), b3, voffB); PG8_STAGE(PG8_SB(1, 1), b3 + hstep, voffB); PG8_STAGE(PG8_SA(1, 0), a3, voffA);
            PG8_WAIT_V(8); PG8_WAIT_L(0); PG8_BAR; PG8_MMA(1, 0, At, B0); PG8_MMA(1, 1, At, B1); PG8_BAR; PG8_SCHED;
            } else {
            PG8_LDB(B0, 0, 0); PG8_SCHED; PG8_LDA(At, 0, 0); PG8_STAGE(PG8_SA(1, 1), a1 + hstep, voffA);
            PG8_WAIT_L(8); PG8_BAR; PG8_WAIT_L(0); PG8_MMA(0, 0, At, B0); PG8_BAR; PG8_SCHED;
            PG8_LDB(B1, 0, 1); PG8_STAGE(PG8_SB(0, 0), b2, voffB);
            PG8_BAR; PG8_WAIT_L(0); PG8_MMA(0, 1, At, B1); PG8_BAR;
            PG8_LDA(At, 0, 1); PG8_STAGE(PG8_SA(0, 0), a2, voffA);
            PG8_BAR; PG8_WAIT_L(0); PG8_MMA(1, 0, At, B0); PG8_BAR; PG8_SCHED;
            PG8_STAGE(PG8_SB(0, 1), b2 + hstep, voffB);
            PG8_WAIT_V(6); PG8_BAR; PG8_MMA(1, 1, At, B1); PG8_BAR;
            PG8_LDB(B0, 1, 0); PG8_SCHED; PG8_LDA(At, 1, 0); PG8_STAGE(PG8_SA(0, 1), a2 + hstep, voffA);
            PG8_WAIT_L(8); PG8_BAR; PG8_WAIT_L(0); PG8_MMA(0, 0, At, B0); PG8_BAR; PG8_SCHED;
            PG8_LDB(B1, 1, 1); PG8_STAGE(PG8_SB(1, 0), b3, voffB);
            PG8_BAR; PG8_WAIT_L(0); PG8_MMA(0, 1, At, B1); PG8_BAR;
            PG8_LDA(At, 1, 1); PG8_STAGE(PG8_SA(1, 0), a3, voffA);
            PG8_BAR; PG8_WAIT_L(0); PG8_MMA(1, 0, At, B0); PG8_BAR; PG8_SCHED;
            PG8_STAGE(PG8_SB(1, 1), b3 + hstep, voffB);
            PG8_WAIT_V(6); PG8_BAR; PG8_MMA(1, 1, At, B1); PG8_BAR;
            }
        }
        if constexpr (ALIGN_EPI) { if (wr == 0) PG8_BAR; }
        if constexpr (!Epi::AFTER_DRAIN) { E(acc, cur, wr, wc, fr, fq); S.done(cur); }
        if (!has_next) break;
#pragma unroll
        for (int a = 0; a < 2; ++a)
#pragma unroll
            for (int b = 0; b < 2; ++b)
#pragma unroll
                for (int m = 0; m < 4; ++m)
#pragma unroll
                    for (int n = 0; n < 2; ++n) acc[a][b][m][n] = (f32x4){0.f, 0.f, 0.f, 0.f};
        cur = nxt; cA = nA; cB = nB; ++ui;
        if constexpr (ALIGN_EPI) { if (wr == 1) PG8_BAR; }
    }
    PG8_WAIT_V(0);
    if constexpr (!ALIGN_EPI) { if (wr == 0) PG8_BAR; }
    PG8_BAR;
    if constexpr (Epi::AFTER_DRAIN) { E.fused(acc, cur, wr, wc, fr, fq, lds, wid, lane); S.done(cur); }
#undef PG8_SA
#undef PG8_SB
#undef PG8_STAGE
#undef PG8_LDA
#undef PG8_LDB
#undef PG8_MMA
#undef PG8_WAIT_V
#undef PG8_WAIT_L
#undef PG8_BAR
#undef PG8_SCHED
}
}
namespace att {
constexpr int D = 128, RS = 1024;
constexpr float THR = 8.f; constexpr bool WSKIP = false;
constexpr float SCALE = 0.08838834764831845f;
constexpr int NW = 8, QBLK = 32, KVBLK = 64, QB = NW * QBLK;
constexpr int SHM_V = KVBLK * D * 2, SHM_K = KVBLK * D * 2;
constexpr int LDS_BYTES = 2 * SHM_V + 2 * SHM_K + NW * 64 * 4;

using bf16 = __hip_bfloat16;
typedef short bf16x8 __attribute__((ext_vector_type(8)));
typedef short s16x4 __attribute__((ext_vector_type(4)));
typedef float f32x16 __attribute__((ext_vector_type(16)));
typedef float f32x4 __attribute__((ext_vector_type(4)));
typedef unsigned u32x4 __attribute__((ext_vector_type(4)));
template <class A, class Bt> struct same_t { static constexpr bool v = false; };
template <class A> struct same_t<A, A> { static constexpr bool v = true; };

#define KSWZ(row, colB) ((row) * 256 + ((colB) ^ (((row) & 7) << 4)))
#define SBAR() __builtin_amdgcn_sched_barrier(0)
__device__ __forceinline__ int att_tid() { int t = threadIdx.x; asm volatile("" : "+v"(t)); return t; }
__device__ __forceinline__ int v_st(int k, int c) { const int kk = (k & ~0xC) | ((k & 4) << 1) | ((k & 8) >> 1); return ((kk >> 3) * 4 + (c >> 5)) * 512 + ((kk & 7) * 32 + (c & 31)) * 2; }
__device__ __forceinline__ int v_rd_base(int lane) { return ((lane & 3) << 3) | (((lane >> 2) & 3) << 6) | (((lane >> 4) & 1) << 5) | (((lane >> 5) & 1) << 8); }
constexpr int v_rd_off(int d0, int ks, int half) { return d0 * 512 + ks * 4096 + half * 2048; }
__device__ __forceinline__ int crow(int r, int hi) { return (r & 3) + 8 * (r >> 2) + 4 * hi; }
__device__ __forceinline__ unsigned cvtpk(float lo, float hi) {
    unsigned r; asm volatile("v_cvt_pk_bf16_f32 %0, %1, %2" : "=v"(r) : "v"(lo), "v"(hi)); return r;
}
__device__ __forceinline__ bf16x8 pack8(f32x4 a, f32x4 b) {
    u32x4 w = {cvtpk(a[0], a[1]), cvtpk(a[2], a[3]), cvtpk(b[0], b[1]), cvtpk(b[2], b[3])};
    return *reinterpret_cast<bf16x8*>(&w);
}
template <class T> __device__ __forceinline__ bf16x8 load8(const T* p) {
    if constexpr (same_t<T, float>::v) { return pack8(*(const f32x4*)p, *(const f32x4*)(p + 4)); }
    else { return *reinterpret_cast<const bf16x8*>(p); }
}
__device__ __forceinline__ void mask_tile(f32x16& p0, f32x16& p1, int dq, unsigned W) {
    const float NEG = -__builtin_inff();
#pragma unroll
    for (int r = 0; r < 16; ++r) {
        const int c = (r & 3) + 8 * (r >> 2);
        if ((unsigned)(dq - c) >= W) p0[r] = NEG;
        if ((unsigned)(dq - c - 32) >= W) p1[r] = NEG;
    }
}
__device__ __forceinline__ void partialSM(f32x16& p0, f32x16& p1, float& m_reg, float& mn, float& alpha) {
    float pmax = p0[0]; for (int r = 1; r < 16; ++r) pmax = fmaxf(pmax, p0[r]); for (int r = 0; r < 16; ++r) pmax = fmaxf(pmax, p1[r]);
    { auto rr = __builtin_amdgcn_permlane32_swap(__float_as_uint(pmax), __float_as_uint(pmax), false, false);
      pmax = fmaxf(__uint_as_float(rr[0]), __uint_as_float(rr[1])); }
    constexpr float C2 = 1.4426950408889634f * SCALE;
    if (__builtin_expect(__all((pmax - m_reg) * SCALE <= THR), 1)) { mn = m_reg; alpha = 1.f; }
    else { mn = fmaxf(m_reg, pmax); alpha = __builtin_amdgcn_exp2f((m_reg - mn) * C2); m_reg = mn; }
    const float mnL = -mn * C2;
    for (int r = 0; r < 16; ++r) p0[r] = fmaf(p0[r], C2, mnL); for (int r = 0; r < 16; ++r) p1[r] = fmaf(p1[r], C2, mnL);
    for (int r = 0; r < 16; ++r) p0[r] = __builtin_amdgcn_exp2f(p0[r]);
}
__device__ __forceinline__ void finishSM(f32x16& p0, f32x16& p1, float alpha, float& l_reg, bf16x8& pa0, bf16x8& pa1, bf16x8& pa2, bf16x8& pa3) {
    for (int r = 0; r < 16; ++r) p1[r] = __builtin_amdgcn_exp2f(p1[r]);
    float ps = 0; for (int r = 0; r < 16; ++r) ps += p0[r]; for (int r = 0; r < 16; ++r) ps += p1[r];
    { auto rr = __builtin_amdgcn_permlane32_swap(__float_as_uint(ps), __float_as_uint(ps), false, false);
      ps = __uint_as_float(rr[0]) + __uint_as_float(rr[1]); }
    l_reg = l_reg * alpha + ps;
#define PK4(P, B_, OUT) do { unsigned a0 = cvtpk(P[B_+0], P[B_+1]), a1 = cvtpk(P[B_+2], P[B_+3]);                          \
        unsigned b0 = cvtpk(P[B_+4], P[B_+5]), b1 = cvtpk(P[B_+6], P[B_+7]);                                             \
        auto r0 = __builtin_amdgcn_permlane32_swap(a0, b0, false, false); auto r1 = __builtin_amdgcn_permlane32_swap(a1, b1, false, false); \
        u32x4 w = {r0[0], r1[0], r0[1], r1[1]}; OUT = *reinterpret_cast<bf16x8*>(&w); } while (0)
    PK4(p0, 0, pa0); PK4(p0, 8, pa1); PK4(p1, 0, pa2); PK4(p1, 8, pa3);
#undef PK4
}
template <int KB, bool SK>
__device__ __forceinline__ void qkt(f32x16& p0, f32x16& p1, const char* K_lds, int r32, int hi, const bf16x8* qr, bool act, int bia) {
    if (SK && !act) { const float NEG = -__builtin_inff();
#pragma unroll
        for (int r = 0; r < 16; ++r) { p0[r] = NEG; p1[r] = NEG; } return; }
    {
#pragma unroll
        for (int g = 0; g < 4; ++g) { typedef const __attribute__((address_space(3))) f32x4* lp4; const f32x4 a = *(lp4)(uintptr_t)(unsigned)(bia + 32 * g), b = *(lp4)(uintptr_t)(unsigned)(bia + 128 + 32 * g);
            p0[4 * g] = a[0]; p0[4 * g + 1] = a[1]; p0[4 * g + 2] = a[2]; p0[4 * g + 3] = a[3];
            p1[4 * g] = b[0]; p1[4 * g + 1] = b[1]; p1[4 * g + 2] = b[2]; p1[4 * g + 3] = b[3]; } }
    const char* kb[4];
#pragma unroll
    for (int dd = 0; dd < 4; ++dd) kb[dd] = K_lds + KB * SHM_K + KSWZ(r32, (dd * 16 + hi * 8) * 2);
#pragma unroll
    for (int d0 = 0; d0 < 8; ++d0) { const char* a = kb[d0 & 3] + (d0 >> 2) * 128;
        bf16x8 b0 = *reinterpret_cast<const bf16x8*>(a);
        bf16x8 b1 = *reinterpret_cast<const bf16x8*>(a + 32 * 256);
        p0 = __builtin_amdgcn_mfma_f32_32x32x16_bf16(b0, qr[d0], p0, 0, 0, 0);
        p1 = __builtin_amdgcn_mfma_f32_32x32x16_bf16(b1, qr[d0], p1, 0, 0, 0); }
}
template <int VB, bool SK>
__device__ __forceinline__ void pv_tile(f32x16* o, int vb0, bf16x8 pa0, bf16x8 pa1, bf16x8 pa2, bf16x8 pa3, bool act) {
    if (SK && !act) return;
#define TRRD(dst, off) asm volatile("ds_read_b64_tr_b16 %0, %1 offset:%2" : "=&v"(dst) : "v"(vb0), "i"(off) : "memory")
#define PV_D0(d0) do { s16x4 l0, l1, l2, l3, h0, h1, h2, h3; constexpr int b_ = VB * SHM_V + v_rd_off(d0, 0, 0);     \
        TRRD(l0, b_); TRRD(h0, b_ + 2048); TRRD(l1, b_ + 4096); TRRD(h1, b_ + 6144); TRRD(l2, b_ + 8192); TRRD(h2, b_ + 10240); TRRD(l3, b_ + 12288); TRRD(h3, b_ + 14336); \
        asm volatile("s_waitcnt lgkmcnt(0)" ::: "memory"); SBAR();                 \
        o[d0] = __builtin_amdgcn_mfma_f32_32x32x16_bf16(pa0, (bf16x8){l0[0], l0[1], l0[2], l0[3], h0[0], h0[1], h0[2], h0[3]}, o[d0], 0, 0, 0);   \
        o[d0] = __builtin_amdgcn_mfma_f32_32x32x16_bf16(pa1, (bf16x8){l1[0], l1[1], l1[2], l1[3], h1[0], h1[1], h1[2], h1[3]}, o[d0], 0, 0, 0);   \
        o[d0] = __builtin_amdgcn_mfma_f32_32x32x16_bf16(pa2, (bf16x8){l2[0], l2[1], l2[2], l2[3], h2[0], h2[1], h2[2], h2[3]}, o[d0], 0, 0, 0);   \
        o[d0] = __builtin_amdgcn_mfma_f32_32x32x16_bf16(pa3, (bf16x8){l3[0], l3[1], l3[2], l3[3], h3[0], h3[1], h3[2], h3[3]}, o[d0], 0, 0, 0); } while (0)
    PV_D0(0); PV_D0(1); PV_D0(2); PV_D0(3);
#undef PV_D0
#undef TRRD
}

template <class TIn, class TOut> struct BlockRef { const TIn* Q; const TIn* K; const TIn* V; TOut* O; int P0; };
template <class TIn> struct Seam {
    bf16x8 qr[8];
    bf16x8 st_v0, st_v1, st_k0, st_k1; f32x4 sf0, sf1, sf2, sf3;
    f32x4 tq[16];
};
__device__ __forceinline__ int swa_jlo(int P0, int W) { const int lowk = P0 - W + 1; return lowk > 0 ? lowk / KVBLK : 0; }
#define ROW(p, k0, rr) ((p) + (size_t)((k0) + (rr)) * RS + sc)
#define VMW() asm volatile("s_waitcnt vmcnt(0)" ::: "memory")
#define VMWN(n) asm volatile("s_waitcnt vmcnt(%0)" :: "i"(n) : "memory")
#define SLOAD_H(Kp, Vp, k0) do { S.st_v0 = load8<TIn>(ROW(Vp, k0, sr)); S.st_v1 = load8<TIn>(ROW(Vp, k0, 32 + sr));              \
                         S.st_k0 = load8<TIn>(ROW(Kp, k0, sr)); S.st_k1 = load8<TIn>(ROW(Kp, k0, 32 + sr)); } while (0)
#define SWRITE_HK(bf) do { *(bf16x8*)(K_lds + (bf) * SHM_K + kws) = S.st_k0; *(bf16x8*)(K_lds + (bf) * SHM_K + kws + 32 * 256) = S.st_k1; } while (0)
#define SWRITE_HV(bf) do { *(bf16x8*)(V_lds + (bf) * SHM_V + vst0) = S.st_v0; *(bf16x8*)(V_lds + (bf) * SHM_V + vst1) = S.st_v1; } while (0)
#define SWRITE_H(bf) do { SWRITE_HV(bf); SWRITE_HK(bf); } while (0)
#define SLOAD_F(p, k0) do { S.sf0 = *(const f32x4*)ROW(p, k0, sr); S.sf1 = *(const f32x4*)(ROW(p, k0, sr) + 4);                \
                            S.sf2 = *(const f32x4*)ROW(p, k0, 32 + sr); S.sf3 = *(const f32x4*)(ROW(p, k0, 32 + sr) + 4); } while (0)
#define SWRITE_KF(bf) do { *(bf16x8*)(K_lds + (bf) * SHM_K + kws) = pack8(S.sf0, S.sf1); *(bf16x8*)(K_lds + (bf) * SHM_K + kws + 32 * 256) = pack8(S.sf2, S.sf3); } while (0)
#define SWRITE_VF(bf) do { *(bf16x8*)(V_lds + (bf) * SHM_V + vst0) = pack8(S.sf0, S.sf1); *(bf16x8*)(V_lds + (bf) * SHM_V + vst1) = pack8(S.sf2, S.sf3); } while (0)
template <class TIn, class TOut>
__device__ __forceinline__ void causal_swa_prime(const BlockRef<TIn, TOut>& cur, int W, char* lds, Seam<TIn>& S) {
    constexpr bool F32 = same_t<TIn, float>::v;
    const int tid = att_tid(), wid = __builtin_amdgcn_readfirstlane(tid >> 6), lane = tid & 63, r32 = lane & 31, hi = lane >> 5;
    const int sr = tid >> 4, sc = (tid & 15) * 8, kws = KSWZ(sr, sc * 2); char* K_lds = lds + 2 * SHM_V;
    const int kb0 = swa_jlo(cur.P0, W) * KVBLK;
    for (int d0 = 0; d0 < 8; ++d0) S.qr[d0] = load8<TIn>(cur.Q + (size_t)(wid * QBLK + r32) * RS + d0 * 16 + hi * 8);
    if constexpr (F32) { SLOAD_F((const float*)cur.K, kb0); VMW(); SWRITE_KF(0); SBAR(); SLOAD_F((const float*)cur.V, kb0); }
    else { SLOAD_H(cur.K, cur.V, kb0); VMW(); SWRITE_HK(0); }
    __syncthreads();
}
template <class TIn, class TOut>
__device__ __forceinline__ void causal_swa_block(const BlockRef<TIn, TOut>& cur, const BlockRef<TIn, TOut>& nxt, int skv, int W, char* lds, Seam<TIn>& S, const float* __restrict__ biasG) {
    constexpr bool F32 = same_t<TIn, float>::v;
    const int tid = att_tid(), wid = __builtin_amdgcn_readfirstlane(tid >> 6), lane = tid & 63, r32 = lane & 31, hi = lane >> 5;
    const int j_lo = swa_jlo(cur.P0, W);
    int j_hi = (cur.P0 + QB - 1) / KVBLK + 1; if (j_hi > skv / KVBLK) j_hi = skv / KVBLK;
    const int NT = j_hi - j_lo;
    {
        float* bl = (float*)(lds + LDS_BYTES);
        unsigned t0 = (unsigned)tid; asm volatile("" : "+v"(t0));
        for (unsigned i4 = t0; i4 < (unsigned)(j_hi * 16); i4 += 512u) *(f32x4*)(bl + 4u * i4) = *(const f32x4*)((const char*)biasG + 16u * i4);
        __syncthreads(); }
    const int biaL = (int)(uintptr_t)(lds + LDS_BYTES) + 16 * hi;
    const int kbn = swa_jlo(nxt.P0, W) * KVBLK;
    const int qlo = cur.P0 + wid * QBLK, qm = qlo + r32 - 4 * hi;
    char* V_lds = lds; char* K_lds = lds + 2 * SHM_V;
    float* ws = (float*)(lds + 2 * SHM_V + 2 * SHM_K) + wid * 64; float* li_l = ws, * al_l = ws + 32;
    float m_reg = -1e30f, l_reg = 0; f32x16 o[4] = {};
    const int sr = tid >> 4, sc = (tid & 15) * 8, vst0 = v_st(sr, sc), vst1 = v_st(32 + sr, sc), kws = KSWZ(sr, sc * 2);
    const int vb0 = (int)(uintptr_t)V_lds + v_rd_base(lane);
    const TIn* Kh = cur.K; const TIn* Vh = cur.V;
#define RESC(a) do { if (__any((a) < 1.f)) { if (hi == 0) al_l[r32] = (a); asm volatile("s_waitcnt lgkmcnt(0)" ::: "memory");              \
                     for (int d_ = 0; d_ < 4; ++d_) for (int r = 0; r < 16; ++r) o[d_][r] *= al_l[crow(r, hi)]; } } while (0)
#define KBASE(t) ((j_lo + (t)) * KVBLK)
#define ACT(t) (KBASE(t) <= qlo + QBLK - 1 && KBASE(t) + KVBLK - 1 >= qlo - W + 1)
#define MASKT(P0_, P1_, t) do { const int kb_ = KBASE(t); if ((!SK || ACT(t)) && (kb_ + KVBLK - 1 > qlo || kb_ <= qlo + QBLK - 1 - W)) mask_tile(P0_, P1_, qm - kb_, (unsigned)W); } while (0)
    constexpr int NQL = F32 ? 16 : 8;
    constexpr bool SK = WSKIP && !F32;
#define SEAM_K0() do { VMWN(NQL); if constexpr (F32) { SWRITE_KF(0); SBAR(); SLOAD_F((const float*)nxt.V, kbn); } else { SWRITE_HK(0); } SBAR(); } while (0)
    f32x16 pA0, pA1, pB0, pB1; float mnA, mnB, alA, alB; bf16x8 pa0, pa1, pa2, pa3;
    if constexpr (F32) { VMW(); SWRITE_VF(0); SBAR(); } else { SWRITE_HV(0); SBAR(); }
    if (NT > 1) { if constexpr (F32) SLOAD_F((const float*)Kh, KBASE(1)); else SLOAD_H(Kh, Vh, KBASE(1)); }
    SBAR(); qkt<0, SK>(pA0, pA1, K_lds, r32, hi, S.qr, ACT(0), biaL + 4 * KBASE(0));
    if constexpr (F32) { if (NT > 1) { VMW(); SWRITE_KF(1); SBAR(); SLOAD_F((const float*)Vh, KBASE(1)); } }
    MASKT(pA0, pA1, 0); partialSM(pA0, pA1, m_reg, mnA, alA);
    if (NT > 1) { VMW(); if constexpr (F32) { SWRITE_VF(1); SBAR(); if (NT > 2) SLOAD_F((const float*)Kh, KBASE(2)); } else SWRITE_H(1); }
    __syncthreads();
#define HALF_STEP(PX0, PX1, mnX, alX, PY0, PY1, alY, t, KB, VB, SB) do {                                                      \
        SBAR(); qkt<KB, SK>(PX0, PX1, K_lds, r32, hi, S.qr, ACT(t), biaL + 4 * KBASE(t));                                             \
        finishSM(PY0, PY1, alY, l_reg, pa0, pa1, pa2, pa3); SBAR();                                                           \
        if ((t) + 1 < NT) { if constexpr (F32) { VMW(); SWRITE_KF(SB); SBAR(); SLOAD_F((const float*)Vh, KBASE((t) + 1)); }  \
                            else { SLOAD_H(Kh, Vh, KBASE((t) + 1)); } SBAR(); }                                               \
        pv_tile<VB, SK>(o, vb0, pa0, pa1, pa2, pa3, ACT((t) - 1)); MASKT(PX0, PX1, (t)); partialSM(PX0, PX1, m_reg, mnX, alX);                                        \
        __syncthreads();                                                                                                      \
        if ((t) + 1 < NT) { VMW(); if constexpr (F32) { SWRITE_VF(SB); SBAR(); if ((t) + 2 < NT) SLOAD_F((const float*)Kh, KBASE((t) + 2)); } \
                            else { SWRITE_H(SB); } }                                                                          \
        RESC(alX); __syncthreads(); } while (0)
    for (int t = 1; t + 1 < NT; t += 2) {
        HALF_STEP(pB0, pB1, mnB, alB, pA0, pA1, alA, t, 1, 0, 0);
        HALF_STEP(pA0, pA1, mnA, alA, pB0, pB1, alB, t + 1, 0, 1, 1);
    }
    const bool even = (NT & 1) == 0;
    if (even) { SBAR(); qkt<1, SK>(pB0, pB1, K_lds, r32, hi, S.qr, ACT(NT - 1), biaL + 4 * KBASE(NT - 1)); SBAR(); }
#define QROW(e) (nxt.Q + (size_t)(wid * QBLK + r32) * RS + ((e) >> 1) * 16 + hi * 8 + ((e) & 1) * 4)
    if constexpr (F32) { SLOAD_F((const float*)nxt.K, kbn); SBAR();
#pragma unroll
        for (int e = 0; e < 8; ++e) S.tq[e] = *(const f32x4*)QROW(e); }
    else { SLOAD_H(nxt.K, nxt.V, kbn); SBAR();
#pragma unroll
        for (int d0 = 0; d0 < 8; ++d0) S.qr[d0] = load8<TIn>(nxt.Q + (size_t)(wid * QBLK + r32) * RS + d0 * 16 + hi * 8); }
    SBAR();
    finishSM(pA0, pA1, alA, l_reg, pa0, pa1, pa2, pa3); SBAR();
    if constexpr (F32) {
#pragma unroll
        for (int e = 8; e < 16; ++e) S.tq[e] = *(const f32x4*)QROW(e); SBAR(); }
#undef QROW
    pv_tile<0, SK>(o, vb0, pa0, pa1, pa2, pa3, ACT(even ? NT - 2 : NT - 1));
    if (even) { MASKT(pB0, pB1, NT - 1); partialSM(pB0, pB1, m_reg, mnB, alB); __syncthreads(); RESC(alB);
        finishSM(pB0, pB1, alB, l_reg, pa0, pa1, pa2, pa3); SBAR(); pv_tile<1, SK>(o, vb0, pa0, pa1, pa2, pa3, ACT(NT - 1)); }
    SBAR(); SEAM_K0();
    if (hi == 0) li_l[r32] = l_reg; asm volatile("s_waitcnt lgkmcnt(0)" ::: "memory");
    float rli[16];
#pragma unroll
    for (int r = 0; r < 16; ++r) rli[r] = __builtin_amdgcn_rcpf(li_l[crow(r, hi)]);
    TOut* Ow = cur.O + (size_t)(wid * QBLK) * RS;
#pragma unroll
    for (int r = 0; r < 16; ++r) { const int orow = crow(r, hi);
#pragma unroll
        for (int d0 = 0; d0 < 4; ++d0) { const float v = o[d0][r] * rli[r];
            if constexpr (same_t<TOut, float>::v) { Ow[(size_t)orow * RS + d0 * 32 + r32] = v; }
            else { const float vn = __shfl_xor(v, 1);
                   if ((r32 & 1) == 0) *(unsigned*)(Ow + (size_t)orow * RS + d0 * 32 + r32) = cvtpk(v, vn); } } }
    if constexpr (F32) {
#pragma unroll
        for (int d0 = 0; d0 < 8; ++d0) S.qr[d0] = pack8(S.tq[2 * d0], S.tq[2 * d0 + 1]); }
    __syncthreads();
#undef RESC
#undef KBASE
#undef ACT
#undef MASKT
#undef SEAM_K0
#undef HALF_STEP
}
#undef ROW
#undef VMW
#undef VMWN
#undef SLOAD_H
#undef SWRITE_HK
#undef SWRITE_HV
#undef SWRITE_H
#undef SLOAD_F
#undef SWRITE_KF
#undef SWRITE_VF
}
#ifndef MK_SPLIT
#define MK_SPLIT 0
#endif
#define LAS __attribute__((address_space(3)))
typedef unsigned short bf16_t;
typedef float v4f __attribute__((ext_vector_type(4)));
typedef float v2f __attribute__((ext_vector_type(2)));
typedef unsigned v4u __attribute__((ext_vector_type(4)));
typedef unsigned v2u __attribute__((ext_vector_type(2)));
typedef short h8 __attribute__((ext_vector_type(8)));

constexpr int DM = 2048, SEQ = 8192, NMETA = 16, NH = 8, HD = 128, DATT = 1024, DSSM = 1024, NG = 64, NP = 64, DFF = 5632, NIN = 8200;
constexpr int MREAL = 2 * SEQ;
constexpr int MROWS = MREAL + NMETA;
constexpr int RPAD = 16640;
constexpr int PPOS = 8256;
constexpr float EPS = 1e-6f;
constexpr float INV_SCALE = 11.313708498984761f;
constexpr int LDS_BYTES = 147456;

constexpr size_t MiB = 1u << 20;
constexpr size_t OFF_WT_UP = 0, OFF_WT_DOWN = 44 * MiB, OFF_WT_OUT = 66 * MiB, OFF_WT_IN = 74 * MiB, OFF_WT_O = 106 * MiB, OFF_WT_GLU = 110 * MiB;
constexpr size_t OFF_KT = 118 * MiB, OFF_WTS = 120 * MiB, OFF_VTS = 136 * MiB, OFF_MISC = 152 * MiB;
constexpr size_t OFF_GP = OFF_MISC, OFF_RSTD0 = OFF_MISC + 640 * 1024, OFF_SUMSQ1 = OFF_MISC + 768 * 1024, OFF_SUMSQ2 = OFF_MISC + 896 * 1024,
                 OFF_LF = OFF_MISC + 1024 * 1024, OFF_BIAS = OFF_MISC + 1664 * 1024, OFF_GP2 = OFF_MISC + 2560 * 1024, OFF_BAR = OFF_MISC + 3072 * 1024;
constexpr size_t OFF_H0B = 156 * MiB, OFF_OB = 419 * MiB, OFF_YG = 452 * MiB;
constexpr size_t OFF_Q = 221 * MiB, OFF_K = 254 * MiB, OFF_V = 287 * MiB, OFF_UB = 320 * MiB, OFF_SGA = 353 * MiB, OFF_SGB = 386 * MiB;
constexpr size_t OFF_M1 = 221 * MiB, OFF_MERGED = 286 * MiB, OFF_H1B = 74 * MiB, OFF_G = 156 * MiB, OFF_U = 333 * MiB;
constexpr size_t WS_NEED = OFF_U + (size_t)MROWS * DFF * 2;
static_assert(WS_NEED <= 512 * MiB, "ws map");
static_assert(OFF_SGA + (size_t)MROWS * 2048 <= OFF_SGB && OFF_SGB + (size_t)MROWS * 2048 <= OFF_OB && OFF_OB + (size_t)MROWS * 2048 <= OFF_YG && OFF_YG + (size_t)MROWS * 2048 <= 512 * MiB && OFF_G + (size_t)MROWS * DFF * 2 <= OFF_U, "ws map 2");

struct Args { const float* in[22]; float* out; unsigned char* ws; int ph_lo, ph_hi; };
static_assert(sizeof(Args) == 22 * 8 + 8 + 8 + 8, "no padding");
enum { I_X = 0, I_META, I_GMIX, I_WIN, I_BF, I_LRE, I_LIM, I_LOGDT, I_BRE, I_BIM, I_CRE, I_CIM, I_DSKIP, I_WGLU, I_WATTO, I_WOUT, I_GFFN, I_WUP, I_CONVW, I_CONVB, I_WDOWN, I_GFINAL };

__device__ __forceinline__ float bf2f(unsigned short h) { return __uint_as_float((unsigned)h << 16); }
__device__ __forceinline__ float bflo(unsigned w) { return __uint_as_float(w << 16); }
__device__ __forceinline__ float bfhi(unsigned w) { return __uint_as_float(w & 0xffff0000u); }
__device__ __forceinline__ unsigned pk2(float lo, float hi) { return pg8::cvt_pk_bf16(lo, hi); }
__device__ __forceinline__ unsigned pk2n(float lo, float hi) { unsigned r; asm("v_cvt_pk_bf16_f32 %0, %1, %2" : "=v"(r) : "v"(lo), "v"(hi)); return r; }
__device__ __forceinline__ float sigmoidf_(float x) { return __builtin_amdgcn_rcpf(1.f + __expf(-x)); }
__device__ __forceinline__ unsigned pack4u8(float a, float b, float c, float d) { return (unsigned)(a * 255.f + 0.5f) | ((unsigned)(b * 255.f + 0.5f) << 8) | ((unsigned)(c * 255.f + 0.5f) << 16) | ((unsigned)(d * 255.f + 0.5f) << 24); }
__device__ __forceinline__ void unpack4u8(unsigned w, float* f) { constexpr float k = 1.f / 255.f; f[0] = (float)(w & 255u) * k; f[1] = (float)((w >> 8) & 255u) * k; f[2] = (float)((w >> 16) & 255u) * k; f[3] = (float)(w >> 24) * k; }
__device__ __forceinline__ float gelu_tanh(float x) { const float u = 0.7978845608028654f * (x + 0.044715f * x * x * x); return x * sigmoidf_(2.f * u); }
__device__ __forceinline__ float wave_sum(float v) {
#pragma unroll
    for (int o = 1; o < 64; o <<= 1) v += __shfl_xor(v, o);
    return v;
}
#define LDS_WAIT() asm volatile("s_waitcnt lgkmcnt(0)" ::: "memory")
#if defined(__HIP_DEVICE_COMPILE__)
#define KARG_PTR(p_) unsigned long long p_ = (unsigned long long)__builtin_amdgcn_kernarg_segment_ptr(); asm volatile("" : "+s"(p_))
#define LOAD_ARGS(name) Args name; { KARG_PTR(p_); name = *(const __attribute__((address_space(4))) Args*)p_; } unsigned char* ws = name.ws
__device__ __forceinline__ bool ph_in(int k) { KARG_PTR(p_); const __attribute__((address_space(4))) Args* q = (const __attribute__((address_space(4))) Args*)p_; return q->ph_lo <= k && k < q->ph_hi; }
#else
#define LOAD_ARGS(name) Args name{}; unsigned char* ws = name.ws
__device__ __forceinline__ bool ph_in(int k) { return false; }
#endif

__device__ __forceinline__ void tr_item(const float* __restrict__ W, int K, int Nsrc, int nsrc0, bf16_t* __restrict__ WT, int ndst0, int k0, const float* __restrict__ ksc, LAS float* scr, int lane) {
    const float* src = W + (size_t)k0 * Nsrc + nsrc0 + lane;
    float v[64];
#pragma unroll
    for (int i = 0; i < 64; ++i) v[i] = __builtin_nontemporal_load(src + (size_t)i * Nsrc);
    if (ksc) { const float sc = ksc[k0 + lane];
#pragma unroll
        for (int i = 0; i < 64; ++i) v[i] *= __uint_as_float(__builtin_amdgcn_readlane(__float_as_uint(sc), i)); }
#pragma unroll
    for (int i = 0; i < 64; ++i) scr[i * 65 + lane] = v[i];
    LDS_WAIT(); asm volatile("" ::: "memory");
    const int c = lane & 7;
#pragma unroll
    for (int j = 0; j < 8; ++j) { const int n = (lane >> 3) + 8 * j; const LAS float* q = scr + (8 * c) * 65 + n;
        v4u o; o.x = pk2(q[0 * 65], q[1 * 65]); o.y = pk2(q[2 * 65], q[3 * 65]); o.z = pk2(q[4 * 65], q[5 * 65]); o.w = pk2(q[6 * 65], q[7 * 65]);
        *(v4u*)(WT + (size_t)(ndst0 + n) * K + k0 + 8 * c) = o; }
    LDS_WAIT(); asm volatile("" ::: "memory");
}
__device__ __forceinline__ int ilv_src(int n, int half) { const int t = n >> 8, w = n & 255; return w < 128 ? 128 * t + w : half + 128 * t + (w - 128); }

__device__ __forceinline__ void p0_transposes(const Args& a, LAS unsigned char* lds, int gw, int NGW, int wid, int lane) {
    LAS float* scr = (LAS float*)(lds + wid * 16640);
    unsigned char* ws = a.ws;
    constexpr int I_IN = (DM / 64) * (8192 / 64), I_O = (DATT / 64) * (DM / 64), I_GLU = (DSSM / 64) * (4096 / 64), I_OUT = (DM / 64) * (DM / 64), I_UP = (DM / 64) * (2 * DFF / 64), I_DN = (DFF / 64) * (DM / 64);
    constexpr int NIT = I_IN + I_O + I_GLU + I_OUT + I_UP + I_DN;
    for (int it = gw; it < NIT; it += NGW) {
        int r = it;
        if (r < I_UP) { const int nb = r % (2 * DFF / 64), kb = r / (2 * DFF / 64), nd = 64 * nb; tr_item(a.in[I_WUP], DM, 2 * DFF, ilv_src(nd, DFF), (bf16_t*)(ws + OFF_WT_UP), nd, 64 * kb, a.in[I_GFFN], scr, lane); continue; } r -= I_UP;
        if (r < I_IN) { const int nb = r % 128, kb = r / 128, nd = 64 * nb; tr_item(a.in[I_WIN], DM, NIN, nd < 3072 ? nd : nd + 8, (bf16_t*)(ws + OFF_WT_IN), nd, 64 * kb, a.in[I_GMIX], scr, lane); continue; } r -= I_IN;
        if (r < I_DN) { const int nb = r % 32, kb = r / 32; tr_item(a.in[I_WDOWN], DFF, DM, 64 * nb, (bf16_t*)(ws + OFF_WT_DOWN), 64 * nb, 64 * kb, nullptr, scr, lane); continue; } r -= I_DN;
        if (r < I_GLU) { const int nb = r % 64, kb = r / 64, nd = 64 * nb; tr_item(a.in[I_WGLU], DSSM, 4096, ilv_src(nd, 2048), (bf16_t*)(ws + OFF_WT_GLU), nd, 64 * kb, nullptr, scr, lane); continue; } r -= I_GLU;
        if (r < I_OUT) { const int nb = r % 32, kb = r / 32; tr_item(a.in[I_WOUT], DM, DM, 64 * nb, (bf16_t*)(ws + OFF_WT_OUT), 64 * nb, 64 * kb, nullptr, scr, lane); continue; } r -= I_OUT;
        { const int nb = r % 32, kb = r / 32; tr_item(a.in[I_WATTO], DATT, DM, 64 * nb, (bf16_t*)(ws + OFF_WT_O), 64 * nb, 64 * kb, nullptr, scr, lane); }
    }
}

constexpr int WF_OFF = 69632;
__device__ __forceinline__ void p0_rows(const Args& a, LAS unsigned char* lds, int gw, int NGW, int lane) {
    unsigned char* ws = a.ws;
    LAS float* wf = (LAS float*)(lds + WF_OFF);
    bf16_t* H0B = (bf16_t*)(ws + OFF_H0B); float* RSTD0 = (float*)(ws + OFF_RSTD0); float* LF = (float*)(ws + OFF_LF);
    const float* bfp = a.in[I_BF];
    for (int r = gw; r < RPAD; r += NGW) {
        v2u* o8 = (v2u*)(H0B + (size_t)r * DM) + lane;
        if (r >= MROWS) {
#pragma unroll
            for (int j = 0; j < 8; ++j) o8[64 * j] = (v2u){0u, 0u};
            if (lane == 0) RSTD0[r] = 0.f;
            continue;
        }
        const float* src = r < MREAL ? a.in[I_X] + (size_t)r * DM : a.in[I_META] + (size_t)(r - MREAL) * DM;
        const v4f* xr = (const v4f*)src + lane;
        v4f v[8]; float s2 = 0.f;
#pragma unroll
        for (int j = 0; j < 8; ++j) { v[j] = __builtin_nontemporal_load(xr + 64 * j); s2 += (v[j].x * v[j].x + v[j].y * v[j].y) + (v[j].z * v[j].z + v[j].w * v[j].w); }
        float f[8];
#pragma unroll
        for (int h = 0; h < 8; ++h) { float acc = 0.f;
#pragma unroll
            for (int j = 0; j < 8; ++j) { const v4f w = *(const LAS v4f*)(wf + h * 2048 + 256 * j + 4 * lane); acc += (v[j].x * w.x + v[j].y * w.y) + (v[j].z * w.z + v[j].w * w.w); }
            f[h] = acc; }
        s2 = wave_sum(s2);
        const float rstd = 1.0f / sqrtf(s2 * (1.f / DM) + EPS);
#pragma unroll
        for (int h = 0; h < 8; ++h) f[h] = wave_sum(f[h]);
#pragma unroll
        for (int j = 0; j < 8; ++j) o8[64 * j] = (v2u){pk2(v[j].x, v[j].y), pk2(v[j].z, v[j].w)};
        if (lane == 0) RSTD0[r] = rstd;
        if (lane < 8) {
            float fv = f[0];
#pragma unroll
            for (int h = 1; h < 8; ++h) fv = (lane == h) ? f[h] : fv;
            const float y = fv * rstd + bfp[lane];
            const float lf = fminf(y, 0.f) - log1pf(__expf(-fabsf(y)));
            if (r < MREAL) { const int b = r >> 13, i = r & 8191; LF[(size_t)(b * 8 + lane) * PPOS + 64 + i] = lf; }
            else { const int j = r - MREAL; LF[(size_t)lane * PPOS + 48 + j] = lf; LF[(size_t)(8 + lane) * PPOS + 48 + j] = lf; }
        }
    }
}

__device__ __forceinline__ void ssm_gen(LAS unsigned char* lds, int g, int part, int tid) {
    LAS float* TBr = (LAS float*)lds; LAS float* TBi = TBr + 65 * 64; LAS float* BBr = TBi + 65 * 64; LAS float* BBi = BBr + 1024; LAS float* CTr = BBi + 1024; LAS float* CTi = CTr + 1024;
    LAS double* AZ = (LAS double*)(CTi + 1024);
    if (tid < 64) { LOAD_ARGS(a); (void)ws; const int p = tid;
        const double dt = exp((double)a.in[I_LOGDT][g]);
        const double lr = (double)a.in[I_LRE][g * 64 + p], li = (double)a.in[I_LIM][g * 64 + p];
        const double mag = exp(lr * dt); double sn, cs; sincos(li * dt, &sn, &cs);
        const double are = mag * cs, aim = mag * sn, den = lr * lr + li * li, nr = are - 1.0;
        AZ[4 * p] = are; AZ[4 * p + 1] = aim; AZ[4 * p + 2] = (nr * lr + aim * li) / den; AZ[4 * p + 3] = (aim * lr - nr * li) / den; }
    __syncthreads();
    { LOAD_ARGS(a); float* GP = (float*)(ws + OFF_GP) + (size_t)g * 2304;
#pragma unroll 1
      for (int e = tid; e < 65 * 64; e += 512) { const int j = e >> 6, p = e & 63;
        double br = AZ[4 * p], bi = AZ[4 * p + 1], rr = 1.0, ri = 0.0;
#pragma unroll
        for (int bit = 0; bit < 7; ++bit) { if ((j >> bit) & 1) { const double t = rr * br - ri * bi; ri = rr * bi + ri * br; rr = t; } const double t2 = br * br - bi * bi; bi = 2.0 * br * bi; br = t2; }
        TBr[e] = (float)rr; TBi[e] = (float)ri;
        if (part == 0 && j == 1) { GP[p] = (float)rr; GP[64 + p] = (float)ri; }
        if (part == 0 && j == 64) { GP[128 + p] = (float)rr; GP[192 + p] = (float)ri; }
        if (part == 0 && (j == 16 || j == 32 || j == 48)) { float* G2 = (float*)(ws + OFF_GP2) + (size_t)g * 384 + ((j >> 4) - 1) * 128 + 2 * p; G2[0] = (float)rr; G2[1] = (float)ri; } }
#pragma unroll 1
      for (int e = tid; e < 1024; e += 512) { const int p = e >> 4; const double zr = AZ[4 * p + 2], zi = AZ[4 * p + 3];
        const double br = (double)a.in[I_BRE][(size_t)g * 1024 + e], bi = (double)a.in[I_BIM][(size_t)g * 1024 + e];
        const float bbr = (float)(zr * br - zi * bi), bbi = (float)(zr * bi + zi * br);
        BBr[e] = bbr; BBi[e] = bbi; if (part == 0) { GP[256 + e] = bbr; GP[1280 + e] = bbi; } }
#pragma unroll 1
      for (int e = tid; e < 1024; e += 512) { const int co = e >> 6, p = e & 63;
        CTr[p * 16 + co] = a.in[I_CRE][(size_t)g * 1024 + e]; CTi[p * 16 + co] = a.in[I_CIM][(size_t)g * 1024 + e]; } }
    __syncthreads();
    { LOAD_ARGS(a); (void)a; bf16_t* KT = (bf16_t*)(ws + OFF_KT) + (size_t)g * 16384;
      const int pair = tid & 255, co = pair >> 4, ci = pair & 15, j0 = 16 * part + 8 * (tid >> 8); float acc[8];
#pragma unroll
      for (int jj = 0; jj < 8; ++jj) acc[jj] = 0.f;
#pragma unroll 4
      for (int p = 0; p < 64; ++p) { const float cr = CTr[p * 16 + co], cim = CTi[p * 16 + co], br = BBr[p * 16 + ci], bi = BBi[p * 16 + ci], wr = cr * br - cim * bi, wi = cr * bi + cim * br;
#pragma unroll
          for (int jj = 0; jj < 8; ++jj) acc[jj] += wr * TBr[(j0 + jj) * 64 + p] - wi * TBi[(j0 + jj) * 64 + p]; }
#pragma unroll
      for (int jj = 0; jj < 8; ++jj) KT[(j0 + jj) * 256 + pair] = (bf16_t)(pk2(acc[jj], 0.f) & 0xffffu); }
    { LOAD_ARGS(a); (void)a; bf16_t* WTS = (bf16_t*)(ws + OFF_WTS) + (size_t)g * 131072;
#pragma unroll 1
      for (int it = 1024 * part + tid; it < 1024 * (part + 1); it += 512) { const int n = it >> 5, k8 = 96 + (it & 31), p = n >> 1, ri = n & 1, sx = k8 >> 1, c0 = (k8 & 1) * 8;
        const float tr = TBr[(63 - sx) * 64 + p], ti = TBi[(63 - sx) * 64 + p]; float v[8];
#pragma unroll
        for (int e = 0; e < 8; ++e) { const float br = BBr[p * 16 + c0 + e], bi = BBi[p * 16 + c0 + e]; v[e] = ri ? (tr * bi + ti * br) : (tr * br - ti * bi); }
        *(v4u*)(WTS + (size_t)n * 1024 + 8 * k8) = (v4u){pk2(v[0], v[1]), pk2(v[2], v[3]), pk2(v[4], v[5]), pk2(v[6], v[7])}; } }
    { LOAD_ARGS(a); (void)a; bf16_t* VTS = (bf16_t*)(ws + OFF_VTS) + (size_t)g * 131072;
#pragma unroll 1
      for (int it = 1024 * part + tid; it < 1024 * (part + 1); it += 512) { const int n = it >> 4, k8 = it & 15, t = n >> 4, co = n & 15; float v[8];
#pragma unroll
        for (int e = 0; e < 4; ++e) { const int p = 4 * k8 + e; const float tr = TBr[(t + 1) * 64 + p], ti = TBi[(t + 1) * 64 + p], cr = CTr[p * 16 + co], ci = CTi[p * 16 + co];
            v[2 * e] = cr * tr - ci * ti; v[2 * e + 1] = -(cr * ti + ci * tr); }
        *(v4u*)(VTS + (size_t)n * 128 + 8 * k8) = (v4u){pk2(v[0], v[1]), pk2(v[2], v[3]), pk2(v[4], v[5]), pk2(v[6], v[7])}; } }
    __syncthreads();
}

__device__ __forceinline__ void cumsum_seq(const Args& a, LAS unsigned char* lds, int seq, int tid) {
    const float* LF = (const float*)(a.ws + OFF_LF) + (size_t)seq * PPOS; float* BI = (float*)(a.ws + OFF_BIAS) + (size_t)seq * PPOS;
    LAS float* wsum = (LAS float*)lds;
    const int base = 48 + 17 * tid; float s = 0.f; float v[17];
#pragma unroll
    for (int i = 0; i < 17; ++i) v[i] = (base + i < PPOS) ? LF[base + i] : 0.f;
#pragma unroll
    for (int i = 0; i < 17; ++i) s += v[i];
    float inc = s;
#pragma unroll
    for (int o = 1; o < 64; o <<= 1) { const float t = __shfl_up(inc, o); if ((tid & 63) >= o) inc += t; }
    if ((tid & 63) == 63) wsum[tid >> 6] = inc;
    __syncthreads();
    float off = 0.f;
    for (int w = 0; w < (tid >> 6); ++w) off += wsum[w];
    float run = off + inc - s;
#pragma unroll
    for (int i = 0; i < 17; ++i) { run += v[i]; if (base + i < PPOS) BI[base + i] = -run * INV_SCALE; }
    if (tid < 48) BI[tid] = -__builtin_inff();
    __syncthreads();
}

struct EpiZ {
    static constexpr bool PERM = true, AFTER_DRAIN = false;
    const float* rstd; bf16_t *Q, *K, *V, *U, *SGA, *SGB;
    __device__ __forceinline__ void operator()(const pg8::f32x4 (&acc)[2][2][4][2], const pg8::Unit& u, int wr, int wc, int fr, int fq) const {
        const int pn = u.pn, sec = pn < 16 ? (pn >> 2) : (pn < 24 ? 4 : 5), colt = (pn < 16 ? (pn & 3) : (pn & 7)) * 256 + wc * 32 + 8 * fq;
        bf16_t* base = sec == 0 ? Q : (sec == 1 ? K : (sec == 2 ? V : (sec == 3 ? U : (sec == 4 ? SGA : SGB))));
        const int ld = sec >= 4 ? 2048 : 1024; const bool pos = sec >= 1 && sec <= 3, sg = sec >= 4;
#pragma unroll
        for (int ai = 0; ai < 2; ++ai)
#pragma unroll
            for (int m = 0; m < 4; ++m) { const int row = u.pm * 256 + ai * 128 + wr * 64 + m * 16 + fr; const float rs = rstd[row];
                int d1 = row, d2 = -1;
                if (pos) { const int j = row - MREAL; d1 = j < 0 ? (row >> 13) * PPOS + 64 + (row & 8191) : (j < NMETA ? 48 + j : -1); d2 = (j >= 0 && j < NMETA) ? PPOS + 48 + j : -1; }
#pragma unroll
                for (int bj = 0; bj < 2; ++bj) { const int col = colt + bj * 128; pg8::f32x4 v0 = acc[ai][bj][m][0] * rs, v1 = acc[ai][bj][m][1] * rs;
                    if (sg) { v0[0] = sigmoidf_(v0[0]); v0[1] = sigmoidf_(v0[1]); v0[2] = sigmoidf_(v0[2]); v0[3] = sigmoidf_(v0[3]); v1[0] = sigmoidf_(v1[0]); v1[1] = sigmoidf_(v1[1]); v1[2] = sigmoidf_(v1[2]); v1[3] = sigmoidf_(v1[3]); }
                    const v4u w = {pk2n(v0[0], v0[1]), pk2n(v0[2], v0[3]), pk2n(v1[0], v1[1]), pk2n(v1[2], v1[3])};
                    if (sg) *(v2u*)((unsigned char*)base + (size_t)d1 * 2048 + col) = (v2u){pack4u8(v0[0], v0[1], v0[2], v0[3]), pack4u8(v1[0], v1[1], v1[2], v1[3])};
                    else if (d1 >= 0) *(v4u*)(base + (size_t)d1 * ld + col) = w;
                    if (d2 >= 0) *(v4u*)(base + (size_t)d2 * ld + col) = w; } }
    }
};
__device__ __forceinline__ void unpack8(const v4u w, float (&f)[8]) { f[0] = bflo(w.x); f[1] = bfhi(w.x); f[2] = bflo(w.y); f[3] = bfhi(w.y); f[4] = bflo(w.z); f[5] = bfhi(w.z); f[6] = bflo(w.w); f[7] = bfhi(w.w); }
struct EpiO {
    static constexpr bool PERM = true, AFTER_DRAIN = false;
    const bf16_t* SGB; bf16_t* M1;
    __device__ __forceinline__ void operator()(const pg8::f32x4 (&acc)[2][2][4][2], const pg8::Unit& u, int wr, int wc, int fr, int fq) const {
        const size_t off0 = (size_t)(u.pm * 256 + wr * 64 + fr) * 2048 + u.pn * 256 + wc * 32 + 8 * fq;
        v2u sg[2][4][2];
#pragma unroll
        for (int ai = 0; ai < 2; ++ai)
#pragma unroll
            for (int m = 0; m < 4; ++m)
#pragma unroll
                for (int bj = 0; bj < 2; ++bj) sg[ai][m][bj] = *(const v2u*)((const unsigned char*)SGB + off0 + (size_t)(ai * 128 + m * 16) * 2048 + bj * 128);
#pragma unroll
        for (int ai = 0; ai < 2; ++ai)
#pragma unroll
            for (int m = 0; m < 4; ++m)
#pragma unroll
                for (int bj = 0; bj < 2; ++bj) { float sf[8]; unpack4u8(sg[ai][m][bj].x, sf); unpack4u8(sg[ai][m][bj].y, sf + 4); const pg8::f32x4 v0 = acc[ai][bj][m][0], v1 = acc[ai][bj][m][1];
                    *(v4u*)(M1 + off0 + (size_t)(ai * 128 + m * 16) * 2048 + bj * 128) = (v4u){pk2n(v0[0] * sf[0], v0[1] * sf[1]), pk2n(v0[2] * sf[2], v0[3] * sf[3]), pk2n(v1[0] * sf[4], v1[1] * sf[5]), pk2n(v1[2] * sf[6], v1[3] * sf[7])}; }
    }
};
struct EpiGlu {
    static constexpr bool PERM = true, AFTER_DRAIN = false;
    const bf16_t* SGA; const bf16_t* M1; bf16_t* MG;
    __device__ __forceinline__ void operator()(const pg8::f32x4 (&acc)[2][2][4][2], const pg8::Unit& u, int wr, int wc, int fr, int fq) const {
        const size_t off0 = (size_t)(u.pm * 256 + wr * 64 + fr) * 2048 + u.pn * 128 + wc * 32 + 8 * fq;
        v2u gav[2][4]; v4u m1v[2][4];
#pragma unroll
        for (int ai = 0; ai < 2; ++ai)
#pragma unroll
            for (int m = 0; m < 4; ++m) { const size_t off = off0 + (size_t)(ai * 128 + m * 16) * 2048; gav[ai][m] = *(const v2u*)((const unsigned char*)SGA + off); m1v[ai][m] = *(const v4u*)(M1 + off); }
#pragma unroll
        for (int ai = 0; ai < 2; ++ai)
#pragma unroll
            for (int m = 0; m < 4; ++m) { float ga[8], m1[8], o[8]; unpack4u8(gav[ai][m].x, ga); unpack4u8(gav[ai][m].y, ga + 4); unpack8(m1v[ai][m], m1);
#pragma unroll
                for (int e = 0; e < 8; ++e) { const float ya = acc[ai][0][m][e >> 2][e & 3], yb = acc[ai][1][m][e >> 2][e & 3]; o[e] = m1[e] + ga[e] * ya * sigmoidf_(yb); }
                *(v4u*)(MG + off0 + (size_t)(ai * 128 + m * 16) * 2048) = (v4u){pk2n(o[0], o[1]), pk2n(o[2], o[3]), pk2n(o[4], o[5]), pk2n(o[6], o[7])}; }
    }
};
struct EpiOut {
    static constexpr bool PERM = true, AFTER_DRAIN = false;
    const bf16_t* XB; float* OUT; bf16_t* H1B; float* SS;
    __device__ __forceinline__ void operator()(const pg8::f32x4 (&acc)[2][2][4][2], const pg8::Unit& u, int wr, int wc, int fr, int fq) const {
#pragma unroll
        for (int ai = 0; ai < 2; ++ai) { const size_t off0 = (size_t)(u.pm * 256 + ai * 128 + wr * 64 + fr) * DM + u.pn * 256 + wc * 32 + 8 * fq;
            v4u h0[4][2];
#pragma unroll
            for (int m = 0; m < 4; ++m)
#pragma unroll
                for (int bj = 0; bj < 2; ++bj) h0[m][bj] = *(const v4u*)(XB + off0 + (size_t)(m * 16) * DM + bj * 128);
#pragma unroll
            for (int m = 0; m < 4; ++m) { float ss = 0.f;
#pragma unroll
                for (int bj = 0; bj < 2; ++bj) { const size_t off = off0 + (size_t)(m * 16) * DM + bj * 128; float xf[8]; unpack8(h0[m][bj], xf); const pg8::f32x4 v0 = acc[ai][bj][m][0] + (pg8::f32x4){xf[0], xf[1], xf[2], xf[3]}, v1 = acc[ai][bj][m][1] + (pg8::f32x4){xf[4], xf[5], xf[6], xf[7]};
                    *(v4u*)(H1B + off) = (v4u){pk2n(v0[0], v0[1]), pk2n(v0[2], v0[3]), pk2n(v1[0], v1[1]), pk2n(v1[2], v1[3])};
                    ss += (v0[0] * v0[0] + v0[1] * v0[1]) + (v0[2] * v0[2] + v0[3] * v0[3]) + (v1[0] * v1[0] + v1[1] * v1[1]) + (v1[2] * v1[2] + v1[3] * v1[3]); }
                ss += __shfl_xor(ss, 16); ss += __shfl_xor(ss, 32);
                if (fq == 0) atomicAdd(SS + u.pm * 256 + ai * 128 + wr * 64 + m * 16 + fr, ss); } }
    }
};
struct EpiUp {
    static constexpr bool PERM = true, AFTER_DRAIN = false;
    const float* SS; bf16_t* G; bf16_t* U; const float* CW; const float* CB;
    __device__ __forceinline__ void operator()(const pg8::f32x4 (&acc)[2][2][4][2], const pg8::Unit& u, int wr, int wc, int fr, int fq) const {
        const int oc = u.pn * 128 + wc * 32 + 8 * fq, lm1 = (fq << 4) | ((fr - 1) & 15), lm2 = (fq << 4) | ((fr - 2) & 15);
        float w0[8], w1[8], w2[8], cb[8];
#pragma unroll
        for (int h = 0; h < 2; ++h) { const v4f x0 = *(const v4f*)(CW + oc + 4 * h), x1 = *(const v4f*)(CW + DFF + oc + 4 * h), x2 = *(const v4f*)(CW + 2 * DFF + oc + 4 * h), x3 = *(const v4f*)(CB + oc + 4 * h);
#pragma unroll
            for (int e = 0; e < 4; ++e) { w0[4 * h + e] = x0[e]; w1[4 * h + e] = x1[e]; w2[4 * h + e] = x2[e]; cb[4 * h + e] = x3[e]; } }
#pragma unroll
        for (int ai = 0; ai < 2; ++ai) { const int rbase = u.pm * 256 + ai * 128 + wr * 64; float gs[4][8], rs[4];
#pragma unroll
            for (int m = 0; m < 4; ++m) { rs[m] = 1.0f / sqrtf(SS[rbase + 16 * m + fr] * (1.f / DM) + EPS);
#pragma unroll
                for (int e = 0; e < 8; ++e) gs[m][e] = acc[ai][0][m][e >> 2][e & 3] * rs[m]; }
#pragma unroll
            for (int m = 0; m < 4; ++m) { const size_t off = (size_t)(rbase + 16 * m + fr) * DFF + oc; float o[8];
#pragma unroll
                for (int e = 0; e < 8; ++e) { const float a1 = __shfl(gs[m][e], lm1), a2 = __shfl(gs[m][e], lm2); float b1 = 0.f, b2 = 0.f;
                    if (m > 0) { b1 = __shfl(gs[m - 1][e], lm1); b2 = __shfl(gs[m - 1][e], lm2); }
                    const float p1 = fr >= 1 ? a1 : b1, p2 = fr >= 2 ? a2 : b2, gc = cb[e] + w0[e] * p2 + w1[e] * p1 + w2[e] * gs[m][e];
                    o[e] = gc * sigmoidf_(gc) * (acc[ai][1][m][e >> 2][e & 3] * rs[m]); }
                const v4u gw = {pk2n(gs[m][0], gs[m][1]), pk2n(gs[m][2], gs[m][3]), pk2n(gs[m][4], gs[m][5]), pk2n(gs[m][6], gs[m][7])};
                if (m == 0 && fr < 2) {
                    const pg8::f32x4 u0 = acc[ai][1][m][0] * rs[m], u1 = acc[ai][1][m][1] * rs[m];
                    *(v4u*)(G + off) = gw; *(v4u*)(U + off) = (v4u){pk2n(u0[0], u0[1]), pk2n(u0[2], u0[3]), pk2n(u1[0], u1[1]), pk2n(u1[2], u1[3])}; }
                else { *(v4u*)(U + off) = (v4u){pk2n(o[0], o[1]), pk2n(o[2], o[3]), pk2n(o[4], o[5]), pk2n(o[6], o[7])}; if (m == 3 && fr >= 14) *(v4u*)(G + off) = gw; } } }
    }
};
struct EpiDown {
    static constexpr bool PERM = true, AFTER_DRAIN = false;
    float* OUT; const bf16_t* H1B; float* SS;
    __device__ __forceinline__ void operator()(const pg8::f32x4 (&acc)[2][2][4][2], const pg8::Unit& u, int wr, int wc, int fr, int fq) const {
#pragma unroll
        for (int ai = 0; ai < 2; ++ai) { const size_t off0 = (size_t)(u.pm * 256 + ai * 128 + wr * 64 + fr) * DM + u.pn * 256 + wc * 32 + 8 * fq;
            v4u h1[4][2];
#pragma unroll
            for (int m = 0; m < 4; ++m)
#pragma unroll
                for (int bj = 0; bj < 2; ++bj) h1[m][bj] = *(const v4u*)(H1B + off0 + (size_t)(m * 16) * DM + bj * 128);
#pragma unroll
            for (int m = 0; m < 4; ++m) { float ss = 0.f;
#pragma unroll
                for (int bj = 0; bj < 2; ++bj) { float* p = OUT + off0 + (size_t)(m * 16) * DM + bj * 128; float hf[8]; unpack8(h1[m][bj], hf);
                    const pg8::f32x4 v0 = acc[ai][bj][m][0] + (pg8::f32x4){hf[0], hf[1], hf[2], hf[3]}, v1 = acc[ai][bj][m][1] + (pg8::f32x4){hf[4], hf[5], hf[6], hf[7]};
                    *(pg8::f32x4*)p = v0; *(pg8::f32x4*)(p + 4) = v1;
                    ss += (v0[0] * v0[0] + v0[1] * v0[1]) + (v0[2] * v0[2] + v0[3] * v0[3]) + (v1[0] * v1[0] + v1[1] * v1[1]) + (v1[2] * v1[2] + v1[3] * v1[3]); }
                ss += __shfl_xor(ss, 16); ss += __shfl_xor(ss, 32);
                if (fq == 0) atomicAdd(SS + u.pm * 256 + ai * 128 + wr * 64 + m * 16 + fr, ss); } }
    }
};

struct ChainOrder {
    pg8::StaticOrder base; const char *A0, *B0, *A1, *B1;
    __device__ void init(int M, int G_, int c_) { base.init(M, DM, G_, c_); }
    __device__ bool next(int i, pg8::Unit& u) const { pg8::Unit t; const int ti = i / 3, k = i - 3 * ti; if (!base.next(ti, t)) return false; u.pm = t.pm; u.kind = k ? 1 : 0; u.pn = k ? 2 * t.pn + (k - 1) : t.pn; return true; }
    template <class G_> __device__ __forceinline__ const char* abase(const G_&, const pg8::Unit& u) const { return u.kind ? A1 : A0; }
    template <class G_> __device__ __forceinline__ const char* bbase(const G_&, const pg8::Unit& u) const { return u.kind ? B1 : B0; }
    __device__ __forceinline__ void a_ready(const pg8::Unit&) const {}
    __device__ __forceinline__ void done(const pg8::Unit&) const {}
};
struct EpiOG {
    static constexpr bool PERM = true, AFTER_DRAIN = false;
    EpiO o; EpiGlu g;
    __device__ __forceinline__ void operator()(const pg8::f32x4 (&acc)[2][2][4][2], const pg8::Unit& u, int wr, int wc, int fr, int fq) const { if (u.kind == 0) o(acc, u, wr, wc, fr, fq); else g(acc, u, wr, wc, fr, fq); }
};

#define MFMA16(a, b, c) __builtin_amdgcn_mfma_f32_16x16x32_bf16(a, b, c, 0, 0, 0)
constexpr int SX_KT = 0, SX_W16 = 0, SX_HB = 32768, SX_Y = 69632, SX_TAB = 139264, SX_HSC = SX_TAB + 2048;
constexpr int W16ROW = 264, V16ROW = 136, SS_SROW = 132, SS_HROW = 136;
static_assert(SX_HB + 128 * SS_HROW * 2 <= SX_Y && 128 * W16ROW * 2 <= SX_Y && SX_Y + 256 * V16ROW * 2 <= SX_TAB && SX_Y + 128 * SS_SROW * 4 <= SX_TAB && SX_HSC + 512 <= LDS_BYTES, "ssm lds");
__device__ __forceinline__ void ssm_unit(const Args& a, LAS unsigned char* lds, int b, int g, int tid) {
    const int wid = __builtin_amdgcn_readfirstlane(tid >> 6), lane = tid & 63, fr = lane & 15, fq = lane >> 4;
    unsigned char* ws = a.ws;
    const bf16_t* UB = (const bf16_t*)(ws + OFF_UB) + (size_t)b * PPOS * 1024 + 16 * g;
    const float* GP = (const float*)(ws + OFF_GP) + (size_t)g * 2304;
    bf16_t* YG = (bf16_t*)(ws + OFF_YG);
    LAS float* Sst = (LAS float*)(lds + SX_Y); LAS bf16_t* Hb = (LAS bf16_t*)(lds + SX_HB); LAS float* hsc = (LAS float*)(lds + SX_HSC);
    LAS bf16_t* W16 = (LAS bf16_t*)(lds + SX_W16); LAS bf16_t* V16 = (LAS bf16_t*)(lds + SX_Y); LAS v2f* TAB = (LAS v2f*)(lds + SX_TAB);
    const bf16_t* ubw = UB + (size_t)(64 + 64 * (16 * wid + fr)) * 1024 + 8 * (fq & 1);
    h8 A[32];
#pragma unroll
    for (int ks = 0; ks < 32; ++ks) A[ks] = *(const h8*)(ubw + (size_t)(2 * ks + (fq >> 1)) * 1024);
    { const bf16_t* wsrc = (const bf16_t*)(ws + OFF_WTS) + (size_t)g * 131072 + 768;
#pragma unroll
      for (int i = 0; i < 8; ++i) { const int it = tid + 512 * i, n = it >> 5, c = it & 31; *(LAS v4u*)(W16 + n * W16ROW + 8 * c) = *(const v4u*)(wsrc + (size_t)n * 1024 + 8 * c); }
      if (tid < 192) TAB[64 + tid] = *(const v2f*)((const float*)(ws + OFF_GP2) + (size_t)g * 384 + 2 * tid); }
    float hr = 0.f, hi_ = 0.f;
    if (wid == 0) {
        const float are = GP[lane], aim = GP[64 + lane]; float bbr[16], bbi[16];
#pragma unroll
        for (int q = 0; q < 4; ++q) { const v4f r4 = *(const v4f*)(GP + 256 + lane * 16 + 4 * q), i4 = *(const v4f*)(GP + 1280 + lane * 16 + 4 * q);
            bbr[4 * q] = r4.x; bbr[4 * q + 1] = r4.y; bbr[4 * q + 2] = r4.z; bbr[4 * q + 3] = r4.w; bbi[4 * q] = i4.x; bbi[4 * q + 1] = i4.y; bbi[4 * q + 2] = i4.z; bbi[4 * q + 3] = i4.w; }
        const v2u uw_ = *(const v2u*)(UB + (size_t)(48 + (lane >> 2)) * 1024 + 4 * (lane & 3));
#pragma unroll 1
        for (int t = 0; t < 16; ++t) {
            float br = 0.f, bi = 0.f;
#pragma unroll
            for (int c4 = 0; c4 < 4; ++c4) { const unsigned sx = __builtin_amdgcn_readlane(uw_.x, 4 * t + c4), sy = __builtin_amdgcn_readlane(uw_.y, 4 * t + c4);
                const float u0 = bflo(sx), u1 = bfhi(sx), u2 = bflo(sy), u3 = bfhi(sy);
                br += bbr[4 * c4] * u0 + bbr[4 * c4 + 1] * u1 + bbr[4 * c4 + 2] * u2 + bbr[4 * c4 + 3] * u3;
                bi += bbi[4 * c4] * u0 + bbi[4 * c4 + 1] * u1 + bbi[4 * c4 + 2] * u2 + bbi[4 * c4 + 3] * u3; }
            const float nr = are * hr - aim * hi_ + br, ni = are * hi_ + aim * hr + bi; hr = nr; hi_ = ni;
            if (b == 0 && t >= 14) {
                hsc[2 * lane] = hr; hsc[2 * lane + 1] = hi_; LDS_WAIT(); asm volatile("" ::: "memory");
                if (lane < 16) { const float* cr = a.in[I_CRE] + ((size_t)g * 16 + lane) * 64; const float* ci = a.in[I_CIM] + ((size_t)g * 16 + lane) * 64; float y = 0.f;
#pragma unroll 16
                    for (int p = 0; p < 64; ++p) y += cr[p] * hsc[2 * p] - ci[p] * hsc[2 * p + 1];
                    y += a.in[I_DSKIP][16 * g + lane] * bf2f(UB[(size_t)(48 + t) * 1024 + lane]);
                    YG[(size_t)(MREAL + t) * 1024 + 16 * g + lane] = (bf16_t)(pk2(gelu_tanh(y), 0.f) & 0xffffu); }
                LDS_WAIT(); asm volatile("" ::: "memory");
            }
        }
    }
    __syncthreads();
#pragma unroll
    for (int nt = 0; nt < 8; ++nt) { pg8::f32x4 srun = {0.f, 0.f, 0.f, 0.f};
#pragma unroll
        for (int sub = 0; sub < 4; ++sub) { pg8::f32x4 ac = {0.f, 0.f, 0.f, 0.f};
#pragma unroll
            for (int kk = 0; kk < 8; ++kk) { const h8 B = *(const LAS h8*)(W16 + (16 * nt + fr) * W16ROW + 32 * kk + 8 * fq); ac = MFMA16(B, A[8 * sub + kk], ac); }
            if (sub == 0) srun = ac;
            else { const v2f f0 = TAB[64 + 8 * nt + 2 * fq], f1 = TAB[64 + 8 * nt + 2 * fq + 1]; const pg8::f32x4 o = srun;
                srun = (pg8::f32x4){f0.x * o[0] - f0.y * o[1] + ac[0], f0.x * o[1] + f0.y * o[0] + ac[1], f1.x * o[2] - f1.y * o[3] + ac[2], f1.x * o[3] + f1.y * o[2] + ac[3]}; } }
        *(LAS pg8::f32x4*)(Sst + (16 * wid + fr) * SS_SROW + 16 * nt + 4 * fq) = srun; }
    __syncthreads();
    { const v4u* src = (const v4u*)((const bf16_t*)(ws + OFF_KT) + (size_t)g * 16384); LAS v4u* dst = (LAS v4u*)(lds + SX_KT);
#pragma unroll
      for (int i = 0; i < 4; ++i) dst[tid + 512 * i] = src[tid + 512 * i]; }
    if (wid == 0) { const float a64r = GP[128 + lane], a64i = GP[192 + lane];
        for (int c = 0; c < 128; ++c) { *(LAS unsigned*)(Hb + c * SS_HROW + 2 * lane) = pk2(hr, hi_); const v2f sv = *(const LAS v2f*)(Sst + c * SS_SROW + 2 * lane);
            const float nr = a64r * hr - a64i * hi_ + sv.x, ni = a64r * hi_ + a64i * hr + sv.y; hr = nr; hi_ = ni; } }
    __syncthreads();
    { const bf16_t* vsrc = (const bf16_t*)(ws + OFF_VTS) + (size_t)g * 131072;
#pragma unroll
      for (int i = 0; i < 8; ++i) { const int it = tid + 512 * i, n = it >> 4, c = it & 15; *(LAS v4u*)(V16 + n * V16ROW + 8 * c) = *(const v4u*)(vsrc + (size_t)n * 128 + 8 * c); } }
    __syncthreads();
    const LAS bf16_t* KTl = (const LAS bf16_t*)(lds + SX_KT) + fr * 16 + 8 * (fq & 1);
    const v4f dv = *(const v4f*)(a.in[I_DSKIP] + 16 * g + 4 * fq);
#pragma unroll
    for (int q8 = 0; q8 < 8; ++q8) {
        pg8::f32x4 acc[8];
#pragma unroll
        for (int i = 0; i < 8; ++i) acc[i] = (pg8::f32x4){0.f, 0.f, 0.f, 0.f};
#pragma unroll
        for (int ks = 0; ks < 4 * q8 + 4; ++ks) {
#pragma unroll
            for (int i = 0; i < 8; ++i) { const int t = 8 * q8 + i, s0 = 2 * ks;
                if (t > s0) { const h8 B = *(const LAS h8*)(KTl + (t - s0 - (fq >> 1)) * 256); acc[i] = MFMA16(B, A[ks], acc[i]); }
                else if (t == s0) { h8 B = *(const LAS h8*)KTl; if (fq >> 1) B = (h8){0, 0, 0, 0, 0, 0, 0, 0}; acc[i] = MFMA16(B, A[ks], acc[i]); } } }
#pragma unroll
        for (int k2 = 0; k2 < 4; ++k2) { v4u hw = *(const LAS v4u*)(Hb + (16 * wid + fr) * SS_HROW + 32 * k2 + 8 * fq);
            if (q8 >= 2) { const LAS v2f* tb = TAB + 64 * (q8 >> 1) + 16 * k2 + 4 * fq; const v2f f0 = tb[0], f1 = tb[1], f2 = tb[2], f3 = tb[3];
                hw.x = pk2(f0.x * bflo(hw.x) - f0.y * bfhi(hw.x), f0.x * bfhi(hw.x) + f0.y * bflo(hw.x)); hw.y = pk2(f1.x * bflo(hw.y) - f1.y * bfhi(hw.y), f1.x * bfhi(hw.y) + f1.y * bflo(hw.y));
                hw.z = pk2(f2.x * bflo(hw.z) - f2.y * bfhi(hw.z), f2.x * bfhi(hw.z) + f2.y * bflo(hw.z)); hw.w = pk2(f3.x * bflo(hw.w) - f3.y * bfhi(hw.w), f3.x * bfhi(hw.w) + f3.y * bflo(hw.w)); }
            const h8 Ah = __builtin_bit_cast(h8, hw);
#pragma unroll
            for (int i = 0; i < 8; ++i) { const h8 B = *(const LAS h8*)(V16 + (16 * (8 * (q8 & 1) + i) + fr) * V16ROW + 32 * k2 + 8 * fq); acc[i] = MFMA16(B, Ah, acc[i]); } }
#pragma unroll
        for (int i = 0; i < 8; ++i) { const int tok = 64 * (16 * wid + fr) + 8 * q8 + i;
            const v2u uw = *(const v2u*)(UB + (size_t)(64 + tok) * 1024 + 4 * fq);
            const float y0 = acc[i][0] + dv.x * bflo(uw.x), y1 = acc[i][1] + dv.y * bfhi(uw.x), y2 = acc[i][2] + dv.z * bflo(uw.y), y3 = acc[i][3] + dv.w * bfhi(uw.y);
            *(v2u*)(YG + (size_t)(b * SEQ + tok) * 1024 + 16 * g + 4 * fq) = (v2u){pk2(gelu_tanh(y0), gelu_tanh(y1)), pk2(gelu_tanh(y2), gelu_tanh(y3))}; }
    }
    __syncthreads();
}

__device__ __forceinline__ void meta_attn(const Args& a, int tid) {
    const int h = tid >> 6, lane = tid & 63, qi = lane >> 2, part = lane & 3;
    unsigned char* ws = a.ws;
    const bf16_t* Qm = (const bf16_t*)(ws + OFF_Q) + (size_t)(MREAL + qi) * 1024 + h * 128 + 32 * part;
    const bf16_t* Km = (const bf16_t*)(ws + OFF_K) + (size_t)48 * 1024 + h * 128 + 32 * part;
    const bf16_t* Vm = (const bf16_t*)(ws + OFF_V) + (size_t)48 * 1024 + h * 128 + 32 * part;
    const float* BI = (const float*)(ws + OFF_BIAS) + (size_t)h * PPOS + 48;
    float q[32];
#pragma unroll
    for (int c = 0; c < 4; ++c) { float t8[8]; unpack8(*(const v4u*)(Qm + 8 * c), t8);
#pragma unroll
        for (int e = 0; e < 8; ++e) q[8 * c + e] = t8[e]; }
    float sc[16]; float mx = -1e30f;
#pragma unroll
    for (int kj = 0; kj < 16; ++kj) { float d = 0.f;
#pragma unroll
        for (int c = 0; c < 4; ++c) { float t8[8]; unpack8(*(const v4u*)(Km + (size_t)kj * 1024 + 8 * c), t8);
#pragma unroll
            for (int e = 0; e < 8; ++e) d += q[8 * c + e] * t8[e]; }
        d += __shfl_xor(d, 1); d += __shfl_xor(d, 2);
        sc[kj] = (kj <= qi) ? (d + BI[kj]) * att::SCALE : -__builtin_inff(); mx = fmaxf(mx, sc[kj]); }
    float l = 0.f;
#pragma unroll
    for (int kj = 0; kj < 16; ++kj) { sc[kj] = __expf(sc[kj] - mx); l += sc[kj]; }
    const float rl = 1.f / l;
    float o[32];
#pragma unroll
    for (int e = 0; e < 32; ++e) o[e] = 0.f;
#pragma unroll
    for (int kj = 0; kj < 16; ++kj) {
#pragma unroll
        for (int c = 0; c < 4; ++c) { float t8[8]; unpack8(*(const v4u*)(Vm + (size_t)kj * 1024 + 8 * c), t8);
#pragma unroll
            for (int e = 0; e < 8; ++e) o[8 * c + e] += sc[kj] * t8[e]; } }
    bf16_t* Om = (bf16_t*)(ws + OFF_OB) + (size_t)(MREAL + qi) * 1024 + h * 128 + 32 * part;
#pragma unroll
    for (int c = 0; c < 4; ++c) *(v4u*)(Om + 8 * c) = (v4u){pk2(o[8 * c] * rl, o[8 * c + 1] * rl), pk2(o[8 * c + 2] * rl, o[8 * c + 3] * rl), pk2(o[8 * c + 4] * rl, o[8 * c + 5] * rl), pk2(o[8 * c + 6] * rl, o[8 * c + 7] * rl)};
}

__device__ __forceinline__ att::BlockRef<att::bf16, att::bf16> att_ref(const Args& a, int bh, int qb) {
    att::BlockRef<att::bf16, att::bf16> r; const int b = bh >> 3, h = bh & 7;
    r.Q = (const att::bf16*)(a.ws + OFF_Q) + (size_t)(b * SEQ + qb * 256) * 1024 + h * 128;
    r.O = (att::bf16*)(a.ws + OFF_OB) + (size_t)(b * SEQ + qb * 256) * 1024 + h * 128;
    r.K = (const att::bf16*)(a.ws + OFF_K) + (size_t)b * PPOS * 1024 + h * 128;
    r.V = (const att::bf16*)(a.ws + OFF_V) + (size_t)b * PPOS * 1024 + h * 128;
    r.P0 = 64 + qb * 256;
    return r;
}
__device__ const signed char ATT_BINS[16][4] = {{4, 19, -1, -1}, {5, 21, -1, -1}, {11, 14, -1, -1}, {1, 25, -1, -1}, {10, 16, -1, -1}, {26, -1, -1, -1}, {7, 18, -1, -1}, {27, -1, -1, -1},
                                                {2, 3, 30, -1}, {17, 20, -1, -1}, {13, 24, -1, -1}, {15, 22, -1, -1}, {8, 29, -1, -1}, {6, 31, -1, -1}, {0, 12, 23, -1}, {9, 28, -1, -1}};
__device__ __forceinline__ void attn_phase(const Args& a, char* lds, int vcu, int G) {
    typedef att::BlockRef<att::bf16, att::bf16> Ref;
    constexpr int W = 1 << 20;
    const float* BIAS = (const float*)(a.ws + OFF_BIAS);
    att::Seam<att::bf16> S;
    if (G == 256) {
        const int bh = (vcu & 127) >> 3, bin = (vcu & 7) + (vcu >= 128 ? 8 : 0);
        int idx = 0;
        Ref cur = att_ref(a, bh, ATT_BINS[bin][0]);
        att::causal_swa_prime<att::bf16, att::bf16>(cur, W, lds, S);
        for (;;) {
            const int nq = idx < 3 ? (int)ATT_BINS[bin][idx + 1] : -1; const bool last = nq < 0;
            const Ref nxt = last ? cur : att_ref(a, bh, nq);
            att::causal_swa_block<att::bf16, att::bf16>(cur, nxt, PPOS, W, lds, S, BIAS + (size_t)bh * PPOS);
            if (last) break;
            cur = nxt; ++idx;
        }
        return;
    }
    constexpr int TOTAL = 256;
    int L = vcu; if (L >= TOTAL) return;
    int bh = L >> 4, x = L & 15, pass = 0;
    Ref cur = att_ref(a, bh, x);
    att::causal_swa_prime<att::bf16, att::bf16>(cur, W, lds, S);
    for (;;) {
        const bool more_pass = pass == 0, more_item = L + G < TOTAL, last = !more_pass && !more_item;
        int bhn = bh, xn = x, passn = pass + 1, Ln = L;
        if (!more_pass) { passn = 0; Ln = more_item ? L + G : L; bhn = Ln >> 4; xn = Ln & 15; }
        const Ref nxt = last ? cur : att_ref(a, bhn, passn ? 31 - xn : xn);
        att::causal_swa_block<att::bf16, att::bf16>(cur, nxt, PPOS, W, lds, S, BIAS + (size_t)bh * PPOS);
        if (last) break;
        cur = nxt; bh = bhn; x = xn; pass = passn; L = Ln;
    }
}

template <int NACC, int K>
__device__ __forceinline__ void thin_tile(const bf16_t* __restrict__ A, const bf16_t* __restrict__ Bt, const int (&n0)[NACC], pg8::f32x4 (&acc)[NACC], LAS unsigned char* lds, int wid, int lane) {
    constexpr int KS = K / 32 / 8; const int fr = lane & 15, fq = lane >> 4;
    const bf16_t* ap = A + (size_t)(MREAL + fr) * K + 8 * fq + 32 * KS * wid; h8 av[KS], bv[NACC][KS];
#pragma unroll
    for (int ks = 0; ks < KS; ++ks) { av[ks] = *(const h8*)(ap + 32 * ks);
#pragma unroll
        for (int j = 0; j < NACC; ++j) bv[j][ks] = *(const h8*)(Bt + (size_t)(n0[j] + fr) * K + 8 * fq + 32 * KS * wid + 32 * ks); }
#pragma unroll
    for (int j = 0; j < NACC; ++j) { acc[j] = (pg8::f32x4){0.f, 0.f, 0.f, 0.f};
#pragma unroll
        for (int ks = 0; ks < KS; ++ks) acc[j] = MFMA16(bv[j][ks], av[ks], acc[j]); }
    LAS pg8::f32x4* red = (LAS pg8::f32x4*)lds;
#pragma unroll
    for (int j = 0; j < NACC; ++j) red[(wid * NACC + j) * 64 + lane] = acc[j];
    __syncthreads();
    if (wid == 0) {
#pragma unroll
        for (int j = 0; j < NACC; ++j) { pg8::f32x4 t = red[j * 64 + lane];
#pragma unroll
            for (int w = 1; w < 8; ++w) t += red[(w * NACC + j) * 64 + lane];
            acc[j] = t; } }
    __syncthreads();
}
__device__ __forceinline__ void unpack4(const v2u w, float (&f)[4]) { f[0] = bflo(w.x); f[1] = bfhi(w.x); f[2] = bflo(w.y); f[3] = bfhi(w.y); }
__device__ __forceinline__ void thin_z(const Args& a, LAS unsigned char* lds, int bx, int G, int wid, int lane) {
    unsigned char* ws = a.ws; const int fr = lane & 15, fq = lane >> 4, row = MREAL + fr;
    for (int grp = bx; grp < 512; grp += G) { const int n0[1] = {16 * grp}; pg8::f32x4 acc[1];
        thin_tile<1, DM>((const bf16_t*)(ws + OFF_H0B), (const bf16_t*)(ws + OFF_WT_IN), n0, acc, lds, wid, lane);
        if (wid != 0) continue;
        const float rs = ((const float*)(ws + OFF_RSTD0))[row]; pg8::f32x4 v = acc[0] * rs;
        const int c = 16 * grp + 4 * fq, sec = c < 4096 ? (c >> 10) : (c < 6144 ? 4 : 5);
        if (sec >= 4) { v[0] = sigmoidf_(v[0]); v[1] = sigmoidf_(v[1]); v[2] = sigmoidf_(v[2]); v[3] = sigmoidf_(v[3]); }
        const v2u w = {pk2(v[0], v[1]), pk2(v[2], v[3])};
        if (sec == 0) *(v2u*)((bf16_t*)(ws + OFF_Q) + (size_t)row * 1024 + c) = w;
        else if (sec == 4) *(unsigned*)(ws + OFF_SGA + (size_t)row * 2048 + (c - 4096)) = pack4u8(v[0], v[1], v[2], v[3]);
        else if (sec == 5) *(unsigned*)(ws + OFF_SGB + (size_t)row * 2048 + (c - 6144)) = pack4u8(v[0], v[1], v[2], v[3]);
        else { bf16_t* base = (bf16_t*)(ws + (sec == 1 ? OFF_K : (sec == 2 ? OFF_V : OFF_UB))); const int cc = c & 1023;
            *(v2u*)(base + (size_t)(48 + fr) * 1024 + cc) = w; *(v2u*)(base + (size_t)(PPOS + 48 + fr) * 1024 + cc) = w; } }
}
__device__ __forceinline__ void thin_o(const Args& a, LAS unsigned char* lds, int bx, int G, int wid, int lane) {
    unsigned char* ws = a.ws; const int fr = lane & 15, fq = lane >> 4, row = MREAL + fr;
    for (int grp = bx; grp < 128; grp += G) { const int n0[1] = {16 * grp}; pg8::f32x4 acc[1];
        thin_tile<1, DATT>((const bf16_t*)(ws + OFF_OB), (const bf16_t*)(ws + OFF_WT_O), n0, acc, lds, wid, lane);
        if (wid != 0) continue;
        const size_t off = (size_t)row * 2048 + 16 * grp + 4 * fq; float sg[4]; unpack4u8(*(const unsigned*)(ws + OFF_SGB + off), sg);
        *(v2u*)((bf16_t*)(ws + OFF_M1) + off) = (v2u){pk2(acc[0][0] * sg[0], acc[0][1] * sg[1]), pk2(acc[0][2] * sg[2], acc[0][3] * sg[3])}; }
}
__device__ __forceinline__ void thin_glu(const Args& a, LAS unsigned char* lds, int bx, int G, int wid, int lane) {
    unsigned char* ws = a.ws; const int fr = lane & 15, fq = lane >> 4, row = MREAL + fr;
    for (int grp = bx; grp < 128; grp += G) { const int oc = 16 * grp, t = oc >> 7, w = oc & 127; const int n0[2] = {256 * t + w, 256 * t + 128 + w}; pg8::f32x4 acc[2];
        thin_tile<2, DSSM>((const bf16_t*)(ws + OFF_YG), (const bf16_t*)(ws + OFF_WT_GLU), n0, acc, lds, wid, lane);
        if (wid != 0) continue;
        const size_t off = (size_t)row * 2048 + oc + 4 * fq; float ga[4], m1[4], o[4]; unpack4u8(*(const unsigned*)(ws + OFF_SGA + off), ga); unpack4(*(const v2u*)((const bf16_t*)(ws + OFF_M1) + off), m1);
#pragma unroll
        for (int e = 0; e < 4; ++e) o[e] = m1[e] + ga[e] * acc[0][e] * sigmoidf_(acc[1][e]);
        *(v2u*)((bf16_t*)(ws + OFF_MERGED) + off) = (v2u){pk2(o[0], o[1]), pk2(o[2], o[3])}; }
}
__device__ __forceinline__ void thin_out(const Args& a, LAS unsigned char* lds, int bx, int G, int wid, int lane) {
    unsigned char* ws = a.ws; const int fr = lane & 15, fq = lane >> 4, row = MREAL + fr;
    for (int grp = bx; grp < 128; grp += G) { const int n0[1] = {16 * grp}; pg8::f32x4 acc[1];
        thin_tile<1, DM>((const bf16_t*)(ws + OFF_MERGED), (const bf16_t*)(ws + OFF_WT_OUT), n0, acc, lds, wid, lane);
        if (wid != 0) continue;
        const int c = 16 * grp + 4 * fq; const pg8::f32x4 v = acc[0] + *(const pg8::f32x4*)(a.in[I_META] + (size_t)fr * DM + c);
        *(v2u*)((bf16_t*)(ws + OFF_H1B) + (size_t)row * DM + c) = (v2u){pk2(v[0], v[1]), pk2(v[2], v[3])};
        float ss = (v[0] * v[0] + v[1] * v[1]) + (v[2] * v[2] + v[3] * v[3]); ss += __shfl_xor(ss, 16); ss += __shfl_xor(ss, 32);
        if (fq == 0) atomicAdd((float*)(ws + OFF_SUMSQ1) + row, ss); }
}
__device__ __forceinline__ void thin_up(const Args& a, LAS unsigned char* lds, int bx, int G, int wid, int lane) {
    unsigned char* ws = a.ws; const int fr = lane & 15, fq = lane >> 4, row = MREAL + fr;
    for (int grp = bx; grp < DFF / 16; grp += G) { const int oc = 16 * grp, t = oc >> 7, w = oc & 127; const int n0[2] = {256 * t + w, 256 * t + 128 + w}; pg8::f32x4 acc[2];
        thin_tile<2, DM>((const bf16_t*)(ws + OFF_H1B), (const bf16_t*)(ws + OFF_WT_UP), n0, acc, lds, wid, lane);
        if (wid != 0) continue;
        const float rs = 1.0f / sqrtf(((const float*)(ws + OFF_SUMSQ1))[row] * (1.f / DM) + EPS); const size_t off = (size_t)row * DFF + oc + 4 * fq;
        *(v2u*)((bf16_t*)(ws + OFF_G) + off) = (v2u){pk2(acc[0][0] * rs, acc[0][1] * rs), pk2(acc[0][2] * rs, acc[0][3] * rs)};
        *(v2u*)((bf16_t*)(ws + OFF_U) + off) = (v2u){pk2(acc[1][0] * rs, acc[1][1] * rs), pk2(acc[1][2] * rs, acc[1][3] * rs)}; }
}

__device__ __forceinline__ void conv_phase(const Args& a, int gt, int NT) {
    const bf16_t* G = (const bf16_t*)(a.ws + OFF_G); bf16_t* U = (bf16_t*)(a.ws + OFF_U);
    const float* cw = a.in[I_CONVW]; const float* cb = a.in[I_CONVB];
    constexpr int NCG = DFF / 8, NITEM = (MREAL / 64) * NCG;
    for (int it = gt; it < NITEM; it += NT) { const int j = it / NCG, cgp = it - j * NCG, r0 = 64 * j, c0 = 8 * cgp;
        float w0[8], w1[8], w2[8], bb[8];
#pragma unroll
        for (int h = 0; h < 2; ++h) { const v4f x0 = *(const v4f*)(cw + c0 + 4 * h), x1 = *(const v4f*)(cw + DFF + c0 + 4 * h), x2 = *(const v4f*)(cw + 2 * DFF + c0 + 4 * h), x3 = *(const v4f*)(cb + c0 + 4 * h);
#pragma unroll
            for (int e = 0; e < 4; ++e) { w0[4 * h + e] = x0[e]; w1[4 * h + e] = x1[e]; w2[4 * h + e] = x2[e]; bb[4 * h + e] = x3[e]; } }
        const bool first = (r0 & 8191) == 0;
        float p2[8], p1[8], g0[8], g1[8], u0[8], u1[8], o0[8], o1[8];
        unpack8(*(const v4u*)(G + (size_t)(first ? MREAL + 14 : r0 - 2) * DFF + c0), p2);
        unpack8(*(const v4u*)(G + (size_t)(first ? MREAL + 15 : r0 - 1) * DFF + c0), p1);
        unpack8(*(const v4u*)(G + (size_t)r0 * DFF + c0), g0); unpack8(*(const v4u*)(G + (size_t)(r0 + 1) * DFF + c0), g1);
        unpack8(*(const v4u*)(U + (size_t)r0 * DFF + c0), u0); unpack8(*(const v4u*)(U + (size_t)(r0 + 1) * DFF + c0), u1);
#pragma unroll
        for (int e = 0; e < 8; ++e) { const float ga = bb[e] + w0[e] * p2[e] + w1[e] * p1[e] + w2[e] * g0[e], gb = bb[e] + w0[e] * p1[e] + w1[e] * g0[e] + w2[e] * g1[e];
            o0[e] = ga * sigmoidf_(ga) * u0[e]; o1[e] = gb * sigmoidf_(gb) * u1[e]; }
        *(v4u*)(U + (size_t)r0 * DFF + c0) = (v4u){pk2(o0[0], o0[1]), pk2(o0[2], o0[3]), pk2(o0[4], o0[5]), pk2(o0[6], o0[7])};
        *(v4u*)(U + (size_t)(r0 + 1) * DFF + c0) = (v4u){pk2(o1[0], o1[1]), pk2(o1[2], o1[3]), pk2(o1[4], o1[5]), pk2(o1[6], o1[7])};
    }
}

#define RLX_AGENT __ATOMIC_RELAXED, __HIP_MEMORY_SCOPE_AGENT
#define XB_TMO      128
#define XB_XCNT(j)  (256  + 64 * (j))
#define XB_XSUB(j)  (1280 + 64 * (j))
#define XB_XGEN(j)  (2304 + 64 * (j))
#define XB_TOP      3328
#define XB_TOPGEN   3392
#define XCD_BAR_WORDS 3456
#define XB_SPIN_CAP (1u << 18)

__device__ __forceinline__ unsigned xb_ld(unsigned* p)              { return __hip_atomic_load(p, __ATOMIC_RELAXED, __HIP_MEMORY_SCOPE_AGENT); }
__device__ __forceinline__ unsigned xb_add(unsigned* p, unsigned v) { return __hip_atomic_fetch_add(p, v, __ATOMIC_RELAXED, __HIP_MEMORY_SCOPE_AGENT); }
__device__ __forceinline__ unsigned xb_xcc_id() { return (unsigned)__builtin_amdgcn_s_getreg((3 << 11) | 20) & 0xFu; }
#define XB_SPIN(cond, bar) do { unsigned _sp = 0; while (cond) { __builtin_amdgcn_s_sleep(1); \
    if ((++_sp & 255u) == 0u) { if (xb_ld(&(bar)[XB_TMO])) break; if (_sp > XB_SPIN_CAP) { atomicAdd(&(bar)[XB_TMO], 1u); break; } } } } while (0)

struct XcdBarrier {
    unsigned* bar; unsigned x;
    volatile LAS unsigned* st;
};

__device__ __forceinline__ XcdBarrier xcd_barrier_post(unsigned* bar, volatile LAS unsigned* st) {
    XcdBarrier b; b.bar = bar; b.x = xb_xcc_id(); b.st = st;
    if (threadIdx.x == 0) (void)xb_add(&bar[XB_XCNT(b.x)], 1u);
    return b;
}
__device__ __forceinline__ void xcd_barrier_complete(unsigned* bar, unsigned x, unsigned& nloc, unsigned& nx) {
    const unsigned G = gridDim.x * gridDim.y * gridDim.z;
    unsigned sum, cnt, mine, sp = 0u;
    for (;;) {
        sum = 0u; cnt = 0u; mine = 0u;
#pragma unroll
        for (unsigned j = 0; j < 16; ++j) { const unsigned c = xb_ld(&bar[XB_XCNT(j)]); sum += c; cnt += (c > 0u) ? 1u : 0u; mine = (j == x) ? c : mine; }
        if (sum == G) break;
        __builtin_amdgcn_s_sleep(1);
        if ((++sp & 255u) == 0u) { if (xb_ld(&bar[XB_TMO])) break; if (sp > XB_SPIN_CAP) { atomicAdd(&bar[XB_TMO], 1u); break; } }
    }
    nloc = mine > 0u ? mine : 1u; nx = cnt > 0u ? cnt : 1u;
}

__device__ __forceinline__ void xcd_barrier(const XcdBarrier& b) {
    asm volatile("s_waitcnt vmcnt(0)" ::: "memory");
    __syncthreads();
    if (threadIdx.x == 0) {
        unsigned* bar = b.bar;
        __builtin_amdgcn_s_waitcnt(0);
        unsigned nloc = b.st[0], nx = b.st[1];
        if (nloc == 0u) { xcd_barrier_complete(bar, b.x, nloc, nx); b.st[0] = nloc; b.st[1] = nx; }
        const unsigned old = xb_add(&bar[XB_XSUB(b.x)], 1u);
        const unsigned gen = old / nloc;
        if (old + 1u == (gen + 1u) * nloc) {
            __builtin_amdgcn_fence(__ATOMIC_RELEASE, "agent");
            asm volatile("s_waitcnt vmcnt(0)" ::: "memory");
            const unsigned og = xb_add(&bar[XB_TOP], 1u);
            const unsigned tg = og / nx;
            if (og + 1u == (tg + 1u) * nx) xb_add(&bar[XB_TOPGEN], 1u);
            else XB_SPIN(xb_ld(&bar[XB_TOPGEN]) == tg, bar);
            __builtin_amdgcn_fence(__ATOMIC_ACQUIRE, "agent");
            xb_add(&bar[XB_XGEN(b.x)], 1u);
            asm volatile("s_waitcnt vmcnt(0)" ::: "memory");
        } else {
            XB_SPIN(xb_ld(&bar[XB_XGEN(b.x)]) == gen, bar);
            __builtin_amdgcn_fence(__ATOMIC_ACQUIRE, "agent");
            asm volatile("s_waitcnt vmcnt(0)" ::: "memory");
        }
    }
    __syncthreads();
}

__global__ void __launch_bounds__(512, 2) mk_fwd(Args a0) {
    extern __shared__ __attribute__((aligned(16))) unsigned char lds_raw[];
    LAS unsigned char* lds = (LAS unsigned char*)lds_raw;
    const int tid = threadIdx.x, lane = tid & 63, wid = __builtin_amdgcn_readfirstlane(tid >> 6);
    const int G = gridDim.x, bx = blockIdx.x;
    volatile LAS unsigned* xb_st = (volatile LAS unsigned*)(lds + (LDS_BYTES - 64));
    if (tid < 2) xb_st[tid] = 0u;
    __syncthreads();
    XcdBarrier xbar; { LOAD_ARGS(ab); (void)ab; xbar = xcd_barrier_post((unsigned*)(ws + OFF_BAR), xb_st); }
#define VCU() ((G % 8 == 0) ? (bx % 8) * (G / 8) + bx / 8 : bx)
    const int gw = bx * 8 + wid, NGW = G * 8;
#ifndef PH_MASK
#define PH_MASK 0x3ff
#endif
#define IN(k) (((PH_MASK >> (k)) & 1) && ph_in(k))
#ifndef PROBE_PH
#define PROBE_PH -1
#endif
#ifndef PROBE_MUL
#define PROBE_MUL 8
#endif
    unsigned long long pr_t0 = 0, pr_dt = 0;
#define SEAM(k) do { if (IN(k) && IN((k) + 1)) { if (ph_in(-7)) cg::this_grid().sync();   xcd_barrier(xbar); } if (PROBE_PH == (k)) pr_dt = __builtin_amdgcn_s_memrealtime() - pr_t0; if (PROBE_PH == (k) + 1) pr_t0 = __builtin_amdgcn_s_memrealtime(); } while (0)
    if (PROBE_PH == 0) pr_t0 = __builtin_amdgcn_s_memrealtime();

    if (IN(0)) { LOAD_ARGS(a);
        { LAS float* wf = (LAS float*)(lds + WF_OFF); const float* win = a.in[I_WIN]; const float* gm = a.in[I_GMIX];
#pragma unroll
          for (int k = tid; k < DM; k += 512) { const float g = gm[k]; const v4f w0 = *(const v4f*)(win + (size_t)k * NIN + 3072), w1 = *(const v4f*)(win + (size_t)k * NIN + 3076);
              wf[0 * 2048 + k] = w0.x * g; wf[1 * 2048 + k] = w0.y * g; wf[2 * 2048 + k] = w0.z * g; wf[3 * 2048 + k] = w0.w * g;
              wf[4 * 2048 + k] = w1.x * g; wf[5 * 2048 + k] = w1.y * g; wf[6 * 2048 + k] = w1.z * g; wf[7 * 2048 + k] = w1.w * g; } }
        { const int gt = bx * 512 + tid, NT = G * 512;
          float* s1 = (float*)(ws + OFF_SUMSQ1); float* s2 = (float*)(ws + OFF_SUMSQ2);
          for (int i = gt; i < RPAD; i += NT) { s1[i] = 0.f; s2[i] = 0.f; }
          constexpr int NZ = 48 * 1024 * 2 / 16;
          for (int i = gt; i < 6 * NZ; i += NT) { const int w = i / NZ, j = i - w * NZ; const size_t base = (w >> 1) == 0 ? OFF_K : ((w >> 1) == 1 ? OFF_V : OFF_UB);
              *(v4u*)(ws + base + (size_t)(w & 1) * PPOS * 1024 * 2 + (size_t)j * 16) = (v4u){0u, 0u, 0u, 0u}; } }
        __syncthreads();
#define SUBSTAMP(id) do { if (PROBE_PH == 100 + (id)) pr_t0 = __builtin_amdgcn_s_memrealtime(); if (PROBE_PH == 99 + (id)) pr_dt = __builtin_amdgcn_s_memrealtime() - pr_t0; } while (0)
        SUBSTAMP(0);
        p0_rows(a, lds, gw, NGW, lane);
        __syncthreads();
        SUBSTAMP(1);
        { LOAD_ARGS(a2); (void)ws; p0_transposes(a2, lds, gw, NGW, wid, lane); }
        __syncthreads();
        SUBSTAMP(2);
        for (int jb = bx; jb < 4 * NG; jb += G) ssm_gen(lds, jb >> 2, jb & 3, tid);
        SUBSTAMP(3);
    }
    SEAM(0);
    if (IN(1)) { LOAD_ARGS(a);
        if (bx >= G - 16) cumsum_seq(a, lds, bx - (G - 16), tid);
        thin_z(a, lds, bx, G, wid, lane);
        pg8::Gemm g{(const bf16_t*)(ws + OFF_H0B), (const bf16_t*)(ws + OFF_WT_IN), MREAL, 8192, DM}; pg8::StaticOrder S; S.init(MREAL, 8192, G, bx);
        EpiZ E{(const float*)(ws + OFF_RSTD0), (bf16_t*)(ws + OFF_Q), (bf16_t*)(ws + OFF_K), (bf16_t*)(ws + OFF_V), (bf16_t*)(ws + OFF_UB), (bf16_t*)(ws + OFF_SGA), (bf16_t*)(ws + OFF_SGB)};
        pg8::gemm_phase<EpiZ, pg8::StaticOrder, true, true>(lds, g, S, E);
    }
    SEAM(1);
    if (IN(2)) { LOAD_ARGS(a);
#ifndef P2_PARTS
#define P2_PARTS 7
#endif
        const int vcu = VCU();
        SUBSTAMP(10);
        if ((P2_PARTS & 1) && vcu < 128) ssm_unit(a, lds, vcu >> 6, vcu & 63, tid);
        if ((P2_PARTS & 2) && vcu == 0) meta_attn(a, tid);
        __syncthreads();
        SUBSTAMP(11);
        if (P2_PARTS & 4) attn_phase(a, (char*)lds_raw, vcu, G);
        SUBSTAMP(12);
    }
    SEAM(2);
    if (IN(3)) { LOAD_ARGS(a);
        thin_o(a, lds, bx, G, wid, lane);
        thin_glu(a, lds, bx, G, wid, lane);
        pg8::Gemm g{(const bf16_t*)(ws + OFF_OB), (const bf16_t*)(ws + OFF_WT_O), MREAL, DM, DATT}; ChainOrder S; S.init(MREAL, G, bx);
        S.A0 = (const char*)(ws + OFF_OB); S.B0 = (const char*)(ws + OFF_WT_O); S.A1 = (const char*)(ws + OFF_YG); S.B1 = (const char*)(ws + OFF_WT_GLU);
        EpiOG E{EpiO{(const bf16_t*)(ws + OFF_SGB), (bf16_t*)(ws + OFF_M1)}, EpiGlu{(const bf16_t*)(ws + OFF_SGA), (const bf16_t*)(ws + OFF_M1), (bf16_t*)(ws + OFF_MERGED)}};
        pg8::gemm_phase<EpiOG, ChainOrder, true, true>(lds, g, S, E);
    }
    SEAM(4);
    if (IN(5)) { LOAD_ARGS(a);
        thin_out(a, lds, bx, G, wid, lane);
        pg8::Gemm g{(const bf16_t*)(ws + OFF_MERGED), (const bf16_t*)(ws + OFF_WT_OUT), MREAL, DM, DM}; pg8::StaticOrder S; S.init(MREAL, DM, G, bx);
        EpiOut E{(const bf16_t*)(ws + OFF_H0B), a.out, (bf16_t*)(ws + OFF_H1B), (float*)(ws + OFF_SUMSQ1)};
        pg8::gemm_phase<EpiOut, pg8::StaticOrder, true, true>(lds, g, S, E);
    }
    SEAM(5);
    if (IN(6)) { LOAD_ARGS(a);
        thin_up(a, lds, bx, G, wid, lane);
        pg8::Gemm g{(const bf16_t*)(ws + OFF_H1B), (const bf16_t*)(ws + OFF_WT_UP), MREAL, 2 * DFF, DM}; pg8::StaticOrder S; S.init(MREAL, 2 * DFF, G, bx);
        EpiUp E{(const float*)(ws + OFF_SUMSQ1), (bf16_t*)(ws + OFF_G), (bf16_t*)(ws + OFF_U), a.in[I_CONVW], a.in[I_CONVB]};
        pg8::gemm_phase<EpiUp, pg8::StaticOrder, true, true>(lds, g, S, E);
    }
    SEAM(6);
    if (IN(7)) { LOAD_ARGS(a); (void)ws; conv_phase(a, bx * 512 + tid, G * 512); }
    SEAM(7);
    if (IN(8)) { LOAD_ARGS(a);
        pg8::Gemm g{(const bf16_t*)(ws + OFF_U), (const bf16_t*)(ws + OFF_WT_DOWN), MREAL, DM, DFF}; pg8::StaticOrder S; S.init(MREAL, DM, G, bx);
        EpiDown E{a.out, (const bf16_t*)(ws + OFF_H1B), (float*)(ws + OFF_SUMSQ2)};
        pg8::gemm_phase<EpiDown, pg8::StaticOrder, true, true>(lds, g, S, E);
    }
    SEAM(8);
    if (IN(9)) { LOAD_ARGS(a);
        const float* ss = (const float*)(ws + OFF_SUMSQ2); const float* gf = a.in[I_GFINAL];
        v4f gv[8];
#pragma unroll
        for (int j = 0; j < 8; ++j) gv[j] = *((const v4f*)gf + lane + 64 * j);
        for (int r = gw; r < MREAL; r += 2 * NGW) {
            const int r1 = r + NGW; const bool two = r1 < MREAL; const int r1c = two ? r1 : r;
            const float rs0 = 1.0f / sqrtf(ss[r] * (1.f / DM) + EPS), rs1 = 1.0f / sqrtf(ss[r1c] * (1.f / DM) + EPS);
            v4f* p0 = (v4f*)(a.out + (size_t)r * DM) + lane; v4f* p1 = (v4f*)(a.out + (size_t)r1c * DM) + lane; v4f x0[8], x1[8];
#pragma unroll
            for (int j = 0; j < 8; ++j) { x0[j] = p0[64 * j]; x1[j] = p1[64 * j]; }
#pragma unroll
            for (int j = 0; j < 8; ++j) p0[64 * j] = x0[j] * rs0 * gv[j];
            if (two) {
#pragma unroll
                for (int j = 0; j < 8; ++j) p1[64 * j] = x1[j] * rs1 * gv[j]; } }
    }
    if (PROBE_PH >= 0 && bx == 0) { const unsigned long long t1 = __builtin_amdgcn_s_memrealtime(); while (__builtin_amdgcn_s_memrealtime() - t1 < (unsigned long long)PROBE_MUL * pr_dt) __builtin_amdgcn_s_sleep(8); }
#undef IN
#undef SEAM
}

extern "C" void kernel_launch(void* const* d_in, const int* in_sizes, int n_in, void* d_out, int out_size, void* d_ws, size_t ws_size, hipStream_t stream) {
    static int grid = 0;
    if (grid == 0) {
        if (n_in != 22 || out_size != MREAL * DM || ws_size < WS_NEED) { fprintf(stderr, "kernel_launch: unexpected shapes (n_in %d out %d ws %zu need %zu)\n", n_in, out_size, ws_size, (size_t)WS_NEED); grid = -1; return; }
        int dev = 0, cus = 0, per_cu = 0;
        (void)hipGetDevice(&dev); (void)hipDeviceGetAttribute(&cus, hipDeviceAttributeMultiprocessorCount, dev);
        if (hipFuncSetAttribute((const void*)mk_fwd, hipFuncAttributeMaxDynamicSharedMemorySize, LDS_BYTES) != hipSuccess) { fprintf(stderr, "kernel_launch: hipFuncSetAttribute failed\n"); grid = -1; return; }
        if (hipOccupancyMaxActiveBlocksPerMultiprocessor(&per_cu, (const void*)mk_fwd, 512, LDS_BYTES) != hipSuccess || per_cu < 1) { fprintf(stderr, "kernel_launch: occupancy query says %d\n", per_cu); per_cu = 1; }
        (void)hipGetLastError();
        grid = cus > 0 ? cus : 256;
    }
    if (grid < 0) return;
    (void)hipMemsetAsync((unsigned char*)d_ws + OFF_BAR, 0, 16384, stream);
    Args a{};
    for (int i = 0; i < 22; ++i) a.in[i] = (const float*)d_in[i];
    a.out = (float*)d_out; a.ws = (unsigned char*)d_ws;
#if MK_SPLIT
    for (int p = 0; p < 10; ++p) { a.ph_lo = p; a.ph_hi = p + 1; hipLaunchKernelGGL(mk_fwd, dim3(grid), dim3(512), LDS_BYTES, stream, a); }
#else
    a.ph_lo = 0; a.ph_hi = 10;
    void* args[] = {&a};
    const hipError_t e = hipLaunchCooperativeKernel((const void*)mk_fwd, dim3(grid), dim3(512), args, LDS_BYTES, stream);
    if (e != hipSuccess) fprintf(stderr, "kernel_launch: cooperative launch failed: %s (grid %d)\n", hipGetErrorString(e), grid);
#endif
}
```
